# Optimizing an MI355X kernel written in HIP

```python
import jax, jax.numpy as jnp
from jax import lax
import numpy as np


D_MODEL = 1024
BATCH = 4
SEQ = 8192
DEPTH = 4

N_MIXERS = 4
N_HEADS = 16
HEAD_DIM = D_MODEL // N_HEADS
HD = N_HEADS * HEAD_DIM
FFN_DIM = 2816
ROPE_THETA = 10000.0
Q_BLOCK = 128
RMS_EPS = 1e-6
NEG_INF = -1e30
NSA_KV_HEADS = 4
NSA_CMP_LEN = 32
NSA_CMP_STRIDE = 16
NSA_SEL_LEN = 64
NSA_N_SEL = 16
NSA_WINDOW = 512
NSA_FORCED_SCORE = 1e9
GLA_HEADS = 4
GLA_KEY_DIM = D_MODEL // 2
GLA_VALUE_DIM = D_MODEL
GLA_GATE_RANK = 16
GLA_TAU = 16.0
GLA_CHUNK = 64

kernel_name = 'hybrid_fox_nsa_gla_stickbreak_macaron'


def rms_norm(x, g):
    xf = x.astype(jnp.float32)
    y = xf * lax.rsqrt(jnp.mean(xf * xf, axis=-1, keepdims=True) + RMS_EPS)
    return (y * g.astype(jnp.float32)).astype(x.dtype)


def rope_tables(seq, dim):
    inv = ROPE_THETA ** (-jnp.arange(0, dim, 2, dtype=jnp.float32) / dim)
    ang = jnp.arange(seq, dtype=jnp.float32)[:, None] * inv[None, :]
    return jnp.cos(ang), jnp.sin(ang)


def apply_rope(x, cos, sin):
    x1, x2 = jnp.split(x, 2, axis=-1)
    c, s = cos[:, None, :], sin[:, None, :]
    return jnp.concatenate([x1 * c - x2 * s, x2 * c + x1 * s], axis=-1).astype(x.dtype)


def swiglu(x, w_gate, w_up, w_down):
    return (jax.nn.silu(x @ w_gate) * (x @ w_up)) @ w_down


def fox_mixer(h, w_in, b_f, g_q, g_k, w_out):
    B, S, _ = h.shape
    H, dh = N_HEADS, HEAD_DIM
    q, k, v, f, og = jnp.split(h @ w_in, np.cumsum([HD, HD, HD, H]).tolist(), axis=-1)
    q = rms_norm(q.reshape(B, S, H, dh), g_q).transpose(0, 2, 1, 3)
    k = rms_norm(k.reshape(B, S, H, dh), g_k).transpose(0, 2, 1, 3)
    v = v.reshape(B, S, H, dh).transpose(0, 2, 1, 3)
    c = jnp.cumsum(jax.nn.log_sigmoid((f + b_f).astype(jnp.float32)), axis=1).transpose(0, 2, 1)
    nb = S // Q_BLOCK
    qb = q.reshape(B, H, nb, Q_BLOCK, dh).transpose(2, 0, 1, 3, 4)
    cb = c.reshape(B, H, nb, Q_BLOCK).transpose(2, 0, 1, 3)
    k_pos = jnp.arange(S)
    scale = dh ** -0.5

    def block(args):
        i, q_i, c_i = args
        q_pos = i * Q_BLOCK + jnp.arange(Q_BLOCK)
        s = jnp.einsum('bhqd,bhkd->bhqk', q_i, k).astype(jnp.float32) * scale + (c_i[..., None] - c[:, :, None, :])
        p = jax.nn.softmax(jnp.where(k_pos[None, :] <= q_pos[:, None], s, NEG_INF), axis=-1)
        return jnp.einsum('bhqk,bhkd->bhqd', p.astype(v.dtype), v)

    o = lax.map(block, (jnp.arange(nb), qb, cb))
    o = o.transpose(1, 0, 3, 2, 4).reshape(B, S, HD)
    return (o * jax.nn.sigmoid(og)) @ w_out


def nsa_mixer(h, w_in, cmp_pos_k, cmp_pos_v, w_cmp_k, w_cmp_v, g_q, g_k, w_out, cos, sin):
    B, S, _ = h.shape
    H, G, dh = N_HEADS, NSA_KV_HEADS, HEAD_DIM
    P = H // G
    kvw = G * dh
    q, kc, vc, ks, vs, kw, vw, gate = jnp.split(h @ w_in, np.cumsum([HD] + [kvw] * 6).tolist(), axis=-1)
    q = apply_rope(rms_norm(q.reshape(B, S, H, dh), g_q), cos, sin)
    q = q.reshape(B, S, G, P, dh).transpose(0, 2, 3, 1, 4)

    def keys(t):
        return apply_rope(rms_norm(t.reshape(B, S, G, dh), g_k), cos, sin).transpose(0, 2, 1, 3)

    def vals(t):
        return t.reshape(B, S, G, dh).transpose(0, 2, 1, 3)

    kc, ks, kw = keys(kc), keys(ks), keys(kw)
    vc, vs, vw = vals(vc), vals(vs), vals(vw)
    n_cmp = (S - NSA_CMP_LEN) // NSA_CMP_STRIDE + 1
    cmp_start = np.arange(n_cmp) * NSA_CMP_STRIDE
    cmp_idx = cmp_start[:, None] + np.arange(NSA_CMP_LEN)[None, :]
    kc = rms_norm(jnp.einsum('bgnld,lde->bgne', kc[:, :, cmp_idx] + cmp_pos_k, w_cmp_k), g_k)
    vc = jnp.einsum('bgnld,lde->bgne', vc[:, :, cmp_idx] + cmp_pos_v, w_cmp_v)
    cmp_end = jnp.asarray(cmp_start + NSA_CMP_LEN - 1)
    n_sel = S // NSA_SEL_LEN
    sel_start = np.arange(n_sel) * NSA_SEL_LEN
    cover = jnp.asarray(((cmp_start[:, None] < sel_start[None, :] + NSA_SEL_LEN)
                         & (cmp_start[:, None] + NSA_CMP_LEN > sel_start[None, :])).astype(np.float32))
    k_top = min(NSA_N_SEL, n_sel)
    ks_blk = ks.reshape(B, G, n_sel, NSA_SEL_LEN, dh)
    vs_blk = vs.reshape(B, G, n_sel, NSA_SEL_LEN, dh)
    pad = ((0, 0), (0, 0), (NSA_WINDOW, 0), (0, 0))
    kw_pad, vw_pad = jnp.pad(kw, pad), jnp.pad(vw, pad)
    nb = S // Q_BLOCK
    qb = q.reshape(B, G, P, nb, Q_BLOCK, dh).transpose(3, 0, 1, 2, 4, 5)
    b_idx = jnp.arange(B)[:, None, None, None]
    g_idx = jnp.arange(G)[None, :, None, None]
    blk = jnp.arange(n_sel)
    scale = dh ** -0.5

    def block(args):
        i, q_i = args
        q_pos = i * Q_BLOCK + jnp.arange(Q_BLOCK)
        s = jnp.einsum('bgpqd,bgnd->bgpqn', q_i, kc).astype(jnp.float32) * scale
        valid = cmp_end[None, :] <= q_pos[:, None]
        p_c = jax.nn.softmax(jnp.where(valid, s, NEG_INF), axis=-1) * valid
        o_c = jnp.einsum('bgpqn,bgnd->bgpqd', p_c.astype(vc.dtype), vc)
        imp = jnp.einsum('bgpqn,nj->bgqj', p_c, cover)
        cur = q_pos[:, None] // NSA_SEL_LEN
        forced = (blk[None, :] == 0) | (blk[None, :] == cur) | (blk[None, :] == cur - 1)
        imp = jnp.where(forced, NSA_FORCED_SCORE, jnp.where(blk[None, :] <= cur, imp, -1.0))
        _, sel = lax.top_k(imp, k_top)
        k_g = ks_blk[b_idx, g_idx, sel]
        v_g = vs_blk[b_idx, g_idx, sel]
        s = jnp.einsum('bgpqd,bgqkld->bgpqkl', q_i, k_g).astype(jnp.float32) * scale
        k_pos = sel[..., None] * NSA_SEL_LEN + jnp.arange(NSA_SEL_LEN)
        ok = (k_pos <= q_pos[:, None, None])[:, :, None]
        s = jnp.where(ok, s, NEG_INF).reshape(B, G, P, Q_BLOCK, k_top * NSA_SEL_LEN)
        p_s = jax.nn.softmax(s, axis=-1).reshape(B, G, P, Q_BLOCK, k_top, NSA_SEL_LEN)
        o_s = jnp.einsum('bgpqkl,bgqkld->bgpqd', p_s.astype(v_g.dtype), v_g)
        k_w = lax.dynamic_slice_in_dim(kw_pad, i * Q_BLOCK, NSA_WINDOW + Q_BLOCK, axis=2)
        v_w = lax.dynamic_slice_in_dim(vw_pad, i * Q_BLOCK, NSA_WINDOW + Q_BLOCK, axis=2)
        w_pos = i * Q_BLOCK - NSA_WINDOW + jnp.arange(NSA_WINDOW + Q_BLOCK)
        diff = q_pos[:, None] - w_pos[None, :]
        ok_w = (diff >= 0) & (diff < NSA_WINDOW) & (w_pos[None, :] >= 0)
        s = jnp.einsum('bgpqd,bgkd->bgpqk', q_i, k_w).astype(jnp.float32) * scale
        p_w = jax.nn.softmax(jnp.where(ok_w, s, NEG_INF), axis=-1)
        o_w = jnp.einsum('bgpqk,bgkd->bgpqd', p_w.astype(v_w.dtype), v_w)
        return jnp.stack([o_c, o_s, o_w], axis=-2)

    o = lax.map(block, (jnp.arange(nb), qb))
    o = o.transpose(1, 0, 4, 2, 3, 5, 6).reshape(B, S, H, 3, dh)
    g = jax.nn.sigmoid(gate.reshape(B, S, H, 3))
    o = jnp.einsum('bshc,bshcd->bshd', g.astype(o.dtype), o)
    return o.reshape(B, S, HD) @ w_out


def gla_mixer(h, w_in, w_gate_up, b_gate, g_out, w_out):
    B, S, _ = h.shape
    Hg = GLA_HEADS
    dk, dv = GLA_KEY_DIM // Hg, GLA_VALUE_DIM // Hg
    C = GLA_CHUNK
    nc = S // C
    q, k, v, g_low, r = jnp.split(h @ w_in, np.cumsum([GLA_KEY_DIM, GLA_KEY_DIM, GLA_VALUE_DIM, GLA_GATE_RANK]).tolist(), axis=-1)
    log_a = jax.nn.log_sigmoid((g_low @ w_gate_up + b_gate).astype(jnp.float32)) / GLA_TAU

    def chunked(t, d):
        return t.reshape(B, nc, C, Hg, d).transpose(0, 3, 1, 2, 4).astype(jnp.float32)

    q = chunked(q, dk) * (dk ** -0.5)
    k = chunked(k, dk)
    v = chunked(v, dv)
    b = jnp.cumsum(chunked(log_a, dk), axis=3)
    b_last = b[:, :, :, -1:, :]
    q_dec = q * jnp.exp(b)
    causal = jnp.tril(jnp.ones((C, C), dtype=bool))
    attn = jnp.where(causal, jnp.einsum('bhncd,bhnsd->bhncs', q_dec, k * jnp.exp(-b)), 0.0)
    o_intra = jnp.einsum('bhncs,bhnse->bhnce', attn, v)
    u = jnp.einsum('bhncd,bhnce->bhnde', k * jnp.exp(b_last - b), v)
    decay = jnp.exp(b_last[:, :, :, 0, :])

    def step(state, inp):
        q_c, dec_c, u_c = inp
        o_c = jnp.einsum('bhcd,bhde->bhce', q_c, state)
        return dec_c[..., None] * state + u_c, o_c

    state0 = jnp.zeros((B, Hg, dk, dv), jnp.float32)
    _, o_inter = lax.scan(step, state0, (jnp.moveaxis(q_dec, 2, 0), jnp.moveaxis(decay, 2, 0), jnp.moveaxis(u, 2, 0)))
    o = o_intra + jnp.moveaxis(o_inter, 0, 2)
    o = o.transpose(0, 2, 3, 1, 4).reshape(B, S, Hg, dv)
    o = rms_norm(o, g_out) * jax.nn.silu(r.reshape(B, S, Hg, dv).astype(jnp.float32))
    return o.reshape(B, S, GLA_VALUE_DIM).astype(h.dtype) @ w_out


def sb_mixer(h, w_in, w_out):
    B, S, _ = h.shape
    H, dh = N_HEADS, HEAD_DIM
    q, k, v = [t.reshape(B, S, H, dh).transpose(0, 2, 1, 3) for t in jnp.split(h @ w_in, 3, axis=-1)]
    nb = S // Q_BLOCK
    qb = q.reshape(B, H, nb, Q_BLOCK, dh).transpose(2, 0, 1, 3, 4)
    k_pos = jnp.arange(S)
    scale = dh ** -0.5

    def block(args):
        i, q_i = args
        q_pos = i * Q_BLOCK + jnp.arange(Q_BLOCK)
        z = jnp.einsum('bhqd,bhkd->bhqk', q_i, k).astype(jnp.float32) * scale
        strict = k_pos[None, :] < q_pos[:, None]
        log_1m = jnp.where(strict, jax.nn.log_sigmoid(-z), 0.0)
        later = lax.cumsum(log_1m, axis=3, reverse=True) - log_1m
        a = jnp.where(strict, jnp.exp(jax.nn.log_sigmoid(z) + later), 0.0)
        return jnp.einsum('bhqk,bhkd->bhqd', a.astype(v.dtype), v)

    o = lax.map(block, (jnp.arange(nb), qb))
    return o.transpose(1, 0, 3, 2, 4).reshape(B, S, HD) @ w_out


def _layers_with_mixer(m):
    return len(range(m, DEPTH, N_MIXERS))


def setup_inputs(seed: int = 0) -> dict:
    keys = iter(jax.random.split(jax.random.key(seed), 40))

    def normal(shape, scale):
        return jax.random.normal(next(keys), shape, jnp.float32) * scale

    def dense(shape):
        return normal(shape, shape[-2] ** -0.5)

    def gain(shape):
        return 1.0 + normal(shape, 0.02)

    nA, nB, nC, nD = (_layers_with_mixer(m) for m in range(N_MIXERS))
    D, F, dh = D_MODEL, FFN_DIM, HEAD_DIM
    fox_cols = 3 * HD + N_HEADS + D
    nsa_cols = HD + 6 * NSA_KV_HEADS * dh + 3 * N_HEADS
    gla_cols = 2 * GLA_KEY_DIM + GLA_VALUE_DIM + GLA_GATE_RANK + GLA_VALUE_DIM
    cmp_scale = (NSA_CMP_LEN * dh) ** -0.5
    return {
        'x': normal((BATCH, SEQ, D), 1.0),
        'norm_g': gain((DEPTH, 3, D)),
        'ffn1_w_gate': dense((DEPTH, D, F)),
        'ffn1_w_up': dense((DEPTH, D, F)),
        'ffn1_w_down': dense((DEPTH, F, D)),
        'ffn2_w_gate': dense((DEPTH, D, F)),
        'ffn2_w_up': dense((DEPTH, D, F)),
        'ffn2_w_down': dense((DEPTH, F, D)),
        'fox_w_in': dense((nA, D, fox_cols)),
        'fox_b_f': normal((nA, N_HEADS), 0.1),
        'fox_g_q': gain((nA, dh)),
        'fox_g_k': gain((nA, dh)),
        'fox_w_out': dense((nA, HD, D)),
        'nsa_w_in': dense((nB, D, nsa_cols)),
        'nsa_cmp_pos_k': normal((nB, NSA_CMP_LEN, dh), 0.02),
        'nsa_cmp_pos_v': normal((nB, NSA_CMP_LEN, dh), 0.02),
        'nsa_w_cmp_k': normal((nB, NSA_CMP_LEN, dh, dh), cmp_scale),
        'nsa_w_cmp_v': normal((nB, NSA_CMP_LEN, dh, dh), cmp_scale),
        'nsa_g_q': gain((nB, dh)),
        'nsa_g_k': gain((nB, dh)),
        'nsa_w_out': dense((nB, HD, D)),
        'gla_w_in': dense((nC, D, gla_cols)),
        'gla_w_gate_up': dense((nC, GLA_GATE_RANK, GLA_KEY_DIM)),
        'gla_b_gate': normal((nC, GLA_KEY_DIM), 0.1),
        'gla_g_out': gain((nC, GLA_VALUE_DIM // GLA_HEADS)),
        'gla_w_out': dense((nC, GLA_VALUE_DIM, D)),
        'sb_w_in': dense((nD, D, 3 * HD)),
        'sb_w_out': dense((nD, HD, D)),
    }


def reference(x, norm_g, ffn1_w_gate, ffn1_w_up, ffn1_w_down, ffn2_w_gate, ffn2_w_up, ffn2_w_down,
              fox_w_in, fox_b_f, fox_g_q, fox_g_k, fox_w_out,
              nsa_w_in, nsa_cmp_pos_k, nsa_cmp_pos_v, nsa_w_cmp_k, nsa_w_cmp_v, nsa_g_q, nsa_g_k, nsa_w_out,
              gla_w_in, gla_w_gate_up, gla_b_gate, gla_g_out, gla_w_out,
              sb_w_in, sb_w_out):
    cos, sin = rope_tables(x.shape[1], HEAD_DIM)
    for i in range(DEPTH):
        m, j = i % N_MIXERS, i // N_MIXERS
        x = x + 0.5 * swiglu(rms_norm(x, norm_g[i, 0]), ffn1_w_gate[i], ffn1_w_up[i], ffn1_w_down[i])
        h = rms_norm(x, norm_g[i, 1])
        if m == 0:
            y = fox_mixer(h, fox_w_in[j], fox_b_f[j], fox_g_q[j], fox_g_k[j], fox_w_out[j])
        elif m == 1:
            y = nsa_mixer(h, nsa_w_in[j], nsa_cmp_pos_k[j], nsa_cmp_pos_v[j], nsa_w_cmp_k[j], nsa_w_cmp_v[j],
                          nsa_g_q[j], nsa_g_k[j], nsa_w_out[j], cos, sin)
        elif m == 2:
            y = gla_mixer(h, gla_w_in[j], gla_w_gate_up[j], gla_b_gate[j], gla_g_out[j], gla_w_out[j])
        else:
            y = sb_mixer(h, sb_w_in[j], sb_w_out[j])
        x = x + y
        x = x + 0.5 * swiglu(rms_norm(x, norm_g[i, 2]), ffn2_w_gate[i], ffn2_w_up[i], ffn2_w_down[i])
    return x
```

```cpp
#include <hip/hip_runtime.h>
#include <hip/hip_cooperative_groups.h>
#include <cstdio>
namespace cg = cooperative_groups;

#ifndef ONE_LAUNCH
#define ONE_LAUNCH 1
#endif

#define ABL 0
#ifndef NPH_RUN
#define NPH_RUN 37
#endif
#define DI __device__ __forceinline__
typedef unsigned short bf16_t;
typedef __attribute__((ext_vector_type(8))) short bf16x8;
typedef __attribute__((ext_vector_type(4))) short bf16x4;
typedef __attribute__((ext_vector_type(16))) float f32x16;
typedef __attribute__((ext_vector_type(2))) __bf16 bf2_t;
typedef __attribute__((ext_vector_type(4))) unsigned u32x4;
typedef __attribute__((ext_vector_type(2))) unsigned u32x2;
typedef __attribute__((ext_vector_type(4))) float f32x4;
DI int tidx() { int t = threadIdx.x; asm volatile("" : "+v"(t)); return t; }
DI int bidx() { int t = blockIdx.x; asm volatile("" : "+s"(t)); return t; }

#define MFMA(a, b, c) __builtin_amdgcn_mfma_f32_32x32x16_bf16((a), (b), (c), 0, 0, 0)

constexpr int S_ = 8192;
constexpr int M_ = 32768;
constexpr int D_ = 1024;
constexpr int F_ = 2816;
constexpr int NPH = 37;
constexpr size_t MiB = 1048576;
constexpr size_t OFF_W1 = 0, OFF_W1D = 11 * MiB, OFF_W2 = 17 * MiB, OFF_W2D = 28 * MiB, OFF_WMI = 34 * MiB,
                 OFF_WMO = 43 * MiB, OFF_WCK = 45 * MiB, OFF_WCV = 46 * MiB;
constexpr size_t OFF_XB = 48 * MiB, OFF_OBUF = 112 * MiB, OFF_SSQ = 460 * MiB, OFF_FLOG = 178 * MiB, OFF_C = 180 * MiB,
                 OFF_GATES = 182 * MiB, OFF_SEL = 188 * MiB, OFF_GLOW = 190 * MiB, OFF_DECAY = 192 * MiB,
                 OFF_KCMP = 193 * MiB, OFF_VCMPT = 194 * MiB, OFF_CBIAS = 195 * MiB, OFF_XBAR = 196 * MiB, OFF_R = 200 * MiB;

struct Params {
  const float* in[28];
  float* out;
  char* ws;
};

#define GAS __attribute__((address_space(1)))
DI const float* inp(const Params& P, int k) {
  asm volatile("" : "+s"(k));
  GAS const float* p = (GAS const float*)P.in[k];
  asm volatile("" : "+s"(p));
  return (const float*)p;
}
DI char* wsp(const Params& P) {
  GAS char* w = (GAS char*)P.ws;
  asm volatile("" : "+s"(w));
  return (char*)w;
}
DI float* outp(const Params& P) {
  GAS float* w = (GAS float*)P.out;
  asm volatile("" : "+s"(w));
  return (float*)w;
}
DI unsigned pack2(float a, float b) {
  bf2_t v;
  v[0] = (__bf16)a;
  v[1] = (__bf16)b;
  return __builtin_bit_cast(unsigned, v);
}
DI bf16_t f2bf(float a) { return (bf16_t)(pack2(a, 0.f) & 0xffffu); }
DI float bf2f(bf16_t v) { return __uint_as_float(((unsigned)v) << 16); }
DI float bflo(unsigned u) { return __uint_as_float(u << 16); }
DI float bfhi(unsigned u) { return __uint_as_float(u & 0xffff0000u); }
DI int crow(int i, int h) { return (i & 3) + 8 * (i >> 2) + 4 * h; }
DI float sigmoidf_(float x) { return __builtin_amdgcn_rcpf(1.f + __expf(-x)); }
DI float logsigmoidf_(float z) { return fminf(z, 0.f) - log1pf(__expf(-fabsf(z))); }
DI float row_rstd(const float* ssq, int m) {
  const f32x4* p = (const f32x4*)(ssq + (size_t)m * 16);
  f32x4 a = p[0], b = p[1], c = p[2], d = p[3];
  float s = a.x;
  s += a.y; s += a.z; s += a.w;
  s += b.x; s += b.y; s += b.z; s += b.w;
  s += c.x; s += c.y; s += c.z; s += c.w;
  s += d.x; s += d.y; s += d.z; s += d.w;
  return rsqrtf(s * (1.f / 1024.f) + 1e-6f);
}
DI void store4bf(bf16_t* p, float a, float b, float c, float d) {
  u32x2 u;
  u.x = pack2(a, b);
  u.y = pack2(c, d);
  *(u32x2*)p = u;
}
DI bf16x8 pack8(float a0, float a1, float a2, float a3, float a4, float a5, float a6, float a7) {
  u32x4 u;
  u.x = pack2(a0, a1);
  u.y = pack2(a2, a3);
  u.z = pack2(a4, a5);
  u.w = pack2(a6, a7);
  return __builtin_bit_cast(bf16x8, u);
}
DI bf16x8 cat4(bf16x4 lo, bf16x4 hi) { return __builtin_shufflevector(lo, hi, 0, 1, 2, 3, 4, 5, 6, 7); }
DI void zero16(f32x16& v) {
#pragma unroll
  for (int i = 0; i < 16; ++i) v[i] = 0.f;
}

template <int MH>
DI void gemm_tile(const bf16_t* Wg, int ldw, const bf16_t* Xg, int ldx, int K, bf16_t* sW, bf16_t* sX,
                  f32x16 (&acc)[MH][2][2]) {
  const int tid = tidx(), lane = tid & 63, wave = tid >> 6, wn = wave >> 1, wm = wave & 1, r = lane & 31,
            h = lane >> 5;
#pragma unroll
  for (int a = 0; a < MH; ++a)
#pragma unroll
    for (int b = 0; b < 2; ++b)
#pragma unroll
      for (int c = 0; c < 2; ++c) zero16(acc[a][b][c]);
  u32x4 rw[4], rx[4 * MH];
  const int nk = K >> 6;
  const int row0 = tid >> 3, cc = tid & 7;
  const bf16_t* wp = Wg + (size_t)row0 * ldw + cc * 8;
  const bf16_t* xp = Xg + (size_t)row0 * ldx + cc * 8;
#pragma unroll
  for (int i = 0; i < 4; ++i) rw[i] = *(const u32x4*)(wp + (size_t)(32 * i) * ldw);
#pragma unroll
  for (int i = 0; i < 4 * MH; ++i) rx[i] = *(const u32x4*)(xp + (size_t)(32 * i) * ldx);
  for (int kt = 0; kt < nk; ++kt) {
    __syncthreads();
#pragma unroll
    for (int i = 0; i < 4; ++i) *(u32x4*)(sW + (row0 + 32 * i) * 72 + cc * 8) = rw[i];
#pragma unroll
    for (int i = 0; i < 4 * MH; ++i) *(u32x4*)(sX + (row0 + 32 * i) * 72 + cc * 8) = rx[i];
    __syncthreads();
    if (kt + 1 < nk) {
      const int k0 = (kt + 1) * 64;
#pragma unroll
      for (int i = 0; i < 4; ++i) rw[i] = *(const u32x4*)(wp + (size_t)(32 * i) * ldw + k0);
#pragma unroll
      for (int i = 0; i < 4 * MH; ++i) rx[i] = *(const u32x4*)(xp + (size_t)(32 * i) * ldx + k0);
    }
#pragma unroll
    for (int kk = 0; kk < 4; ++kk) {
      bf16x8 a0 = *(const bf16x8*)(sW + (wn * 64 + r) * 72 + kk * 16 + h * 8);
      bf16x8 a1 = *(const bf16x8*)(sW + (wn * 64 + 32 + r) * 72 + kk * 16 + h * 8);
#pragma unroll
      for (int mq = 0; mq < 2 * MH; ++mq) {
        bf16x8 b = *(const bf16x8*)(sX + (wm * 64 * MH + mq * 32 + r) * 72 + kk * 16 + h * 8);
        acc[mq >> 1][0][mq & 1] = MFMA(a0, b, acc[mq >> 1][0][mq & 1]);
        acc[mq >> 1][1][mq & 1] = MFMA(a1, b, acc[mq >> 1][1][mq & 1]);
      }
    }
  }
}

template <int MH, class Epi>
DI void gemm_phase(const bf16_t* Wt, int Npad, const bf16_t* X, int ldx, int K, char* smem, const Epi& epi) {
  bf16_t* sW = (bf16_t*)smem;
  bf16_t* sX = sW + 128 * 72;
  const int NT = Npad >> 7, MT = M_ / (128 * MH);
  const int wave = tidx() >> 6, wn = wave >> 1, wm = wave & 1;
  const int nblk = gridDim.x;
  const int lb = ((nblk & 7) == 0) ? ((bidx() & 7) * (nblk >> 3) + (bidx() >> 3)) : bidx();
  for (int t = lb; t < NT * MT; t += nblk) {
    const int nt = t % NT, mt = t / NT;
    f32x16 acc[MH][2][2];
    gemm_tile<MH>(Wt + (size_t)nt * 128 * K, K, X + (size_t)mt * 128 * MH * ldx, ldx, K, sW, sX, acc);
#pragma unroll
    for (int mh = 0; mh < MH; ++mh) epi(acc[mh], nt * 128 + wn * 64, mt * 128 * MH + wm * 64 * MH + mh * 64);
  }
}

struct EpiFfn1 {
  const float* ssq;
  bf16_t* act;
  DI void operator()(f32x16 (&acc)[2][2], int nb, int mb) const {
    const int lane = tidx() & 63, r = lane & 31, h = lane >> 5;
    const int jb = (nb >> 6) * 32;
#pragma unroll
    for (int mi = 0; mi < 2; ++mi) {
      const int m = mb + mi * 32 + r;
      const float rstd = row_rstd(ssq, m);
#pragma unroll
      for (int a = 0; a < 4; ++a) {
        float v[4];
#pragma unroll
        for (int q = 0; q < 4; ++q) {
          float g = acc[0][mi][4 * a + q] * rstd, u = acc[1][mi][4 * a + q] * rstd;
          v[q] = g * sigmoidf_(g) * u;
        }
        store4bf(act + (size_t)m * F_ + jb + 8 * a + 4 * h, v[0], v[1], v[2], v[3]);
      }
    }
  }
};

struct EpiResid {
  const float* xin;
  float* xout;
  bf16_t* xb;
  float* ssqn;
  float scale;
  DI void operator()(f32x16 (&acc)[2][2], int nb, int mb) const {
    const int lane = tidx() & 63, r = lane & 31, h = lane >> 5;
#pragma unroll
    for (int mi = 0; mi < 2; ++mi) {
      const int m = mb + mi * 32 + r;
      float part = 0.f;
#pragma unroll
      for (int ni = 0; ni < 2; ++ni)
#pragma unroll
        for (int a = 0; a < 4; ++a) {
          const int n = nb + ni * 32 + 8 * a + 4 * h;
          f32x4 xi = *(const f32x4*)(xin + (size_t)m * D_ + n);
          f32x4 xo;
          xo.x = xi.x + scale * acc[ni][mi][4 * a + 0];
          xo.y = xi.y + scale * acc[ni][mi][4 * a + 1];
          xo.z = xi.z + scale * acc[ni][mi][4 * a + 2];
          xo.w = xi.w + scale * acc[ni][mi][4 * a + 3];
          *(f32x4*)(xout + (size_t)m * D_ + n) = xo;
          store4bf(xb + (size_t)m * D_ + n, xo.x, xo.y, xo.z, xo.w);
          part += xo.x * xo.x + xo.y * xo.y + xo.z * xo.z + xo.w * xo.w;
        }
      part += __shfl_xor(part, 32);
      if (h == 0) ssqn[(size_t)m * 16 + (nb >> 6)] = part;
    }
  }
};

struct EpiQKV {
  const float* ssq;
  const float* gq;
  const float* gk;
  const float* bfv;
  bf16_t* Q;
  bf16_t* K;
  bf16_t* VT;
  bf16_t* obuf;
  float* flog;
  int fox;
  DI void operator()(f32x16 (&acc)[2][2], int nb, int mb) const {
    const int lane = tidx() & 63, r = lane & 31, h = lane >> 5;
#pragma unroll
    for (int mi = 0; mi < 2; ++mi) {
      const int m = mb + mi * 32 + r, b = m >> 13, t = m & 8191;
      const float rstd = row_rstd(ssq, m);
      if (nb < 2048) {
        const int isk = nb >= 1024, hh = (nb & 1023) >> 6;
        float v[2][16];
        float ss = 0.f;
#pragma unroll
        for (int ni = 0; ni < 2; ++ni)
#pragma unroll
          for (int i = 0; i < 16; ++i) {
            v[ni][i] = acc[ni][mi][i] * rstd;
            ss += v[ni][i] * v[ni][i];
          }
        if (fox) {
          ss += __shfl_xor(ss, 32);
          const float rinv = rsqrtf(ss * (1.f / 64.f) + 1e-6f);
          const float* g = isk ? gk : gq;
#pragma unroll
          for (int ni = 0; ni < 2; ++ni)
#pragma unroll
            for (int i = 0; i < 16; ++i) v[ni][i] *= rinv * g[ni * 32 + crow(i, h)];
        }
        bf16_t* dst = (isk ? K : Q) + ((size_t)(b * 16 + hh) * S_ + t) * 64;
#pragma unroll
        for (int ni = 0; ni < 2; ++ni)
#pragma unroll
          for (int a = 0; a < 4; ++a)
            store4bf(dst + ni * 32 + 8 * a + 4 * h, v[ni][4 * a], v[ni][4 * a + 1], v[ni][4 * a + 2], v[ni][4 * a + 3]);
      } else if (nb < 3072) {
        const int hh = (nb - 2048) >> 6;
#pragma unroll
        for (int ni = 0; ni < 2; ++ni)
#pragma unroll
          for (int i = 0; i < 16; ++i) {
            const int d = ni * 32 + crow(i, h);
            VT[((size_t)(b * 16 + hh) * 64 + d) * S_ + t] = f2bf(acc[ni][mi][i] * rstd);
          }
      } else if (fox && nb < 4096) {
        const int hh = (nb - 3072) >> 6;
#pragma unroll
        for (int ni = 0; ni < 2; ++ni)
#pragma unroll
          for (int a = 0; a < 4; ++a)
            store4bf(obuf + (size_t)m * D_ + hh * 64 + ni * 32 + 8 * a + 4 * h, sigmoidf_(acc[ni][mi][4 * a] * rstd),
                     sigmoidf_(acc[ni][mi][4 * a + 1] * rstd), sigmoidf_(acc[ni][mi][4 * a + 2] * rstd),
                     sigmoidf_(acc[ni][mi][4 * a + 3] * rstd));
      } else if (fox && nb == 4096) {
#pragma unroll
        for (int i = 0; i < 8; ++i) {
          const int hh = crow(i, h);
          flog[(size_t)(b * 16 + hh) * S_ + t] = logsigmoidf_(acc[0][mi][i] * rstd + bfv[hh]);
        }
      }
    }
  }
};

struct EpiNSA {
  const float* ssq;
  const float* gq;
  const float* gk;
  bf16_t* Q;
  bf16_t* KC;
  bf16_t* KS;
  bf16_t* KW;
  bf16_t* VC;
  bf16_t* VST;
  bf16_t* VWT;
  float* gates;
  DI void operator()(f32x16 (&acc)[2][2], int nb, int mb) const {
    const int lane = tidx() & 63, r = lane & 31, h = lane >> 5;
    if (nb > 2560) return;
#pragma unroll
    for (int mi = 0; mi < 2; ++mi) {
      const int m = mb + mi * 32 + r, b = m >> 13, t = m & 8191;
      const float rstd = row_rstd(ssq, m);
      if (nb == 2560) {
#pragma unroll
        for (int ni = 0; ni < 2; ++ni)
#pragma unroll
          for (int i = 0; i < 16; ++i) {
            const int nl = ni * 32 + crow(i, h);
            if (nl < 48) gates[(size_t)m * 48 + nl] = sigmoidf_(acc[ni][mi][i] * rstd);
          }
        continue;
      }
      int seg = -1, hh;
      if (nb < 1024) {
        hh = nb >> 6;
      } else {
        seg = (nb - 1024) >> 8;
        hh = ((nb - 1024) & 255) >> 6;
      }
      const int kv = b * 4 + hh;
      if (seg == 1) {
        bf16_t* dst = VC + ((size_t)kv * S_ + t) * 64;
#pragma unroll
        for (int ni = 0; ni < 2; ++ni)
#pragma unroll
          for (int a = 0; a < 4; ++a)
            store4bf(dst + ni * 32 + 8 * a + 4 * h, acc[ni][mi][4 * a] * rstd, acc[ni][mi][4 * a + 1] * rstd,
                     acc[ni][mi][4 * a + 2] * rstd, acc[ni][mi][4 * a + 3] * rstd);
      } else if (seg == 3 || seg == 5) {
        bf16_t* dst = (seg == 3 ? VST : VWT);
#pragma unroll
        for (int ni = 0; ni < 2; ++ni)
#pragma unroll
          for (int i = 0; i < 16; ++i) {
            const int d = ni * 32 + crow(i, h);
            dst[((size_t)kv * 64 + d) * S_ + t] = f2bf(acc[ni][mi][i] * rstd);
          }
      } else {
        float v[2][16];
        float ss = 0.f;
#pragma unroll
        for (int ni = 0; ni < 2; ++ni)
#pragma unroll
          for (int i = 0; i < 16; ++i) {
            v[ni][i] = acc[ni][mi][i] * rstd;
            ss += v[ni][i] * v[ni][i];
          }
        ss += __shfl_xor(ss, 32);
        const float rinv = rsqrtf(ss * (1.f / 64.f) + 1e-6f);
        const float* g = (seg < 0) ? gq : gk;
        const float tf = (float)t;
#pragma unroll
        for (int i = 0; i < 16; ++i) {
          const int fi = crow(i, h);
          const float x1 = v[0][i] * rinv * g[fi], x2 = v[1][i] * rinv * g[32 + fi];
          const float inv = exp2f(-(float)fi * 0.41524101186092034f);
          const float ang = tf * inv;
          const float Chi = 0.15915494f, Clo = 6.4206383e-9f;
          const float p = ang * Chi;
          const float e = __builtin_fmaf(ang, Chi, -p);
          const float fr = (p - floorf(p)) + (e + ang * Clo);
          const float sn = __builtin_amdgcn_sinf(fr), cs = __builtin_amdgcn_cosf(fr);
          v[0][i] = x1 * cs - x2 * sn;
          v[1][i] = x2 * cs + x1 * sn;
          if ((i & 1) == 1) __builtin_amdgcn_sched_barrier(0);
        }
        bf16_t* dst;
        if (seg < 0)
          dst = Q + ((size_t)(b * 16 + hh) * S_ + t) * 64;
        else
          dst = (seg == 0 ? KC : (seg == 2 ? KS : KW)) + ((size_t)kv * S_ + t) * 64;
#pragma unroll
        for (int ni = 0; ni < 2; ++ni)
#pragma unroll
          for (int a = 0; a < 4; ++a)
            store4bf(dst + ni * 32 + 8 * a + 4 * h, v[ni][4 * a], v[ni][4 * a + 1], v[ni][4 * a + 2], v[ni][4 * a + 3]);
      }
    }
  }
};

struct EpiGLA {
  const float* ssq;
  bf16_t* QG;
  bf16_t* KG;
  bf16_t* VTG;
  bf16_t* obuf;
  float* glow;
  DI void operator()(f32x16 (&acc)[2][2], int nb, int mb) const {
    const int lane = tidx() & 63, r = lane & 31, h = lane >> 5;
    if (nb > 3072) return;
#pragma unroll
    for (int mi = 0; mi < 2; ++mi) {
      const int m = mb + mi * 32 + r, b = m >> 13, t = m & 8191;
      const float rstd = row_rstd(ssq, m);
      if (nb < 1024) {
        bf16_t* dst = (nb < 512 ? QG + (size_t)m * 512 + nb : KG + (size_t)m * 512 + (nb - 512));
#pragma unroll
        for (int ni = 0; ni < 2; ++ni)
#pragma unroll
          for (int a = 0; a < 4; ++a)
            store4bf(dst + ni * 32 + 8 * a + 4 * h, acc[ni][mi][4 * a] * rstd, acc[ni][mi][4 * a + 1] * rstd,
                     acc[ni][mi][4 * a + 2] * rstd, acc[ni][mi][4 * a + 3] * rstd);
      } else if (nb < 2048) {
#pragma unroll
        for (int ni = 0; ni < 2; ++ni)
#pragma unroll
          for (int i = 0; i < 16; ++i) {
            const int e = nb - 1024 + ni * 32 + crow(i, h);
            VTG[((size_t)b * 1024 + e) * S_ + t] = f2bf(acc[ni][mi][i] * rstd);
          }
      } else if (nb < 3072) {
#pragma unroll
        for (int ni = 0; ni < 2; ++ni)
#pragma unroll
          for (int a = 0; a < 4; ++a) {
            float v[4];
#pragma unroll
            for (int q = 0; q < 4; ++q) {
              float z = acc[ni][mi][4 * a + q] * rstd;
              v[q] = z * sigmoidf_(z);
            }
            store4bf(obuf + (size_t)m * D_ + (nb - 2048) + ni * 32 + 8 * a + 4 * h, v[0], v[1], v[2], v[3]);
          }
      } else {
#pragma unroll
        for (int i = 0; i < 8; ++i) glow[(size_t)m * 16 + crow(i, h)] = acc[0][mi][i] * rstd;
      }
    }
  }
};

struct EpiCmp {
  const float* cb;
  const float* gk;
  bf16_t* dst;
  int isv;
  DI void operator()(f32x16 (&acc)[2][2], int nb, int mb) const {
    const int lane = tidx() & 63, r = lane & 31, h = lane >> 5;
    if (nb != 0) return;
#pragma unroll
    for (int mi = 0; mi < 2; ++mi) {
      const int n = mb + mi * 32 + r;
      const bool ok = n < 511;
      float v[2][16];
      float ss = 0.f;
#pragma unroll
      for (int ni = 0; ni < 2; ++ni)
#pragma unroll
        for (int i = 0; i < 16; ++i) {
          v[ni][i] = ok ? acc[ni][mi][i] + cb[ni * 32 + crow(i, h)] : 0.f;
          ss += v[ni][i] * v[ni][i];
        }
      if (!isv) {
        ss += __shfl_xor(ss, 32);
        const float rinv = rsqrtf(ss * (1.f / 64.f) + 1e-6f);
#pragma unroll
        for (int ni = 0; ni < 2; ++ni)
#pragma unroll
          for (int a = 0; a < 4; ++a) {
            const int e = ni * 32 + 8 * a + 4 * h;
            store4bf(dst + (size_t)n * 64 + e, v[ni][4 * a] * rinv * gk[e], v[ni][4 * a + 1] * rinv * gk[e + 1],
                     v[ni][4 * a + 2] * rinv * gk[e + 2], v[ni][4 * a + 3] * rinv * gk[e + 3]);
          }
      } else {
#pragma unroll
        for (int ni = 0; ni < 2; ++ni)
#pragma unroll
          for (int i = 0; i < 16; ++i) dst[(size_t)(ni * 32 + crow(i, h)) * 512 + n] = f2bf(v[ni][i]);
      }
    }
  }
};

template <class Src>
DI void prep_job(bf16_t* dst, int Npad, int K, float* sT, Src src) {
  const int tid = tidx();
  const int NT = Npad >> 6, KT = K >> 6;
  for (int t = bidx(); t < NT * KT; t += gridDim.x) {
    const int nt = t % NT, kt = t / NT;
    __syncthreads();
#pragma unroll 4
    for (int i = 0; i < 16; ++i) {
      const int e = tid + 256 * i, kk = e >> 6, nn = e & 63;
      sT[kk * 65 + nn] = src(kt * 64 + kk, nt * 64 + nn);
    }
    __syncthreads();
#pragma unroll 4
    for (int i = 0; i < 8; ++i) {
      const int e = tid + 256 * i, nn = e >> 5, kp = e & 31;
      *(unsigned*)(dst + (size_t)(nt * 64 + nn) * K + kt * 64 + 2 * kp) = pack2(sT[(2 * kp) * 65 + nn], sT[(2 * kp + 1) * 65 + nn]);
    }
  }
}

DI void prep_layer(const Params& P, int L, char* smem) {
  float* sT = (float*)smem;
  char* ws = wsp(P);
  const float* ng = inp(P, 1) + (size_t)L * 3 * D_;
  for (int f = 0; f < 2; ++f) {
    const float* wg = inp(P, f ? 5 : 2) + (size_t)L * D_ * F_;
    const float* wu = inp(P, f ? 6 : 3) + (size_t)L * D_ * F_;
    const float* wd = inp(P, f ? 7 : 4) + (size_t)L * D_ * F_;
    const float* g = ng + (f ? 2 * D_ : 0);
    prep_job((bf16_t*)(ws + (f ? OFF_W2 : OFF_W1)), 2 * F_, D_, sT, [=](int k, int n) {
      const int grp = n >> 6, rr = n & 63;
      const float* s = rr < 32 ? wg : wu;
      return s[(size_t)k * F_ + grp * 32 + (rr & 31)] * g[k];
    });
    prep_job((bf16_t*)(ws + (f ? OFF_W2D : OFF_W1D)), D_, F_, sT, [=](int k, int n) { return wd[(size_t)k * D_ + n]; });
  }
  const float* g1 = ng + D_;
  bf16_t* wmi = (bf16_t*)(ws + OFF_WMI);
  bf16_t* wmo = (bf16_t*)(ws + OFF_WMO);
  if (L == 0) {
    const float* w = inp(P, 8);
    prep_job(wmi, 4224, D_, sT, [=](int k, int n) {
      int c = n < 3072 ? n : (n < 4096 ? n + 16 : (n < 4112 ? n - 1024 : -1));
      return c < 0 ? 0.f : w[(size_t)k * 4112 + c] * g1[k];
    });
    const float* wo = inp(P, 12);
    prep_job(wmo, D_, D_, sT, [=](int k, int n) { return wo[(size_t)k * D_ + n]; });
  } else if (L == 1) {
    const float* w = inp(P, 13);
    prep_job(wmi, 2688, D_, sT, [=](int k, int n) { return n < 2608 ? w[(size_t)k * 2608 + n] * g1[k] : 0.f; });
    const float* wo = inp(P, 20);
    prep_job(wmo, D_, D_, sT, [=](int k, int n) { return wo[(size_t)k * D_ + n]; });
    const float* wck = inp(P, 16);
    const float* wcv = inp(P, 17);
    prep_job((bf16_t*)(ws + OFF_WCK), 128, 2048, sT, [=](int k, int n) { return n < 64 ? wck[(size_t)k * 64 + n] : 0.f; });
    prep_job((bf16_t*)(ws + OFF_WCV), 128, 2048, sT, [=](int k, int n) { return n < 64 ? wcv[(size_t)k * 64 + n] : 0.f; });
    if (bidx() == 0 && tidx() < 128) {
      const int e = tidx() & 63, which = tidx() >> 6;
      const float* pos = which ? inp(P, 15) : inp(P, 14);
      const float* wc = which ? inp(P, 17) : inp(P, 16);
      float s = 0.f;
      for (int kd = 0; kd < 2048; ++kd) s += pos[kd] * wc[(size_t)kd * 64 + e];
      ((float*)(ws + OFF_CBIAS))[which * 64 + e] = s;
    }
  } else if (L == 2) {
    const float* w = inp(P, 21);
    prep_job(wmi, 3200, D_, sT, [=](int k, int n) {
      int c = n < 2048 ? n : (n < 3072 ? n + 16 : (n < 3088 ? n - 1024 : -1));
      return c < 0 ? 0.f : w[(size_t)k * 3088 + c] * g1[k];
    });
    const float* wo = inp(P, 25);
    prep_job(wmo, D_, D_, sT, [=](int k, int n) { return wo[(size_t)k * D_ + n]; });
  } else {
    const float* w = inp(P, 26);
    prep_job(wmi, 3072, D_, sT, [=](int k, int n) { return w[(size_t)k * 3072 + n] * g1[k]; });
    const float* wo = inp(P, 27);
    prep_job(wmo, D_, D_, sT, [=](int k, int n) { return wo[(size_t)k * D_ + n]; });
  }
}

DI void init_phase(const Params& P) {
  const int tid = tidx(), lane = tid & 63, wave = tid >> 6;
  float* ssq = (float*)(wsp(P) + OFF_SSQ);
  bf16_t* xb = (bf16_t*)(wsp(P) + OFF_XB);
  const float* x = inp(P, 0);
  for (int row = bidx() * 4 + wave; row < M_; row += gridDim.x * 4) {
    float s = 0.f;
#pragma unroll
    for (int i = 0; i < 4; ++i) {
      const int c = (i * 64 + lane) * 4;
      f32x4 v = *(const f32x4*)(x + (size_t)row * D_ + c);
      s += v.x * v.x + v.y * v.y + v.z * v.z + v.w * v.w;
      store4bf(xb + (size_t)row * D_ + c, v.x, v.y, v.z, v.w);
    }
#pragma unroll
    for (int o = 32; o >= 1; o >>= 1) s += __shfl_xor(s, o);
    if (lane < 16) ssq[(size_t)row * 16 + lane] = (lane == 0) ? s : 0.f;
  }
}

struct AttnSmem {
  bf16_t k[64 * 72];
  bf16_t v[64 * 72];
  float c[64];
};

DI void attn_load(const bf16_t* Kb, int ldk, const bf16_t* VTb, int ldv, int j, u32x4 (&kr)[2], u32x4 (&vr)[2]) {
  const int tid = tidx();
#pragma unroll
  for (int i = 0; i < 2; ++i) {
    const int c = tid + 256 * i, row = c >> 3, cc = c & 7;
    kr[i] = *(const u32x4*)(Kb + (size_t)(j * 64 + row) * ldk + cc * 8);
    vr[i] = *(const u32x4*)(VTb + (size_t)row * ldv + j * 64 + cc * 8);
  }
}
DI void attn_store(AttnSmem& sm, const u32x4 (&kr)[2], const u32x4 (&vr)[2]) {
  const int tid = tidx();
#pragma unroll
  for (int i = 0; i < 2; ++i) {
    const int c = tid + 256 * i, row = c >> 3, cc = c & 7;
    *(u32x4*)(sm.k + row * 72 + cc * 8) = kr[i];
    *(u32x4*)(sm.v + row * 72 + cc * 8) = vr[i];
  }
}
DI void attn_qk(const AttnSmem& sm, const bf16x8 (&qf)[4], f32x16 (&st)[2]) {
  const int lane = tidx() & 63, r = lane & 31, h = lane >> 5;
#pragma unroll
  for (int kt = 0; kt < 2; ++kt) {
    zero16(st[kt]);
#pragma unroll
    for (int kk = 0; kk < 4; ++kk) {
      bf16x8 a = *(const bf16x8*)(sm.k + (kt * 32 + r) * 72 + kk * 16 + h * 8);
      st[kt] = MFMA(a, qf[kk], st[kt]);
    }
  }
}
DI void attn_pv(const AttnSmem& sm, const f32x16 (&st)[2], f32x16 (&o)[2]) {
  const int lane = tidx() & 63, r = lane & 31, h = lane >> 5;
#pragma unroll
  for (int kt = 0; kt < 2; ++kt)
#pragma unroll
    for (int s2 = 0; s2 < 2; ++s2) {
      bf16x8 pk = pack8(st[kt][8 * s2], st[kt][8 * s2 + 1], st[kt][8 * s2 + 2], st[kt][8 * s2 + 3], st[kt][8 * s2 + 4],
                        st[kt][8 * s2 + 5], st[kt][8 * s2 + 6], st[kt][8 * s2 + 7]);
#pragma unroll
      for (int dt = 0; dt < 2; ++dt) {
        const bf16_t* p = sm.v + (dt * 32 + r) * 72 + kt * 32 + 16 * s2 + 4 * h;
        bf16x8 a = cat4(*(const bf16x4*)p, *(const bf16x4*)(p + 8));
        o[dt] = MFMA(a, pk, o[dt]);
      }
    }
}
DI void load_qf(const bf16_t* Qrow, bf16x8 (&qf)[4]) {
  const int h = (tidx() & 63) >> 5;
#pragma unroll
  for (int kk = 0; kk < 4; ++kk) qf[kk] = *(const bf16x8*)(Qrow + kk * 16 + h * 8);
}

template <int MODE>
DI void flash_pass(const bf16_t* Kb, const bf16_t* VTb, const float* cB, float cq, u32x4 selw, int qw, int jlo, int jhi,
                   const bf16x8 (&qf)[4], f32x16 (&o)[2], float& lsum, AttnSmem& sm) {
  const int tid = tidx(), lane = tid & 63, r = lane & 31, h = lane >> 5;
  const int query = qw + r;
  float m_run = -1e30f, l_run = 0.f;
  zero16(o[0]);
  zero16(o[1]);
  u32x4 kr[2], vr[2];
  float cr = 0.f;
  attn_load(Kb, 64, VTb, S_, jlo, kr, vr);
  if (MODE == 0 && tid < 64) cr = cB[jlo * 64 + tid];
  for (int j = jlo; j <= jhi; ++j) {
    __syncthreads();
    attn_store(sm, kr, vr);
    if (MODE == 0 && tid < 64) sm.c[tid] = cr;
    __syncthreads();
    if (j < jhi) {
      attn_load(Kb, 64, VTb, S_, j + 1, kr, vr);
      if (MODE == 0 && tid < 64) cr = cB[(j + 1) * 64 + tid];
    }
    bool active = (j * 64 <= qw + 31);
    bool bit = true;
    if (MODE == 1) active = active && (j * 64 + 63 >= qw - 511);
    if (MODE == 2) {
      const int wi = j >> 5;
      const unsigned w = wi == 0 ? selw.x : (wi == 1 ? selw.y : (wi == 2 ? selw.z : selw.w));
      bit = (w >> (j & 31)) & 1u;
      active = active && (__ballot(bit) != 0ull);
    }
    if (active) {
      f32x16 st[2];
      attn_qk(sm, qf, st);
      const float SC = 0.125f * 1.4426950408889634f;
      const bool interior = (MODE != 0) && (j * 64 + 63 <= qw) && (MODE != 1 || (qw + 31 - j * 64 < 512));
      float mx = -1e30f;
      if (interior) {
#pragma unroll
        for (int kt = 0; kt < 2; ++kt)
#pragma unroll
          for (int i = 0; i < 16; ++i) {
            const float s = st[kt][i] * SC;
            st[kt][i] = s;
            mx = fmaxf(mx, s);
          }
        if (MODE == 2 && !bit) mx = -1e30f;
      } else {
#pragma unroll
        for (int kt = 0; kt < 2; ++kt)
#pragma unroll
          for (int i = 0; i < 16; ++i) {
            const int kl = kt * 32 + crow(i, h);
            const int key = j * 64 + kl;
            float s = st[kt][i] * SC;
            bool ok = key <= query;
            if (MODE == 0) s += (cq - sm.c[kl]) * 1.4426950408889634f;
            if (MODE == 1) ok = ok && (query - key < 512);
            if (MODE == 2) ok = ok && bit;
            s = ok ? s : -1e30f;
            st[kt][i] = s;
            mx = fmaxf(mx, s);
          }
      }
      mx = fmaxf(mx, __shfl_xor(mx, 32));
      const float m_new = fmaxf(m_run, mx);
      const float alpha = __builtin_amdgcn_exp2f(m_run - m_new);
      float ps = 0.f;
      if (interior) {
#pragma unroll
        for (int kt = 0; kt < 2; ++kt)
#pragma unroll
          for (int i = 0; i < 16; ++i) {
            float p = __builtin_amdgcn_exp2f(st[kt][i] - m_new);
            if (MODE == 2) p = bit ? p : 0.f;
            st[kt][i] = p;
            ps += p;
          }
      } else {
#pragma unroll
        for (int kt = 0; kt < 2; ++kt)
#pragma unroll
          for (int i = 0; i < 16; ++i) {
            const float s = st[kt][i];
            const float p = (s > -1e29f) ? __builtin_amdgcn_exp2f(s - m_new) : 0.f;
            st[kt][i] = p;
            ps += p;
          }
      }
      ps += __shfl_xor(ps, 32);
      l_run = l_run * alpha + ps;
      m_run = m_new;
#pragma unroll
      for (int dt = 0; dt < 2; ++dt)
#pragma unroll
        for (int i = 0; i < 16; ++i) o[dt][i] *= alpha;
      attn_pv(sm, st, o);
    }
  }
  lsum = l_run;
}

DI void fox_pass(const bf16_t* Kb, const bf16_t* VTb, const float* cB, float cq, float sbound, int qw, int jhi,
                 const bf16x8 (&qf)[4], f32x16 (&o)[2], float& lsum, AttnSmem& sm) {
  const int tid = tidx(), lane = tid & 63, r = lane & 31, h = lane >> 5;
  const int query = qw + r;
  float m_run = -1e30f, l_run = 0.f;
  zero16(o[0]);
  zero16(o[1]);
  u32x4 kr[2], vr[2];
  float cr = 0.f;
  int done = 0;
  attn_load(Kb, 64, VTb, S_, jhi, kr, vr);
  if (tid < 64) cr = cB[jhi * 64 + tid];
  for (int j = jhi; j >= 0; --j) {
    if (__syncthreads_and(done)) break;
    attn_store(sm, kr, vr);
    if (tid < 64) sm.c[tid] = cr;
    __syncthreads();
    if (j > 0) {
      attn_load(Kb, 64, VTb, S_, j - 1, kr, vr);
      if (tid < 64) cr = cB[(j - 1) * 64 + tid];
    }
    if (j * 64 <= qw + 31) {
      f32x16 st[2];
      attn_qk(sm, qf, st);
      float mx = -1e30f;
#pragma unroll
      for (int kt = 0; kt < 2; ++kt)
#pragma unroll
        for (int i = 0; i < 16; ++i) {
          const int kl = kt * 32 + crow(i, h);
          const int key = j * 64 + kl;
          float s = st[kt][i] * 0.125f + (cq - sm.c[kl]);
          s = (key <= query) ? s : -1e30f;
          st[kt][i] = s;
          mx = fmaxf(mx, s);
        }
      mx = fmaxf(mx, __shfl_xor(mx, 32));
      const float m_new = fmaxf(m_run, mx);
      const float alpha = __expf(m_run - m_new);
      float ps = 0.f;
#pragma unroll
      for (int kt = 0; kt < 2; ++kt)
#pragma unroll
        for (int i = 0; i < 16; ++i) {
          const float s = st[kt][i];
          const float p = (s > -1e29f) ? __expf(s - m_new) : 0.f;
          st[kt][i] = p;
          ps += p;
        }
      ps += __shfl_xor(ps, 32);
      l_run = l_run * alpha + ps;
      m_run = m_new;
#pragma unroll
      for (int dt = 0; dt < 2; ++dt)
#pragma unroll
        for (int i = 0; i < 16; ++i) o[dt][i] *= alpha;
      attn_pv(sm, st, o);
      done = (sbound + cq - sm.c[0] < m_run - 104.f) ? 1 : 0;
    }
  }
  lsum = l_run;
}
DI void fox_scan_phase(const Params& P, char* smem) {
  double* sp = (double*)smem;
  const float* flog = (const float*)(wsp(P) + OFF_FLOG);
  float* c = (float*)(wsp(P) + OFF_C);
  const int tid = tidx();
  for (int seq = bidx(); seq < 64; seq += gridDim.x) {
    const float* src = flog + (size_t)seq * S_ + tid * 32;
    double tot = 0.0;
    for (int i = 0; i < 32; ++i) tot += (double)src[i];
    __syncthreads();
    sp[tid] = tot;
    __syncthreads();
    double pre = 0.0;
    for (int i = 0; i < tid; ++i) pre += sp[i];
    float* dst = c + (size_t)seq * S_ + tid * 32;
    for (int i = 0; i < 32; ++i) {
      pre += (double)src[i];
      dst[i] = (float)pre;
    }
  }
}

DI void fox_attn_phase(const Params& P, char* smem, int rep) {
  AttnSmem& sm = *(AttnSmem*)smem;
  const bf16_t* Q = (const bf16_t*)(wsp(P) + OFF_R);
  const bf16_t* K = Q + (size_t)M_ * D_;
  const bf16_t* VT = K + (size_t)M_ * D_;
  const float* c = (const float*)(wsp(P) + OFF_C);
  bf16_t* obuf = (bf16_t*)(wsp(P) + OFF_OBUF);
  const int lane = tidx() & 63, wave = tidx() >> 6, r = lane & 31, h = lane >> 5;
  float gqm = 0.f, gkm = 0.f;
  for (int d = 0; d < 64; ++d) {
    gqm = fmaxf(gqm, fabsf(inp(P, 10)[d]));
    gkm = fmaxf(gkm, fabsf(inp(P, 11)[d]));
  }
  const float sbound = 8.16f * gqm * gkm;
  for (int it = bidx(); it < 4096; it += gridDim.x) {
    const int qt = 63 - (it >> 6), bh = it & 63;
    const int q0 = qt * 128, qw = q0 + wave * 32, query = qw + r;
    bf16x8 qf[4];
    load_qf(Q + ((size_t)bh * S_ + query) * 64, qf);
    const float cq = c[(size_t)bh * S_ + query];
    f32x16 o[2];
    float l;
    fox_pass(K + (size_t)bh * S_ * 64, VT + (size_t)bh * 64 * S_, c + (size_t)bh * S_, cq, sbound, qw, 2 * qt + 1, qf, o, l, sm);
    const float inv = 1.f / l;
    const int b = bh >> 4, hh = bh & 15;
    bf16_t* dst = obuf + ((size_t)b * S_ + query) * D_ + hh * 64;
#pragma unroll
    for (int dt = 0; dt < 2; ++dt)
#pragma unroll
      for (int a = 0; a < 4; ++a) {
        bf16_t* p = dst + dt * 32 + 8 * a + 4 * h;
        u32x2 g = *(const u32x2*)p;
        if (rep) *(u32x2*)p = g;
        else
        store4bf(p, o[dt][4 * a] * inv * bflo(g.x), o[dt][4 * a + 1] * inv * bfhi(g.x), o[dt][4 * a + 2] * inv * bflo(g.y),
                 o[dt][4 * a + 3] * inv * bfhi(g.y));
      }
  }
}

DI void sb_attn_phase(const Params& P, char* smem) {
  AttnSmem& sm = *(AttnSmem*)smem;
  const bf16_t* Q = (const bf16_t*)(wsp(P) + OFF_R);
  const bf16_t* K = Q + (size_t)M_ * D_;
  const bf16_t* VT = K + (size_t)M_ * D_;
  bf16_t* obuf = (bf16_t*)(wsp(P) + OFF_OBUF);
  const int tid = tidx(), lane = tid & 63, wave = tid >> 6, r = lane & 31, h = lane >> 5;
  bf16x8 tdiag[2], ones;
#pragma unroll
  for (int s2 = 0; s2 < 2; ++s2)
#pragma unroll
    for (int jj = 0; jj < 8; ++jj) {
      const int kj = 16 * s2 + 8 * (jj >> 2) + 4 * h + (jj & 3);
      tdiag[s2][jj] = (kj > r) ? (short)0x3f80 : (short)0;
    }
#pragma unroll
  for (int jj = 0; jj < 8; ++jj) ones[jj] = (short)0x3f80;

  for (int it = bidx(); it < 4096; it += gridDim.x) {
    const int qt = 63 - (it >> 6), bh = it & 63;
    const int q0 = qt * 128, qw = q0 + wave * 32, query = qw + r;
    const bf16_t* Kb = K + (size_t)bh * S_ * 64;
    const bf16_t* VTb = VT + (size_t)bh * 64 * S_;
    bf16x8 qf[4];
    load_qf(Q + ((size_t)bh * S_ + query) * 64, qf);
    f32x16 o[2];
    zero16(o[0]);
    zero16(o[1]);
    float R = 0.f;
    u32x4 kr[2], vr[2];
    const int jhi = 2 * qt + 1;
    attn_load(Kb, 64, VTb, S_, jhi, kr, vr);
    for (int j = jhi; j >= 0; --j) {
      if (__syncthreads_and(R < -110.f)) break;
      attn_store(sm, kr, vr);
      __syncthreads();
      if (j > 0) attn_load(Kb, 64, VTb, S_, j - 1, kr, vr);
      if (j * 64 < qw + 31) {
        f32x16 st[2], Lv[2], lat[2];
        attn_qk(sm, qf, st);
        float tot = 0.f;
#pragma unroll
        for (int kt = 0; kt < 2; ++kt)
#pragma unroll
          for (int i = 0; i < 16; ++i) {
            const int key = j * 64 + kt * 32 + crow(i, h);
            const float z = st[kt][i] * 0.125f;
            const float sp = fmaxf(z, 0.f) + __logf(1.f + __expf(-fabsf(z)));
            const float L = (key < query) ? -sp : 0.f;
            st[kt][i] = z;
            Lv[kt][i] = L;
            tot += L;
          }
        tot += __shfl_xor(tot, 32);
        bf16x8 hi[2][2], lo[2][2];
#pragma unroll
        for (int kt = 0; kt < 2; ++kt)
#pragma unroll
          for (int s2 = 0; s2 < 2; ++s2) {
            float hv[8], lv[8];
#pragma unroll
            for (int q = 0; q < 8; ++q) {
              const float L = Lv[kt][8 * s2 + q];
              hv[q] = bf2f(f2bf(L));
              lv[q] = L - hv[q];
            }
            hi[kt][s2] = pack8(hv[0], hv[1], hv[2], hv[3], hv[4], hv[5], hv[6], hv[7]);
            lo[kt][s2] = pack8(lv[0], lv[1], lv[2], lv[3], lv[4], lv[5], lv[6], lv[7]);
          }
        zero16(lat[0]);
        zero16(lat[1]);
#pragma unroll
        for (int s2 = 0; s2 < 2; ++s2) {
          lat[0] = MFMA(tdiag[s2], hi[0][s2], lat[0]);
          lat[0] = MFMA(tdiag[s2], lo[0][s2], lat[0]);
          lat[0] = MFMA(ones, hi[1][s2], lat[0]);
          lat[0] = MFMA(ones, lo[1][s2], lat[0]);
          lat[1] = MFMA(tdiag[s2], hi[1][s2], lat[1]);
          lat[1] = MFMA(tdiag[s2], lo[1][s2], lat[1]);
        }
#pragma unroll
        for (int kt = 0; kt < 2; ++kt)
#pragma unroll
          for (int i = 0; i < 16; ++i) {
            const int key = j * 64 + kt * 32 + crow(i, h);
            const float e = st[kt][i] + Lv[kt][i] + lat[kt][i] + R;
            st[kt][i] = (key < query) ? __expf(e) : 0.f;
          }
        R += tot;
        attn_pv(sm, st, o);
      }
    }
    const int b = bh >> 4, hh = bh & 15;
    bf16_t* dst = obuf + ((size_t)b * S_ + query) * D_ + hh * 64;
#pragma unroll
    for (int dt = 0; dt < 2; ++dt)
#pragma unroll
      for (int a = 0; a < 4; ++a)
        store4bf(dst + dt * 32 + 8 * a + 4 * h, o[dt][4 * a], o[dt][4 * a + 1], o[dt][4 * a + 2], o[dt][4 * a + 3]);
  }
}

DI void nsa_compress_phase(const Params& P, char* smem) {
  bf16_t* sW = (bf16_t*)smem;
  bf16_t* sX = sW + 128 * 72;
  const bf16_t* KC = (const bf16_t*)(wsp(P) + OFF_R + 64 * MiB);
  const bf16_t* VC = (const bf16_t*)(wsp(P) + OFF_R + 112 * MiB);
  const float* cb = (const float*)(wsp(P) + OFF_CBIAS);
  const int wave = tidx() >> 6, wn = wave >> 1, wm = wave & 1;
  for (int t = bidx(); t < 64; t += gridDim.x) {
    const int isv = t >> 5, kv = (t >> 1) & 15, mt = t & 1;
    const bf16_t* Wt = (const bf16_t*)(wsp(P) + (isv ? OFF_WCV : OFF_WCK));
    const bf16_t* X = (isv ? VC : KC) + ((size_t)kv * S_ + (size_t)mt * 256 * 16) * 64;
    f32x16 acc[2][2][2];
    gemm_tile<2>(Wt, 2048, X, 1024, 2048, sW, sX, acc);
    EpiCmp epi;
    epi.cb = cb + isv * 64;
    epi.gk = inp(P, 19);
    epi.isv = isv;
    epi.dst = isv ? (bf16_t*)(wsp(P) + OFF_VCMPT) + (size_t)kv * 64 * 512 : (bf16_t*)(wsp(P) + OFF_KCMP) + (size_t)kv * 512 * 64;
    epi(acc[0], wn * 64, mt * 256 + wm * 128);
    epi(acc[1], wn * 64, mt * 256 + wm * 128 + 64);
  }
}

struct CmpSmem {
  AttnSmem a;
  float imp[32 * 132];
};

DI void nsa_cmp_phase(const Params& P, char* smem) {
  CmpSmem& sm = *(CmpSmem*)smem;
  const bf16_t* Q = (const bf16_t*)(wsp(P) + OFF_R);
  const bf16_t* KCMP = (const bf16_t*)(wsp(P) + OFF_KCMP);
  const bf16_t* VCMPT = (const bf16_t*)(wsp(P) + OFF_VCMPT);
  const float* gates = (const float*)(wsp(P) + OFF_GATES);
  bf16_t* obuf = (bf16_t*)(wsp(P) + OFF_OBUF);
  u32x4* sel = (u32x4*)(wsp(P) + OFF_SEL);
  const int tid = tidx(), lane = tid & 63, wave = tid >> 6, r = lane & 31, h = lane >> 5;
  for (int it = bidx(); it < 4096; it += gridDim.x) {
    const int tt = 255 - (it >> 4), kv = it & 15, b = kv >> 2, g = kv & 3;
    const int t0 = tt * 32, head = g * 4 + wave, query = t0 + r;
    const bf16_t* Kb = KCMP + (size_t)kv * 512 * 64;
    const bf16_t* VTb = VCMPT + (size_t)kv * 64 * 512;
    bf16x8 qf[4];
    load_qf(Q + ((size_t)(b * 16 + head) * S_ + query) * 64, qf);
    const int ntiles = ((t0 >> 4) >> 6) + 1;
    __syncthreads();
    for (int e = tid; e < 32 * 132; e += 256) sm.imp[e] = 0.f;
    float m_run = -1e30f, l_run = 0.f;
    u32x4 kr[2], vr[2];
    for (int jt = 0; jt < ntiles; ++jt) {
      attn_load(Kb, 64, VTb, 512, jt, kr, vr);
      __syncthreads();
      attn_store(sm.a, kr, vr);
      __syncthreads();
      f32x16 st[2];
      attn_qk(sm.a, qf, st);
      float mx = -1e30f;
#pragma unroll
      for (int kt = 0; kt < 2; ++kt)
#pragma unroll
        for (int i = 0; i < 16; ++i) {
          const int n = jt * 64 + kt * 32 + crow(i, h);
          const float s = (16 * n + 31 <= query) ? st[kt][i] * 0.125f : -1e30f;
          st[kt][i] = s;
          mx = fmaxf(mx, s);
        }
      mx = fmaxf(mx, __shfl_xor(mx, 32));
      const float m_new = fmaxf(m_run, mx);
      float ps = 0.f;
#pragma unroll
      for (int kt = 0; kt < 2; ++kt)
#pragma unroll
        for (int i = 0; i < 16; ++i) ps += (st[kt][i] > -1e29f) ? __expf(st[kt][i] - m_new) : 0.f;
      ps += __shfl_xor(ps, 32);
      l_run = l_run * __expf(m_run - m_new) + ps;
      m_run = m_new;
    }
    const float linv = l_run > 0.f ? 1.f / l_run : 0.f;
    f32x16 o[2];
    zero16(o[0]);
    zero16(o[1]);
    for (int jt = 0; jt < ntiles; ++jt) {
      attn_load(Kb, 64, VTb, 512, jt, kr, vr);
      __syncthreads();
      attn_store(sm.a, kr, vr);
      __syncthreads();
      f32x16 st[2];
      attn_qk(sm.a, qf, st);
#pragma unroll
      for (int kt = 0; kt < 2; ++kt)
#pragma unroll
        for (int i = 0; i < 16; ++i) {
          const int n = jt * 64 + kt * 32 + crow(i, h);
          st[kt][i] = (16 * n + 31 <= query) ? __expf(st[kt][i] * 0.125f - m_run) * linv : 0.f;
        }
      attn_pv(sm.a, st, o);
      for (int w = 0; w < 4; ++w) {
        if (wave == w) {
          float* ip = sm.imp + r * 132 + jt * 16 + h;
#pragma unroll
          for (int kt = 0; kt < 2; ++kt)
#pragma unroll
            for (int a = 0; a < 4; ++a) {
              const float G = st[kt][4 * a] + st[kt][4 * a + 1] + st[kt][4 * a + 2] + st[kt][4 * a + 3];
              const float x = __shfl_xor(st[kt][4 * a + 3], 32);
              ip[kt * 8 + 2 * a] += G + (h ? x : 0.f);
              if (!h) ip[kt * 8 + 2 * a + 2] += x;
            }
        }
        __syncthreads();
      }
    }
    {
      const size_t m = (size_t)b * S_ + query;
      float gc = gates[m * 48 + head * 3 + 0];
#if ABL == 3
      gc = 0.f;
#endif
      bf16_t* dst = obuf + m * D_ + head * 64;
#pragma unroll
      for (int dt = 0; dt < 2; ++dt)
#pragma unroll
        for (int a = 0; a < 4; ++a)
          store4bf(dst + dt * 32 + 8 * a + 4 * h, o[dt][4 * a] * gc, o[dt][4 * a + 1] * gc, o[dt][4 * a + 2] * gc,
                   o[dt][4 * a + 3] * gc);
    }
    for (int tk = 0; tk < 8; ++tk) {
      const int tl = wave * 8 + tk, t = t0 + tl, cur = t >> 6;
      const float* ip = sm.imp + tl * 132;
      const int j0 = lane, j1 = lane + 64;
      const bool f0 = (j0 == 0) || (j0 == cur) || (j0 == cur - 1);
      const bool f1 = (j1 == cur) || (j1 == cur - 1);
      const float v0 = f0 ? 1e9f : (j0 <= cur ? ip[j0] : -1.f);
      const float v1 = f1 ? 1e9f : (j1 <= cur ? ip[j1] : -1.f);
      int r0 = 0, r1 = 0;
      for (int jp = 0; jp <= cur; ++jp) {
        const bool fp = (jp == 0) || (jp == cur) || (jp == cur - 1);
        const float vp = fp ? 1e9f : ip[jp];
        r0 += (vp > v0 || (vp == v0 && jp < j0)) ? 1 : 0;
        r1 += (vp > v1 || (vp == v1 && jp < j1)) ? 1 : 0;
      }
      const unsigned long long m0 = __ballot(j0 <= cur && r0 < 16);
      const unsigned long long m1 = __ballot(j1 <= cur && r1 < 16);
      if (lane == 0) {
        u32x4 w;
        w.x = (unsigned)m0;
        w.y = (unsigned)(m0 >> 32);
        w.z = (unsigned)m1;
        w.w = (unsigned)(m1 >> 32);
        sel[(size_t)kv * S_ + t] = w;
      }
    }
  }
}

DI void nsa_attn_phase(const Params& P, char* smem, int rep) {
  AttnSmem& sm = *(AttnSmem*)smem;
  char* R = wsp(P) + OFF_R;
  const bf16_t* Q = (const bf16_t*)R;
  const bf16_t* KS = (const bf16_t*)(R + 80 * MiB);
  const bf16_t* KW = (const bf16_t*)(R + 96 * MiB);
  const bf16_t* VST = (const bf16_t*)(R + 128 * MiB);
  const bf16_t* VWT = (const bf16_t*)(R + 144 * MiB);
  const float* gates = (const float*)(wsp(P) + OFF_GATES);
  const u32x4* sel = (const u32x4*)(wsp(P) + OFF_SEL);
  bf16_t* obuf = (bf16_t*)(wsp(P) + OFF_OBUF);
  const int lane = tidx() & 63, wave = tidx() >> 6, r = lane & 31, h = lane >> 5;
  for (int it = bidx(); it < 4096; it += gridDim.x) {
    const int qt = 63 - (it >> 6), bh = it & 63, b = bh >> 4, head = bh & 15, kv = b * 4 + (head >> 2);
    const int q0 = qt * 128, qw = q0 + wave * 32, query = qw + r;
    bf16x8 qf[4];
    load_qf(Q + ((size_t)bh * S_ + query) * 64, qf);
    const u32x4 selw = sel[(size_t)kv * S_ + query];
    const size_t m = (size_t)b * S_ + query;
    float gs = gates[m * 48 + head * 3 + 1], gw = gates[m * 48 + head * 3 + 2];
    if (rep) { gs = 0.f; gw = 0.f; }
#if ABL == 1
    gs = 0.f;
#elif ABL == 2
    gw = 0.f;
#endif
    f32x16 o[2], ow[2];
    float l;
    const int jlo = (q0 > 511 ? q0 - 511 : 0) >> 6;
    flash_pass<1>(KW + (size_t)kv * S_ * 64, VWT + (size_t)kv * 64 * S_, nullptr, 0.f, selw, qw, jlo, 2 * qt + 1, qf, o, l, sm);
    {
      const float sc = gw / l;
#pragma unroll
      for (int dt = 0; dt < 2; ++dt)
#pragma unroll
        for (int i = 0; i < 16; ++i) ow[dt][i] = o[dt][i] * sc;
    }
    flash_pass<2>(KS + (size_t)kv * S_ * 64, VST + (size_t)kv * 64 * S_, nullptr, 0.f, selw, qw, 0, 2 * qt + 1, qf, o, l, sm);
    const float sc = gs / l;
    bf16_t* dst = obuf + m * D_ + head * 64;
#pragma unroll
    for (int dt = 0; dt < 2; ++dt)
#pragma unroll
      for (int a = 0; a < 4; ++a) {
        bf16_t* p = dst + dt * 32 + 8 * a + 4 * h;
        u32x2 g = *(const u32x2*)p;
        store4bf(p, ow[dt][4 * a] + o[dt][4 * a] * sc + bflo(g.x), ow[dt][4 * a + 1] + o[dt][4 * a + 1] * sc + bfhi(g.x),
                 ow[dt][4 * a + 2] + o[dt][4 * a + 2] * sc + bflo(g.y), ow[dt][4 * a + 3] + o[dt][4 * a + 3] * sc + bfhi(g.y));
      }
  }
}

struct GlaSmem {
  float glow[64 * 16];
  float tot[2 * 128];
  float ssq[2 * 64];
  bf16_t q[64 * 136];
  bf16_t ki[64 * 136];
  bf16_t a[64 * 72];
};

DI void gla_compute_b(const Params& P, GlaSmem& sm, int b, int hg, int t0, float (&bv)[32], float& blast) {
  const int tid = tidx(), d = tid & 127, half = tid >> 7;
  const float* glow = (const float*)(wsp(P) + OFF_GLOW) + ((size_t)b * S_ + t0) * 16;
  __syncthreads();
  for (int e = tid; e < 1024; e += 256) sm.glow[e] = glow[e];
  const int col = hg * 128 + d;
  float w[16];
#pragma unroll
  for (int q = 0; q < 16; ++q) w[q] = inp(P, 22)[q * 512 + col];
  const float bias = inp(P, 23)[col];
  __syncthreads();
  float run = 0.f;
#pragma unroll
  for (int cc = 0; cc < 32; ++cc) {
    const float* gl = sm.glow + (half * 32 + cc) * 16;
    float z = 0.f;
#pragma unroll
    for (int q = 0; q < 16; ++q) z += gl[q] * w[q];
    z += bias;
    run += logsigmoidf_(z) * (1.f / 16.f);
    bv[cc] = run;
    if ((cc & 3) == 3) __builtin_amdgcn_sched_barrier(0);
  }
  sm.tot[half * 128 + d] = run;
  __syncthreads();
  const float t0v = sm.tot[d], t1v = sm.tot[128 + d];
  if (half) {
#pragma unroll
    for (int cc = 0; cc < 32; ++cc) bv[cc] += t0v;
  }
  blast = t0v + t1v;
}

DI void gla_u_phase(const Params& P, char* smem) {
  GlaSmem& sm = *(GlaSmem*)smem;
  char* R = wsp(P) + OFF_R;
  const bf16_t* KG = (const bf16_t*)(R + 32 * MiB);
  const bf16_t* VTG = (const bf16_t*)(R + 64 * MiB);
  bf16_t* UT = (bf16_t*)(R + 128 * MiB);
  float* decay = (float*)(wsp(P) + OFF_DECAY);
  bf16_t* sKT = sm.q;
  const int tid = tidx(), lane = tid & 63, wave = tid >> 6, r = lane & 31, h = lane >> 5;
  const int d = tid & 127, half = tid >> 7;
  for (int it = bidx(); it < 2048; it += gridDim.x) {
    const int n = it & 127, bhg = it >> 7, b = bhg >> 2, hg = bhg & 3, t0 = n * 64;
    float bv[32], blast;
    gla_compute_b(P, sm, b, hg, t0, bv, blast);
#pragma unroll
    for (int cc = 0; cc < 32; ++cc) {
      const int c = half * 32 + cc;
      const float k = bf2f(KG[((size_t)b * S_ + t0 + c) * 512 + hg * 128 + d]);
      sKT[d * 72 + c] = f2bf(k * __expf(blast - bv[cc]));
      if ((cc & 7) == 7) __builtin_amdgcn_sched_barrier(0);
    }
    if (half == 0) decay[(size_t)it * 128 + d] = __expf(blast);
    __syncthreads();
#pragma unroll 1
    for (int m2 = 0; m2 < 2; ++m2) {
      const int e0 = (2 * wave + m2) * 32;
      f32x16 acc[4];
#pragma unroll
      for (int q = 0; q < 4; ++q) zero16(acc[q]);
      const bf16_t* vrow = VTG + ((size_t)b * 1024 + hg * 256 + e0 + r) * S_ + t0;
#pragma unroll
      for (int kk = 0; kk < 4; ++kk) {
        bf16x8 a = *(const bf16x8*)(vrow + kk * 16 + h * 8);
#pragma unroll
        for (int nt = 0; nt < 4; ++nt) {
          bf16x8 bb = *(const bf16x8*)(sKT + (nt * 32 + r) * 72 + kk * 16 + h * 8);
          acc[nt] = MFMA(a, bb, acc[nt]);
        }
        __builtin_amdgcn_sched_barrier(0);
      }
      bf16_t* ub = UT + ((size_t)it * 256 + e0 + 4 * h) * 128 + r;
#pragma unroll
      for (int nt = 0; nt < 4; ++nt) {
#pragma unroll
        for (int i = 0; i < 16; ++i) ub[((i & 3) + 8 * (i >> 2)) * 128 + nt * 32] = f2bf(acc[nt][i]);
        __builtin_amdgcn_sched_barrier(0);
      }
    }
  }
}

DI void gla_scan_phase(const Params& P, int rep) {
  bf16_t* UT = (bf16_t*)(wsp(P) + OFF_R + 128 * MiB);
  const float* decay = (const float*)(wsp(P) + OFF_DECAY);
  for (int gid = bidx() * 256 + tidx(); gid < 16 * 256 * 128; gid += gridDim.x * 256) {
    const int bhg = gid >> 15, e = (gid >> 7) & 255, d = gid & 127;
    float state = 0.f;
    for (int n0 = 0; n0 < 128; n0 += 8) {
      float u[8], dc[8];
#pragma unroll
      for (int q = 0; q < 8; ++q) {
        const size_t it = (size_t)bhg * 128 + n0 + q;
        u[q] = bf2f(UT[(it * 256 + e) * 128 + d]);
        dc[q] = decay[it * 128 + d];
      }
#pragma unroll
      for (int q = 0; q < 8; ++q) {
        const size_t it = (size_t)bhg * 128 + n0 + q;
        UT[(it * 256 + e) * 128 + d] = rep ? f2bf(u[q]) : f2bf(state);
        state = dc[q] * state + u[q];
      }
    }
  }
}

DI void gla_out_phase(const Params& P, char* smem, int rep) {
  GlaSmem& sm = *(GlaSmem*)smem;
  char* R = wsp(P) + OFF_R;
  const bf16_t* QG = (const bf16_t*)R;
  const bf16_t* KG = (const bf16_t*)(R + 32 * MiB);
  const bf16_t* VTG = (const bf16_t*)(R + 64 * MiB);
  const bf16_t* UT = (const bf16_t*)(R + 128 * MiB);
  bf16_t* obuf = (bf16_t*)(wsp(P) + OFF_OBUF);
  const float* gout = inp(P, 24);
  const int tid = tidx(), lane = tid & 63, wave = tid >> 6, r = lane & 31, h = lane >> 5;
  const int d = tid & 127, half = tid >> 7;
  for (int it = bidx(); it < 2048; it += gridDim.x) {
    const int n = it & 127, bhg = it >> 7, b = bhg >> 2, hg = bhg & 3, t0 = n * 64;
    float bv[32], blast;
    gla_compute_b(P, sm, b, hg, t0, bv, blast);
#pragma unroll
    for (int cc = 0; cc < 32; ++cc) {
      const int c = half * 32 + cc;
      const size_t off = ((size_t)b * S_ + t0 + c) * 512 + hg * 128 + d;
      const float q = bf2f(QG[off]), k = bf2f(KG[off]);
      sm.q[c * 136 + d] = f2bf(q * 0.08838834764831845f * __expf(bv[cc]));
      sm.ki[c * 136 + d] = f2bf(k * __expf(-bv[cc]));
      if ((cc & 3) == 3) __builtin_amdgcn_sched_barrier(0);
    }
    __syncthreads();
    {
      const int ct = wave >> 1, stt = wave & 1;
      f32x16 acc;
      zero16(acc);
      if (stt <= ct) {
#pragma unroll
        for (int kk = 0; kk < 8; ++kk) {
          bf16x8 a = *(const bf16x8*)(sm.q + (ct * 32 + r) * 136 + kk * 16 + h * 8);
          bf16x8 bb = *(const bf16x8*)(sm.ki + (stt * 32 + r) * 136 + kk * 16 + h * 8);
          acc = MFMA(a, bb, acc);
        }
      }
#pragma unroll
      for (int i = 0; i < 16; ++i) {
        const int c = ct * 32 + crow(i, h), s = stt * 32 + r;
        sm.a[c * 72 + s] = f2bf(s <= c ? acc[i] : 0.f);
      }
    }
    __syncthreads();
    const int ctok = wave & 1, eh = wave >> 1;
    f32x16 acc[4];
#pragma unroll
    for (int q = 0; q < 4; ++q) zero16(acc[q]);
#pragma unroll
    for (int kk = 0; kk < 4; ++kk) {
      bf16x8 bb = *(const bf16x8*)(sm.a + (ctok * 32 + r) * 72 + kk * 16 + h * 8);
#pragma unroll
      for (int mt = 0; mt < 4; ++mt) {
        bf16x8 a = *(const bf16x8*)(VTG + ((size_t)b * 1024 + hg * 256 + eh * 128 + mt * 32 + r) * S_ + t0 + kk * 16 + h * 8);
        acc[mt] = MFMA(a, bb, acc[mt]);
      }
      if (kk & 1) __builtin_amdgcn_sched_barrier(0);
    }
#pragma unroll
    for (int kk = 0; kk < 8; ++kk) {
      bf16x8 bb = *(const bf16x8*)(sm.q + (ctok * 32 + r) * 136 + kk * 16 + h * 8);
#pragma unroll
      for (int mt = 0; mt < 4; ++mt) {
        bf16x8 a = *(const bf16x8*)(UT + ((size_t)it * 256 + eh * 128 + mt * 32 + r) * 128 + kk * 16 + h * 8);
        acc[mt] = MFMA(a, bb, acc[mt]);
      }
      if (kk & 1) __builtin_amdgcn_sched_barrier(0);
    }
    float ss = 0.f;
#pragma unroll
    for (int mt = 0; mt < 4; ++mt)
#pragma unroll
      for (int i = 0; i < 16; ++i) ss += acc[mt][i] * acc[mt][i];
    ss += __shfl_xor(ss, 32);
    if (h == 0) sm.ssq[eh * 64 + ctok * 32 + r] = ss;
    __syncthreads();
    const float tot = sm.ssq[ctok * 32 + r] + sm.ssq[64 + ctok * 32 + r];
    const float rinv = rsqrtf(tot * (1.f / 256.f) + 1e-6f);
    bf16_t* dst = obuf + ((size_t)b * S_ + t0 + ctok * 32 + r) * D_ + hg * 256 + eh * 128;
#pragma unroll
    for (int mt = 0; mt < 4; ++mt)
#pragma unroll
      for (int a = 0; a < 4; ++a) {
        const int el = mt * 32 + 8 * a + 4 * h;
        const float* gp = gout + eh * 128 + el;
        bf16_t* p = dst + el;
        u32x2 g = *(const u32x2*)p;
        if (rep) *(u32x2*)p = g;
        else
        store4bf(p, acc[mt][4 * a] * rinv * gp[0] * bflo(g.x), acc[mt][4 * a + 1] * rinv * gp[1] * bfhi(g.x),
                 acc[mt][4 * a + 2] * rinv * gp[2] * bflo(g.y), acc[mt][4 * a + 3] * rinv * gp[3] * bfhi(g.y));
      }
  }
}

#define XB_TMO 128
#define XB_XCNT(j) (256 + 64 * (j))
#define XB_XSUB(j) (1280 + 64 * (j))
#define XB_XGEN(j) (2304 + 64 * (j))
#define XB_TOP 3328
#define XB_TOPGEN 3392
#define XCD_BAR_WORDS 3456
#define XB_SPIN_CAP (1u << 21)
#define LAS __attribute__((address_space(3)))
DI unsigned xb_ld(unsigned* p) { return __hip_atomic_load(p, __ATOMIC_RELAXED, __HIP_MEMORY_SCOPE_AGENT); }
DI unsigned xb_add(unsigned* p, unsigned v) { return __hip_atomic_fetch_add(p, v, __ATOMIC_RELAXED, __HIP_MEMORY_SCOPE_AGENT); }
DI unsigned xb_xcc_id() { return (unsigned)__builtin_amdgcn_s_getreg((3 << 11) | 20) & 0xFu; }
#define XB_SPIN(cond, bar)                                           \
  do {                                                               \
    unsigned _sp = 0;                                                \
    while (cond) {                                                   \
      __builtin_amdgcn_s_sleep(1);                                   \
      if ((++_sp & 255u) == 0u) {                                    \
        if (xb_ld(&(bar)[XB_TMO])) break;                            \
        if (_sp > XB_SPIN_CAP) {                                     \
          atomicAdd(&(bar)[XB_TMO], 1u);                             \
          break;                                                     \
        }                                                            \
      }                                                              \
    }                                                                \
  } while (0)
struct XcdBarrier {
  unsigned* bar;
  unsigned x;
  volatile LAS unsigned* st;
};
DI XcdBarrier xcd_barrier_post(unsigned* bar, volatile LAS unsigned* st) {
  XcdBarrier b;
  b.bar = bar;
  b.x = xb_xcc_id();
  b.st = st;
  if (threadIdx.x == 0) (void)xb_add(&bar[XB_XCNT(b.x)], 1u);
  return b;
}
DI void xcd_barrier_complete(unsigned* bar, unsigned x, unsigned& nloc, unsigned& nx) {
  const unsigned G = gridDim.x * gridDim.y * gridDim.z;
  unsigned sum, cnt, mine, sp = 0u;
  for (;;) {
    sum = 0u;
    cnt = 0u;
    mine = 0u;
#pragma unroll
    for (unsigned j = 0; j < 16; ++j) {
      const unsigned c = xb_ld(&bar[XB_XCNT(j)]);
      sum += c;
      cnt += (c > 0u) ? 1u : 0u;
      mine = (j == x) ? c : mine;
    }
    if (sum == G) break;
    __builtin_amdgcn_s_sleep(1);
    if ((++sp & 255u) == 0u) {
      if (xb_ld(&bar[XB_TMO])) break;
      if (sp > XB_SPIN_CAP) {
        atomicAdd(&bar[XB_TMO], 1u);
        break;
      }
    }
  }
  nloc = mine > 0u ? mine : 1u;
  nx = cnt > 0u ? cnt : 1u;
}
DI void xcd_barrier(const XcdBarrier& b) {
  asm volatile("s_waitcnt vmcnt(0)" ::: "memory");
  __syncthreads();
  if (threadIdx.x == 0) {
    unsigned* bar = b.bar;
    __builtin_amdgcn_s_waitcnt(0);
    unsigned nloc = b.st[0], nx = b.st[1];
    if (nloc == 0u) {
      xcd_barrier_complete(bar, b.x, nloc, nx);
      b.st[0] = nloc;
      b.st[1] = nx;
    }
    const unsigned old = xb_add(&bar[XB_XSUB(b.x)], 1u);
    const unsigned gen = old / nloc;
    if (old + 1u == (gen + 1u) * nloc) {
      __builtin_amdgcn_fence(__ATOMIC_RELEASE, "agent");
      asm volatile("s_waitcnt vmcnt(0)" ::: "memory");
      const unsigned og = xb_add(&bar[XB_TOP], 1u);
      const unsigned tg = og / nx;
      if (og + 1u == (tg + 1u) * nx) xb_add(&bar[XB_TOPGEN], 1u);
      else XB_SPIN(xb_ld(&bar[XB_TOPGEN]) == tg, bar);
      __builtin_amdgcn_fence(__ATOMIC_ACQUIRE, "agent");
      xb_add(&bar[XB_XGEN(b.x)], 1u);
      asm volatile("s_waitcnt vmcnt(0)" ::: "memory");
    } else {
      XB_SPIN(xb_ld(&bar[XB_XGEN(b.x)]) == gen, bar);
      __builtin_amdgcn_fence(__ATOMIC_ACQUIRE, "agent");
      asm volatile("s_waitcnt vmcnt(0)" ::: "memory");
    }
  }
  __syncthreads();
}

DI void run_phase(const Params& P, int ph, char* smem, int rep) {
  char* ws = wsp(P);
  float* ssq = (float*)(ws + OFF_SSQ);
  bf16_t* xb = (bf16_t*)(ws + OFF_XB);
  bf16_t* obuf = (bf16_t*)(ws + OFF_OBUF);
  bf16_t* act = (bf16_t*)(ws + OFF_R);
  if (ph == 0) {
    init_phase(P);
    prep_layer(P, 0, smem);
    return;
  }
  int L, lp;
  if (ph <= 8) { L = 0; lp = ph - 1; }
  else if (ph <= 18) { L = 1; lp = ph - 10; }
  else if (ph <= 28) { L = 2; lp = ph - 20; }
  else { L = 3; lp = ph - 30; }
  if (lp < 0) {
    prep_layer(P, L, smem);
    return;
  }
  const int nmix = (L == 0) ? 2 : (L == 1 ? 3 : (L == 2 ? 3 : 1));
  const float* s0 = ssq + (size_t)(3 * L) * M_ * 16;
  const float* s1 = s0 + (size_t)M_ * 16;
  const float* s2 = s1 + (size_t)M_ * 16;
  if (lp == 0 || lp == 4 + nmix) {
    const bool f2 = lp != 0;
    EpiFfn1 e;
    e.ssq = f2 ? s2 : s0;
    e.act = act;
    gemm_phase<2>((const bf16_t*)(ws + (f2 ? OFF_W2 : OFF_W1)), 2 * F_, xb, D_, D_, smem, e);
  } else if (lp == 1 || lp == 5 + nmix) {
    const bool f2 = lp != 1;
    EpiResid e;
    e.xin = (L == 0 && !f2 && !rep) ? inp(P, 0) : outp(P);
    e.xout = outp(P);
    e.xb = xb;
    e.ssqn = ssq + (size_t)(3 * L + (f2 ? 3 : 1)) * M_ * 16;
    e.scale = rep ? 0.f : 0.5f;
    gemm_phase<2>((const bf16_t*)(ws + (f2 ? OFF_W2D : OFF_W1D)), D_, act, F_, F_, smem, e);
  } else if (lp == 3 + nmix) {
    EpiResid e;
    e.xin = outp(P);
    e.xout = outp(P);
    e.xb = xb;
    e.ssqn = ssq + (size_t)(3 * L + 2) * M_ * 16;
    e.scale = rep ? 0.f : 1.f;
    gemm_phase<2>((const bf16_t*)(ws + OFF_WMO), D_, obuf, D_, D_, smem, e);
  } else if (lp == 2) {
    const bf16_t* wmi = (const bf16_t*)(ws + OFF_WMI);
    char* R = ws + OFF_R;
    if (L == 0 || L == 3) {
      EpiQKV e;
      e.ssq = s1;
      e.gq = inp(P, 10);
      e.gk = inp(P, 11);
      e.bfv = inp(P, 9);
      e.Q = (bf16_t*)R;
      e.K = (bf16_t*)(R + 64 * MiB);
      e.VT = (bf16_t*)(R + 128 * MiB);
      e.obuf = obuf;
      e.flog = (float*)(ws + OFF_FLOG);
      e.fox = (L == 0);
      gemm_phase<2>(wmi, L == 0 ? 4224 : 3072, xb, D_, D_, smem, e);
    } else if (L == 1) {
      EpiNSA e;
      e.ssq = s1;
      e.gq = inp(P, 18);
      e.gk = inp(P, 19);
      e.Q = (bf16_t*)R;
      e.KC = (bf16_t*)(R + 64 * MiB);
      e.KS = (bf16_t*)(R + 80 * MiB);
      e.KW = (bf16_t*)(R + 96 * MiB);
      e.VC = (bf16_t*)(R + 112 * MiB);
      e.VST = (bf16_t*)(R + 128 * MiB);
      e.VWT = (bf16_t*)(R + 144 * MiB);
      e.gates = (float*)(ws + OFF_GATES);
      gemm_phase<1>(wmi, 2688, xb, D_, D_, smem, e);
    } else {
      EpiGLA e;
      e.ssq = s1;
      e.QG = (bf16_t*)R;
      e.KG = (bf16_t*)(R + 32 * MiB);
      e.VTG = (bf16_t*)(R + 64 * MiB);
      e.obuf = obuf;
      e.glow = (float*)(ws + OFF_GLOW);
      gemm_phase<2>(wmi, 3200, xb, D_, D_, smem, e);
    }
  } else {
    const int mp = lp - 3;
    if (L == 0) {
      if (mp == 0) {
        fox_scan_phase(P, smem);
      }
      else {
        fox_attn_phase(P, smem, rep);
      }
    } else if (L == 1) {
      if (mp == 0) nsa_compress_phase(P, smem);
      else if (mp == 1) nsa_cmp_phase(P, smem);
      else {
        nsa_attn_phase(P, smem, rep);
      }
    } else if (L == 2) {
      if (mp == 0) gla_u_phase(P, smem);
      else if (mp == 1) gla_scan_phase(P, rep);
      else gla_out_phase(P, smem, rep);
    } else {
      sb_attn_phase(P, smem);
    }
  }
}

__global__ void __launch_bounds__(256, 2) mega_kernel(Params P, int ph_lo, int ph_hi) {
  __shared__ __attribute__((aligned(16))) char smem[57344];
  __shared__ __attribute__((aligned(16))) unsigned xbw[4];
  if (threadIdx.x == 0) { xbw[0] = 0u; xbw[1] = 0u; xbw[2] = 0u; xbw[3] = 0u; }
  __syncthreads();
  XcdBarrier xb = xcd_barrier_post((unsigned*)(P.ws + OFF_XBAR), (volatile LAS unsigned*)xbw);
  for (int ph = ph_lo; ph < ph_hi; ++ph) {
    run_phase(P, ph, smem, 0);
    if (ph + 1 < ph_hi) {
      if (ph == ph_lo) {
        asm volatile("s_waitcnt vmcnt(0)" ::: "memory");
        cg::this_grid().sync();
        __builtin_amdgcn_fence(__ATOMIC_ACQUIRE, "agent");
        asm volatile("s_waitcnt vmcnt(0)" ::: "memory");
        __syncthreads();
      } else {
        xcd_barrier(xb);
      }
    }
  }
}

extern "C" void kernel_launch(void* const* d_in, const int* in_sizes, int n_in, void* d_out, int out_size, void* d_ws,
                              size_t ws_size, hipStream_t stream) {
  static int grid_blocks = 0;
  if (!grid_blocks) {
    int dev = 0, cus = 0, per_cu = 0;
    hipGetDevice(&dev);
    hipDeviceGetAttribute(&cus, hipDeviceAttributeMultiprocessorCount, dev);
    hipOccupancyMaxActiveBlocksPerMultiprocessor(&per_cu, mega_kernel, 256, 0);
    if (per_cu > 2) per_cu = 2;
    if (per_cu < 1) per_cu = 1;
    grid_blocks = cus * per_cu;
  }
  Params p{};
  for (int i = 0; i < 28; ++i) p.in[i] = (const float*)d_in[i];
  p.out = (float*)d_out;
  p.ws = (char*)d_ws;
  hipMemsetAsync((char*)d_ws + OFF_XBAR, 0, XCD_BAR_WORDS * sizeof(unsigned), stream);
#if ONE_LAUNCH
  int lo = 0, hi = NPH_RUN;
  void* args[] = {&p, &lo, &hi};
  hipError_t e = hipLaunchCooperativeKernel((void*)mega_kernel, dim3(grid_blocks), dim3(256), args, 0, stream);
  if (e != hipSuccess) fprintf(stderr, "cooperative launch failed: %s (grid %d)\n", hipGetErrorString(e), grid_blocks);
#else
  for (int ph = 0; ph < NPH_RUN; ++ph) mega_kernel<<<grid_blocks, 256, 0, stream>>>(p, ph, ph + 1);
#endif
}
```

```cpp
#include <hip/hip_runtime.h>
#include <hip/hip_cooperative_groups.h>
#include <cstdio>
namespace cg = cooperative_groups;

#ifndef ONE_LAUNCH
#define ONE_LAUNCH 1
#endif

#define ABL 0
#ifndef NPH_RUN
#define NPH_RUN 37
#endif
#define DI __device__ __forceinline__
typedef unsigned short bf16_t;
typedef __attribute__((ext_vector_type(8))) short bf16x8;
typedef __attribute__((ext_vector_type(4))) short bf16x4;
typedef __attribute__((ext_vector_type(16))) float f32x16;
typedef __attribute__((ext_vector_type(2))) __bf16 bf2_t;
typedef __attribute__((ext_vector_type(4))) unsigned u32x4;
typedef __attribute__((ext_vector_type(2))) unsigned u32x2;
typedef __attribute__((ext_vector_type(4))) float f32x4;
DI int tidx() { int t = threadIdx.x; asm volatile("" : "+v"(t)); return t; }
DI int bidx() { int t = blockIdx.x; asm volatile("" : "+s"(t)); return t; }

#define MFMA(a, b, c) __builtin_amdgcn_mfma_f32_32x32x16_bf16((a), (b), (c), 0, 0, 0)

constexpr int S_ = 8192;
constexpr int M_ = 32768;
constexpr int D_ = 1024;
constexpr int F_ = 2816;
constexpr int NPH = 37;
constexpr size_t MiB = 1048576;
constexpr size_t OFF_W1 = 0, OFF_W1D = 11 * MiB, OFF_W2 = 17 * MiB, OFF_W2D = 28 * MiB, OFF_WMI = 34 * MiB,
                 OFF_WMO = 43 * MiB, OFF_WCK = 45 * MiB, OFF_WCV = 46 * MiB;
constexpr size_t OFF_XB = 48 * MiB, OFF_OBUF = 112 * MiB, OFF_SSQ = 460 * MiB, OFF_FLOG = 178 * MiB, OFF_C = 180 * MiB,
                 OFF_GATES = 182 * MiB, OFF_SEL = 188 * MiB, OFF_GLOW = 190 * MiB, OFF_DECAY = 192 * MiB,
                 OFF_KCMP = 193 * MiB, OFF_VCMPT = 194 * MiB, OFF_CBIAS = 195 * MiB, OFF_XBAR = 196 * MiB, OFF_R = 200 * MiB;

struct Params {
  const float* in[28];
  float* out;
  char* ws;
};

#define GAS __attribute__((address_space(1)))
DI const float* inp(const Params& P, int k) {
  asm volatile("" : "+s"(k));
  GAS const float* p = (GAS const float*)P.in[k];
  asm volatile("" : "+s"(p));
  return (const float*)p;
}
DI char* wsp(const Params& P) {
  GAS char* w = (GAS char*)P.ws;
  asm volatile("" : "+s"(w));
  return (char*)w;
}
DI float* outp(const Params& P) {
  GAS float* w = (GAS float*)P.out;
  asm volatile("" : "+s"(w));
  return (float*)w;
}
DI unsigned pack2(float a, float b) {
  bf2_t v;
  v[0] = (__bf16)a;
  v[1] = (__bf16)b;
  return __builtin_bit_cast(unsigned, v);
}
DI bf16_t f2bf(float a) { return (bf16_t)(pack2(a, 0.f) & 0xffffu); }
DI float bf2f(bf16_t v) { return __uint_as_float(((unsigned)v) << 16); }
DI float bflo(unsigned u) { return __uint_as_float(u << 16); }
DI float bfhi(unsigned u) { return __uint_as_float(u & 0xffff0000u); }
DI int crow(int i, int h) { return (i & 3) + 8 * (i >> 2) + 4 * h; }
DI float sigmoidf_(float x) { return __builtin_amdgcn_rcpf(1.f + __expf(-x)); }
DI float logsigmoidf_(float z) { return fminf(z, 0.f) - log1pf(__expf(-fabsf(z))); }
DI float row_rstd(const float* ssq, int m) {
  const f32x4* p = (const f32x4*)(ssq + (size_t)m * 16);
  f32x4 a = p[0], b = p[1], c = p[2], d = p[3];
  float s = a.x;
  s += a.y; s += a.z; s += a.w;
  s += b.x; s += b.y; s += b.z; s += b.w;
  s += c.x; s += c.y; s += c.z; s += c.w;
  s += d.x; s += d.y; s += d.z; s += d.w;
  return rsqrtf(s * (1.f / 1024.f) + 1e-6f);
}
DI void store4bf(bf16_t* p, float a, float b, float c, float d) {
  u32x2 u;
  u.x = pack2(a, b);
  u.y = pack2(c, d);
  *(u32x2*)p = u;
}
DI bf16x8 pack8(float a0, float a1, float a2, float a3, float a4, float a5, float a6, float a7) {
  u32x4 u;
  u.x = pack2(a0, a1);
  u.y = pack2(a2, a3);
  u.z = pack2(a4, a5);
  u.w = pack2(a6, a7);
  return __builtin_bit_cast(bf16x8, u);
}
DI bf16x8 cat4(bf16x4 lo, bf16x4 hi) { return __builtin_shufflevector(lo, hi, 0, 1, 2, 3, 4, 5, 6, 7); }
DI void zero16(f32x16& v) {
#pragma unroll
  for (int i = 0; i < 16; ++i) v[i] = 0.f;
}

template <int MH>
DI void gemm_tile(const bf16_t* Wg, int ldw, const bf16_t* Xg, int ldx, int K, bf16_t* sW, bf16_t* sX,
                  f32x16 (&acc)[MH][2][2]) {
  const int tid = tidx(), lane = tid & 63, wave = tid >> 6, wn = wave >> 1, wm = wave & 1, r = lane & 31,
            h = lane >> 5;
#pragma unroll
  for (int a = 0; a < MH; ++a)
#pragma unroll
    for (int b = 0; b < 2; ++b)
#pragma unroll
      for (int c = 0; c < 2; ++c) zero16(acc[a][b][c]);
  u32x4 rw[4], rx[4 * MH];
  const int nk = K >> 6;
  const int row0 = tid >> 3, cc = tid & 7;
  const bf16_t* wp = Wg + (size_t)row0 * ldw + cc * 8;
  const bf16_t* xp = Xg + (size_t)row0 * ldx + cc * 8;
#pragma unroll
  for (int i = 0; i < 4; ++i) rw[i] = *(const u32x4*)(wp + (size_t)(32 * i) * ldw);
#pragma unroll
  for (int i = 0; i < 4 * MH; ++i) rx[i] = *(const u32x4*)(xp + (size_t)(32 * i) * ldx);
  for (int kt = 0; kt < nk; ++kt) {
    __syncthreads();
#pragma unroll
    for (int i = 0; i < 4; ++i) *(u32x4*)(sW + (row0 + 32 * i) * 72 + cc * 8) = rw[i];
#pragma unroll
    for (int i = 0; i < 4 * MH; ++i) *(u32x4*)(sX + (row0 + 32 * i) * 72 + cc * 8) = rx[i];
    __syncthreads();
    if (kt + 1 < nk) {
      const int k0 = (kt + 1) * 64;
#pragma unroll
      for (int i = 0; i < 4; ++i) rw[i] = *(const u32x4*)(wp + (size_t)(32 * i) * ldw + k0);
#pragma unroll
      for (int i = 0; i < 4 * MH; ++i) rx[i] = *(const u32x4*)(xp + (size_t)(32 * i) * ldx + k0);
    }
    __builtin_amdgcn_sched_barrier(0);
#pragma unroll
    for (int kk = 0; kk < 4; ++kk) {
      bf16x8 a0 = *(const bf16x8*)(sW + (wn * 64 + r) * 72 + kk * 16 + h * 8);
      bf16x8 a1 = *(const bf16x8*)(sW + (wn * 64 + 32 + r) * 72 + kk * 16 + h * 8);
#pragma unroll
      for (int mq = 0; mq < 2 * MH; ++mq) {
        bf16x8 b = *(const bf16x8*)(sX + (wm * 64 * MH + mq * 32 + r) * 72 + kk * 16 + h * 8);
        acc[mq >> 1][0][mq & 1] = MFMA(a0, b, acc[mq >> 1][0][mq & 1]);
        acc[mq >> 1][1][mq & 1] = MFMA(a1, b, acc[mq >> 1][1][mq & 1]);
      }
    }
  }
}

template <int MH, class Epi>
DI void gemm_phase(const bf16_t* Wt, int Npad, const bf16_t* X, int ldx, int K, char* smem, const Epi& epi) {
  bf16_t* sW = (bf16_t*)smem;
  bf16_t* sX = sW + 128 * 72;
  const int NT = Npad >> 7, MT = M_ / (128 * MH);
  const int wave = tidx() >> 6, wn = wave >> 1, wm = wave & 1;
  const int nblk = gridDim.x;
  const int lb = ((nblk & 7) == 0) ? ((bidx() & 7) * (nblk >> 3) + (bidx() >> 3)) : bidx();
  for (int t = lb; t < NT * MT; t += nblk) {
    const int nt = t % NT, mt = t / NT;
    f32x16 acc[MH][2][2];
    gemm_tile<MH>(Wt + (size_t)nt * 128 * K, K, X + (size_t)mt * 128 * MH * ldx, ldx, K, sW, sX, acc);
#pragma unroll
    for (int mh = 0; mh < MH; ++mh) epi(acc[mh], nt * 128 + wn * 64, mt * 128 * MH + wm * 64 * MH + mh * 64);
  }
}

struct EpiFfn1 {
  const float* ssq;
  bf16_t* act;
  DI void operator()(f32x16 (&acc)[2][2], int nb, int mb) const {
    const int lane = tidx() & 63, r = lane & 31, h = lane >> 5;
    const int jb = (nb >> 6) * 32;
#pragma unroll
    for (int mi = 0; mi < 2; ++mi) {
      const int m = mb + mi * 32 + r;
      const float rstd = row_rstd(ssq, m);
#pragma unroll
      for (int a = 0; a < 4; ++a) {
        float v[4];
#pragma unroll
        for (int q = 0; q < 4; ++q) {
          float g = acc[0][mi][4 * a + q] * rstd, u = acc[1][mi][4 * a + q] * rstd;
          v[q] = g * sigmoidf_(g) * u;
        }
        store4bf(act + (size_t)m * F_ + jb + 8 * a + 4 * h, v[0], v[1], v[2], v[3]);
      }
    }
  }
};

struct EpiResid {
  const float* xin;
  float* xout;
  bf16_t* xb;
  float* ssqn;
  float scale;
  DI void operator()(f32x16 (&acc)[2][2], int nb, int mb) const {
    const int lane = tidx() & 63, r = lane & 31, h = lane >> 5;
#pragma unroll
    for (int mi = 0; mi < 2; ++mi) {
      const int m = mb + mi * 32 + r;
      float part = 0.f;
#pragma unroll
      for (int ni = 0; ni < 2; ++ni)
#pragma unroll
        for (int a = 0; a < 4; ++a) {
          const int n = nb + ni * 32 + 8 * a + 4 * h;
          f32x4 xi = *(const f32x4*)(xin + (size_t)m * D_ + n);
          f32x4 xo;
          xo.x = xi.x + scale * acc[ni][mi][4 * a + 0];
          xo.y = xi.y + scale * acc[ni][mi][4 * a + 1];
          xo.z = xi.z + scale * acc[ni][mi][4 * a + 2];
          xo.w = xi.w + scale * acc[ni][mi][4 * a + 3];
          *(f32x4*)(xout + (size_t)m * D_ + n) = xo;
          store4bf(xb + (size_t)m * D_ + n, xo.x, xo.y, xo.z, xo.w);
          part += xo.x * xo.x + xo.y * xo.y + xo.z * xo.z + xo.w * xo.w;
        }
      part += __shfl_xor(part, 32);
      if (h == 0) ssqn[(size_t)m * 16 + (nb >> 6)] = part;
    }
  }
};

struct EpiQKV {
  const float* ssq;
  const float* gq;
  const float* gk;
  const float* bfv;
  bf16_t* Q;
  bf16_t* K;
  bf16_t* VT;
  bf16_t* obuf;
  float* flog;
  int fox;
  DI void operator()(f32x16 (&acc)[2][2], int nb, int mb) const {
    const int lane = tidx() & 63, r = lane & 31, h = lane >> 5;
#pragma unroll
    for (int mi = 0; mi < 2; ++mi) {
      const int m = mb + mi * 32 + r, b = m >> 13, t = m & 8191;
      const float rstd = row_rstd(ssq, m);
      if (nb < 2048) {
        const int isk = nb >= 1024, hh = (nb & 1023) >> 6;
        float v[2][16];
        float ss = 0.f;
#pragma unroll
        for (int ni = 0; ni < 2; ++ni)
#pragma unroll
          for (int i = 0; i < 16; ++i) {
            v[ni][i] = acc[ni][mi][i] * rstd;
            ss += v[ni][i] * v[ni][i];
          }
        if (fox) {
          ss += __shfl_xor(ss, 32);
          const float rinv = rsqrtf(ss * (1.f / 64.f) + 1e-6f);
          const float* g = isk ? gk : gq;
#pragma unroll
          for (int ni = 0; ni < 2; ++ni)
#pragma unroll
            for (int i = 0; i < 16; ++i) v[ni][i] *= rinv * g[ni * 32 + crow(i, h)];
        }
        bf16_t* dst = (isk ? K : Q) + ((size_t)(b * 16 + hh) * S_ + t) * 64;
#pragma unroll
        for (int ni = 0; ni < 2; ++ni)
#pragma unroll
          for (int a = 0; a < 4; ++a)
            store4bf(dst + ni * 32 + 8 * a + 4 * h, v[ni][4 * a], v[ni][4 * a + 1], v[ni][4 * a + 2], v[ni][4 * a + 3]);
      } else if (nb < 3072) {
        const int hh = (nb - 2048) >> 6;
#pragma unroll
        for (int ni = 0; ni < 2; ++ni)
#pragma unroll
          for (int i = 0; i < 16; ++i) {
            const int d = ni * 32 + crow(i, h);
            VT[((size_t)(b * 16 + hh) * 64 + d) * S_ + t] = f2bf(acc[ni][mi][i] * rstd);
          }
      } else if (fox && nb < 4096) {
        const int hh = (nb - 3072) >> 6;
#pragma unroll
        for (int ni = 0; ni < 2; ++ni)
#pragma unroll
          for (int a = 0; a < 4; ++a)
            store4bf(obuf + (size_t)m * D_ + hh * 64 + ni * 32 + 8 * a + 4 * h, sigmoidf_(acc[ni][mi][4 * a] * rstd),
                     sigmoidf_(acc[ni][mi][4 * a + 1] * rstd), sigmoidf_(acc[ni][mi][4 * a + 2] * rstd),
                     sigmoidf_(acc[ni][mi][4 * a + 3] * rstd));
      } else if (fox && nb == 4096) {
#pragma unroll
        for (int i = 0; i < 8; ++i) {
          const int hh = crow(i, h);
          flog[(size_t)(b * 16 + hh) * S_ + t] = logsigmoidf_(acc[0][mi][i] * rstd + bfv[hh]);
        }
      }
    }
  }
};

struct EpiNSA {
  const float* ssq;
  const float* gq;
  const float* gk;
  bf16_t* Q;
  bf16_t* KC;
  bf16_t* KS;
  bf16_t* KW;
  bf16_t* VC;
  bf16_t* VST;
  bf16_t* VWT;
  float* gates;
  DI void operator()(f32x16 (&acc)[2][2], int nb, int mb) const {
    const int lane = tidx() & 63, r = lane & 31, h = lane >> 5;
    if (nb > 2560) return;
#pragma unroll
    for (int mi = 0; mi < 2; ++mi) {
      const int m = mb + mi * 32 + r, b = m >> 13, t = m & 8191;
      const float rstd = row_rstd(ssq, m);
      if (nb == 2560) {
#pragma unroll
        for (int ni = 0; ni < 2; ++ni)
#pragma unroll
          for (int i = 0; i < 16; ++i) {
            const int nl = ni * 32 + crow(i, h);
            if (nl < 48) gates[(size_t)m * 48 + nl] = sigmoidf_(acc[ni][mi][i] * rstd);
          }
        continue;
      }
      int seg = -1, hh;
      if (nb < 1024) {
        hh = nb >> 6;
      } else {
        seg = (nb - 1024) >> 8;
        hh = ((nb - 1024) & 255) >> 6;
      }
      const int kv = b * 4 + hh;
      if (seg == 1) {
        bf16_t* dst = VC + ((size_t)kv * S_ + t) * 64;
#pragma unroll
        for (int ni = 0; ni < 2; ++ni)
#pragma unroll
          for (int a = 0; a < 4; ++a)
            store4bf(dst + ni * 32 + 8 * a + 4 * h, acc[ni][mi][4 * a] * rstd, acc[ni][mi][4 * a + 1] * rstd,
                     acc[ni][mi][4 * a + 2] * rstd, acc[ni][mi][4 * a + 3] * rstd);
      } else if (seg == 3 || seg == 5) {
        bf16_t* dst = (seg == 3 ? VST : VWT);
#pragma unroll
        for (int ni = 0; ni < 2; ++ni)
#pragma unroll
          for (int i = 0; i < 16; ++i) {
            const int d = ni * 32 + crow(i, h);
            dst[((size_t)kv * 64 + d) * S_ + t] = f2bf(acc[ni][mi][i] * rstd);
          }
      } else {
        float v[2][16];
        float ss = 0.f;
#pragma unroll
        for (int ni = 0; ni < 2; ++ni)
#pragma unroll
          for (int i = 0; i < 16; ++i) {
            v[ni][i] = acc[ni][mi][i] * rstd;
            ss += v[ni][i] * v[ni][i];
          }
        ss += __shfl_xor(ss, 32);
        const float rinv = rsqrtf(ss * (1.f / 64.f) + 1e-6f);
        const float* g = (seg < 0) ? gq : gk;
        const float tf = (float)t;
#pragma unroll
        for (int i = 0; i < 16; ++i) {
          const int fi = crow(i, h);
          const float x1 = v[0][i] * rinv * g[fi], x2 = v[1][i] * rinv * g[32 + fi];
          const float inv = exp2f(-(float)fi * 0.41524101186092034f);
          const float ang = tf * inv;
          const float Chi = 0.15915494f, Clo = 6.4206383e-9f;
          const float p = ang * Chi;
          const float e = __builtin_fmaf(ang, Chi, -p);
          const float fr = (p - floorf(p)) + (e + ang * Clo);
          const float sn = __builtin_amdgcn_sinf(fr), cs = __builtin_amdgcn_cosf(fr);
          v[0][i] = x1 * cs - x2 * sn;
          v[1][i] = x2 * cs + x1 * sn;
          if ((i & 1) == 1) __builtin_amdgcn_sched_barrier(0);
        }
        bf16_t* dst;
        if (seg < 0)
          dst = Q + ((size_t)(b * 16 + hh) * S_ + t) * 64;
        else
          dst = (seg == 0 ? KC : (seg == 2 ? KS : KW)) + ((size_t)kv * S_ + t) * 64;
#pragma unroll
        for (int ni = 0; ni < 2; ++ni)
#pragma unroll
          for (int a = 0; a < 4; ++a)
            store4bf(dst + ni * 32 + 8 * a + 4 * h, v[ni][4 * a], v[ni][4 * a + 1], v[ni][4 * a + 2], v[ni][4 * a + 3]);
      }
    }
  }
};

struct EpiGLA {
  const float* ssq;
  bf16_t* QG;
  bf16_t* KG;
  bf16_t* VTG;
  bf16_t* obuf;
  float* glow;
  DI void operator()(f32x16 (&acc)[2][2], int nb, int mb) const {
    const int lane = tidx() & 63, r = lane & 31, h = lane >> 5;
    if (nb > 3072) return;
#pragma unroll
    for (int mi = 0; mi < 2; ++mi) {
      const int m = mb + mi * 32 + r, b = m >> 13, t = m & 8191;
      const float rstd = row_rstd(ssq, m);
      if (nb < 1024) {
        bf16_t* dst = (nb < 512 ? QG + (size_t)m * 512 + nb : KG + (size_t)m * 512 + (nb - 512));
#pragma unroll
        for (int ni = 0; ni < 2; ++ni)
#pragma unroll
          for (int a = 0; a < 4; ++a)
            store4bf(dst + ni * 32 + 8 * a + 4 * h, acc[ni][mi][4 * a] * rstd, acc[ni][mi][4 * a + 1] * rstd,
                     acc[ni][mi][4 * a + 2] * rstd, acc[ni][mi][4 * a + 3] * rstd);
      } else if (nb < 2048) {
#pragma unroll
        for (int ni = 0; ni < 2; ++ni)
#pragma unroll
          for (int i = 0; i < 16; ++i) {
            const int e = nb - 1024 + ni * 32 + crow(i, h);
            VTG[((size_t)b * 1024 + e) * S_ + t] = f2bf(acc[ni][mi][i] * rstd);
          }
      } else if (nb < 3072) {
#pragma unroll
        for (int ni = 0; ni < 2; ++ni)
#pragma unroll
          for (int a = 0; a < 4; ++a) {
            float v[4];
#pragma unroll
            for (int q = 0; q < 4; ++q) {
              float z = acc[ni][mi][4 * a + q] * rstd;
              v[q] = z * sigmoidf_(z);
            }
            store4bf(obuf + (size_t)m * D_ + (nb - 2048) + ni * 32 + 8 * a + 4 * h, v[0], v[1], v[2], v[3]);
          }
      } else {
#pragma unroll
        for (int i = 0; i < 8; ++i) glow[(size_t)m * 16 + crow(i, h)] = acc[0][mi][i] * rstd;
      }
    }
  }
};

struct EpiCmp {
  const float* cb;
  const float* gk;
  bf16_t* dst;
  int isv;
  DI void operator()(f32x16 (&acc)[2][2], int nb, int mb) const {
    const int lane = tidx() & 63, r = lane & 31, h = lane >> 5;
    if (nb != 0) return;
#pragma unroll
    for (int mi = 0; mi < 2; ++mi) {
      const int n = mb + mi * 32 + r;
      const bool ok = n < 511;
      float v[2][16];
      float ss = 0.f;
#pragma unroll
      for (int ni = 0; ni < 2; ++ni)
#pragma unroll
        for (int i = 0; i < 16; ++i) {
          v[ni][i] = ok ? acc[ni][mi][i] + cb[ni * 32 + crow(i, h)] : 0.f;
          ss += v[ni][i] * v[ni][i];
        }
      if (!isv) {
        ss += __shfl_xor(ss, 32);
        const float rinv = rsqrtf(ss * (1.f / 64.f) + 1e-6f);
#pragma unroll
        for (int ni = 0; ni < 2; ++ni)
#pragma unroll
          for (int a = 0; a < 4; ++a) {
            const int e = ni * 32 + 8 * a + 4 * h;
            store4bf(dst + (size_t)n * 64 + e, v[ni][4 * a] * rinv * gk[e], v[ni][4 * a + 1] * rinv * gk[e + 1],
                     v[ni][4 * a + 2] * rinv * gk[e + 2], v[ni][4 * a + 3] * rinv * gk[e + 3]);
          }
      } else {
#pragma unroll
        for (int ni = 0; ni < 2; ++ni)
#pragma unroll
          for (int i = 0; i < 16; ++i) dst[(size_t)(ni * 32 + crow(i, h)) * 512 + n] = f2bf(v[ni][i]);
      }
    }
  }
};

template <class Src>
DI void prep_job(bf16_t* dst, int Npad, int K, float* sT, Src src) {
  const int tid = tidx();
  const int NT = Npad >> 6, KT = K >> 6;
  for (int t = bidx(); t < NT * KT; t += gridDim.x) {
    const int nt = t % NT, kt = t / NT;
    __syncthreads();
#pragma unroll 4
    for (int i = 0; i < 16; ++i) {
      const int e = tid + 256 * i, kk = e >> 6, nn = e & 63;
      sT[kk * 65 + nn] = src(kt * 64 + kk, nt * 64 + nn);
    }
    __syncthreads();
#pragma unroll 4
    for (int i = 0; i < 8; ++i) {
      const int e = tid + 256 * i, nn = e >> 5, kp = e & 31;
      *(unsigned*)(dst + (size_t)(nt * 64 + nn) * K + kt * 64 + 2 * kp) = pack2(sT[(2 * kp) * 65 + nn], sT[(2 * kp + 1) * 65 + nn]);
    }
  }
}

DI void prep_layer(const Params& P, int L, char* smem) {
  float* sT = (float*)smem;
  char* ws = wsp(P);
  const float* ng = inp(P, 1) + (size_t)L * 3 * D_;
  for (int f = 0; f < 2; ++f) {
    const float* wg = inp(P, f ? 5 : 2) + (size_t)L * D_ * F_;
    const float* wu = inp(P, f ? 6 : 3) + (size_t)L * D_ * F_;
    const float* wd = inp(P, f ? 7 : 4) + (size_t)L * D_ * F_;
    const float* g = ng + (f ? 2 * D_ : 0);
    prep_job((bf16_t*)(ws + (f ? OFF_W2 : OFF_W1)), 2 * F_, D_, sT, [=](int k, int n) {
      const int grp = n >> 6, rr = n & 63;
      const float* s = rr < 32 ? wg : wu;
      return s[(size_t)k * F_ + grp * 32 + (rr & 31)] * g[k];
    });
    prep_job((bf16_t*)(ws + (f ? OFF_W2D : OFF_W1D)), D_, F_, sT, [=](int k, int n) { return wd[(size_t)k * D_ + n]; });
  }
  const float* g1 = ng + D_;
  bf16_t* wmi = (bf16_t*)(ws + OFF_WMI);
  bf16_t* wmo = (bf16_t*)(ws + OFF_WMO);
  if (L == 0) {
    const float* w = inp(P, 8);
    prep_job(wmi, 4224, D_, sT, [=](int k, int n) {
      int c = n < 3072 ? n : (n < 4096 ? n + 16 : (n < 4112 ? n - 1024 : -1));
      return c < 0 ? 0.f : w[(size_t)k * 4112 + c] * g1[k];
    });
    const float* wo = inp(P, 12);
    prep_job(wmo, D_, D_, sT, [=](int k, int n) { return wo[(size_t)k * D_ + n]; });
  } else if (L == 1) {
    const float* w = inp(P, 13);
    prep_job(wmi, 2688, D_, sT, [=](int k, int n) { return n < 2608 ? w[(size_t)k * 2608 + n] * g1[k] : 0.f; });
    const float* wo = inp(P, 20);
    prep_job(wmo, D_, D_, sT, [=](int k, int n) { return wo[(size_t)k * D_ + n]; });
    const float* wck = inp(P, 16);
    const float* wcv = inp(P, 17);
    prep_job((bf16_t*)(ws + OFF_WCK), 128, 2048, sT, [=](int k, int n) { return n < 64 ? wck[(size_t)k * 64 + n] : 0.f; });
    prep_job((bf16_t*)(ws + OFF_WCV), 128, 2048, sT, [=](int k, int n) { return n < 64 ? wcv[(size_t)k * 64 + n] : 0.f; });
    if (bidx() == 0 && tidx() < 128) {
      const int e = tidx() & 63, which = tidx() >> 6;
      const float* pos = which ? inp(P, 15) : inp(P, 14);
      const float* wc = which ? inp(P, 17) : inp(P, 16);
      float s = 0.f;
      for (int kd = 0; kd < 2048; ++kd) s += pos[kd] * wc[(size_t)kd * 64 + e];
      ((float*)(ws + OFF_CBIAS))[which * 64 + e] = s;
    }
  } else if (L == 2) {
    const float* w = inp(P, 21);
    prep_job(wmi, 3200, D_, sT, [=](int k, int n) {
      int c = n < 2048 ? n : (n < 3072 ? n + 16 : (n < 3088 ? n - 1024 : -1));
      return c < 0 ? 0.f : w[(size_t)k * 3088 + c] * g1[k];
    });
    const float* wo = inp(P, 25);
    prep_job(wmo, D_, D_, sT, [=](int k, int n) { return wo[(size_t)k * D_ + n]; });
  } else {
    const float* w = inp(P, 26);
    prep_job(wmi, 3072, D_, sT, [=](int k, int n) { return w[(size_t)k * 3072 + n] * g1[k]; });
    const float* wo = inp(P, 27);
    prep_job(wmo, D_, D_, sT, [=](int k, int n) { return wo[(size_t)k * D_ + n]; });
  }
}

DI void init_phase(const Params& P) {
  const int tid = tidx(), lane = tid & 63, wave = tid >> 6;
  float* ssq = (float*)(wsp(P) + OFF_SSQ);
  bf16_t* xb = (bf16_t*)(wsp(P) + OFF_XB);
  const float* x = inp(P, 0);
  for (int row = bidx() * 4 + wave; row < M_; row += gridDim.x * 4) {
    float s = 0.f;
#pragma unroll
    for (int i = 0; i < 4; ++i) {
      const int c = (i * 64 + lane) * 4;
      f32x4 v = *(const f32x4*)(x + (size_t)row * D_ + c);
      s += v.x * v.x + v.y * v.y + v.z * v.z + v.w * v.w;
      store4bf(xb + (size_t)row * D_ + c, v.x, v.y, v.z, v.w);
    }
#pragma unroll
    for (int o = 32; o >= 1; o >>= 1) s += __shfl_xor(s, o);
    if (lane < 16) ssq[(size_t)row * 16 + lane] = (lane == 0) ? s : 0.f;
  }
}

struct AttnSmem {
  bf16_t k[64 * 72];
  bf16_t v[64 * 72];
  float c[64];
};

DI void attn_load(const bf16_t* Kb, int ldk, const bf16_t* VTb, int ldv, int j, u32x4 (&kr)[2], u32x4 (&vr)[2]) {
  const int tid = tidx();
#pragma unroll
  for (int i = 0; i < 2; ++i) {
    const int c = tid + 256 * i, row = c >> 3, cc = c & 7;
    kr[i] = *(const u32x4*)(Kb + (size_t)(j * 64 + row) * ldk + cc * 8);
    vr[i] = *(const u32x4*)(VTb + (size_t)row * ldv + j * 64 + cc * 8);
  }
}
DI void attn_store(AttnSmem& sm, const u32x4 (&kr)[2], const u32x4 (&vr)[2]) {
  const int tid = tidx();
#pragma unroll
  for (int i = 0; i < 2; ++i) {
    const int c = tid + 256 * i, row = c >> 3, cc = c & 7;
    *(u32x4*)(sm.k + row * 72 + cc * 8) = kr[i];
    *(u32x4*)(sm.v + row * 72 + cc * 8) = vr[i];
  }
}
DI void attn_qk(const AttnSmem& sm, const bf16x8 (&qf)[4], f32x16 (&st)[2]) {
  const int lane = tidx() & 63, r = lane & 31, h = lane >> 5;
#pragma unroll
  for (int kt = 0; kt < 2; ++kt) {
    zero16(st[kt]);
#pragma unroll
    for (int kk = 0; kk < 4; ++kk) {
      bf16x8 a = *(const bf16x8*)(sm.k + (kt * 32 + r) * 72 + kk * 16 + h * 8);
      st[kt] = MFMA(a, qf[kk], st[kt]);
    }
  }
}
DI void attn_pv(const AttnSmem& sm, const f32x16 (&st)[2], f32x16 (&o)[2]) {
  const int lane = tidx() & 63, r = lane & 31, h = lane >> 5;
#pragma unroll
  for (int kt = 0; kt < 2; ++kt)
#pragma unroll
    for (int s2 = 0; s2 < 2; ++s2) {
      bf16x8 pk = pack8(st[kt][8 * s2], st[kt][8 * s2 + 1], st[kt][8 * s2 + 2], st[kt][8 * s2 + 3], st[kt][8 * s2 + 4],
                        st[kt][8 * s2 + 5], st[kt][8 * s2 + 6], st[kt][8 * s2 + 7]);
#pragma unroll
      for (int dt = 0; dt < 2; ++dt) {
        const bf16_t* p = sm.v + (dt * 32 + r) * 72 + kt * 32 + 16 * s2 + 4 * h;
        bf16x8 a = cat4(*(const bf16x4*)p, *(const bf16x4*)(p + 8));
        o[dt] = MFMA(a, pk, o[dt]);
      }
    }
}
DI void load_qf(const bf16_t* Qrow, bf16x8 (&qf)[4]) {
  const int h = (tidx() & 63) >> 5;
#pragma unroll
  for (int kk = 0; kk < 4; ++kk) qf[kk] = *(const bf16x8*)(Qrow + kk * 16 + h * 8);
}

template <int MODE>
DI void flash_pass(const bf16_t* Kb, const bf16_t* VTb, const float* cB, float cq, u32x4 selw, int qw, int jlo, int jhi,
                   const bf16x8 (&qf)[4], f32x16 (&o)[2], float& lsum, AttnSmem& sm) {
  const int tid = tidx(), lane = tid & 63, r = lane & 31, h = lane >> 5;
  const int query = qw + r;
  float m_run = -1e30f, l_run = 0.f;
  zero16(o[0]);
  zero16(o[1]);
  u32x4 kr[2], vr[2];
  float cr = 0.f;
  attn_load(Kb, 64, VTb, S_, jlo, kr, vr);
  if (MODE == 0 && tid < 64) cr = cB[jlo * 64 + tid];
  for (int j = jlo; j <= jhi; ++j) {
    __syncthreads();
    attn_store(sm, kr, vr);
    if (MODE == 0 && tid < 64) sm.c[tid] = cr;
    __syncthreads();
    if (j < jhi) {
      attn_load(Kb, 64, VTb, S_, j + 1, kr, vr);
      if (MODE == 0 && tid < 64) cr = cB[(j + 1) * 64 + tid];
    }
    bool active = (j * 64 <= qw + 31);
    bool bit = true;
    if (MODE == 1) active = active && (j * 64 + 63 >= qw - 511);
    if (MODE == 2) {
      const int wi = j >> 5;
      const unsigned w = wi == 0 ? selw.x : (wi == 1 ? selw.y : (wi == 2 ? selw.z : selw.w));
      bit = (w >> (j & 31)) & 1u;
      active = active && (__ballot(bit) != 0ull);
    }
    if (active) {
      f32x16 st[2];
      attn_qk(sm, qf, st);
      const float SC = 0.125f * 1.4426950408889634f;
      const bool interior = (MODE != 0) && (j * 64 + 63 <= qw) && (MODE != 1 || (qw + 31 - j * 64 < 512));
      float mx = -1e30f;
      if (interior) {
#pragma unroll
        for (int kt = 0; kt < 2; ++kt)
#pragma unroll
          for (int i = 0; i < 16; ++i) {
            const float s = st[kt][i] * SC;
            st[kt][i] = s;
            mx = fmaxf(mx, s);
          }
        if (MODE == 2 && !bit) mx = -1e30f;
      } else {
#pragma unroll
        for (int kt = 0; kt < 2; ++kt)
#pragma unroll
          for (int i = 0; i < 16; ++i) {
            const int kl = kt * 32 + crow(i, h);
            const int key = j * 64 + kl;
            float s = st[kt][i] * SC;
            bool ok = key <= query;
            if (MODE == 0) s += (cq - sm.c[kl]) * 1.4426950408889634f;
            if (MODE == 1) ok = ok && (query - key < 512);
            if (MODE == 2) ok = ok && bit;
            s = ok ? s : -1e30f;
            st[kt][i] = s;
            mx = fmaxf(mx, s);
          }
      }
      mx = fmaxf(mx, __shfl_xor(mx, 32));
      const float m_new = fmaxf(m_run, mx);
      const float alpha = __builtin_amdgcn_exp2f(m_run - m_new);
      float ps = 0.f;
      if (interior) {
#pragma unroll
        for (int kt = 0; kt < 2; ++kt)
#pragma unroll
          for (int i = 0; i < 16; ++i) {
            float p = __builtin_amdgcn_exp2f(st[kt][i] - m_new);
            if (MODE == 2) p = bit ? p : 0.f;
            st[kt][i] = p;
            ps += p;
          }
      } else {
#pragma unroll
        for (int kt = 0; kt < 2; ++kt)
#pragma unroll
          for (int i = 0; i < 16; ++i) {
            const float s = st[kt][i];
            const float p = (s > -1e29f) ? __builtin_amdgcn_exp2f(s - m_new) : 0.f;
            st[kt][i] = p;
            ps += p;
          }
      }
      ps += __shfl_xor(ps, 32);
      l_run = l_run * alpha + ps;
      m_run = m_new;
#pragma unroll
      for (int dt = 0; dt < 2; ++dt)
#pragma unroll
        for (int i = 0; i < 16; ++i) o[dt][i] *= alpha;
      attn_pv(sm, st, o);
    }
  }
  lsum = l_run;
}

DI void fox_pass(const bf16_t* Kb, const bf16_t* VTb, const float* cB, float cq, float sbound, int qw, int jhi,
                 const bf16x8 (&qf)[4], f32x16 (&o)[2], float& lsum, AttnSmem& sm) {
  const int tid = tidx(), lane = tid & 63, r = lane & 31, h = lane >> 5;
  const int query = qw + r;
  float m_run = -1e30f, l_run = 0.f;
  zero16(o[0]);
  zero16(o[1]);
  u32x4 kr[2], vr[2];
  float cr = 0.f;
  int done = 0;
  attn_load(Kb, 64, VTb, S_, jhi, kr, vr);
  if (tid < 64) cr = cB[jhi * 64 + tid];
  for (int j = jhi; j >= 0; --j) {
    if (__syncthreads_and(done)) break;
    attn_store(sm, kr, vr);
    if (tid < 64) sm.c[tid] = cr;
    __syncthreads();
    if (j > 0) {
      attn_load(Kb, 64, VTb, S_, j - 1, kr, vr);
      if (tid < 64) cr = cB[(j - 1) * 64 + tid];
    }
    if (j * 64 <= qw + 31) {
      f32x16 st[2];
      attn_qk(sm, qf, st);
      float mx = -1e30f;
#pragma unroll
      for (int kt = 0; kt < 2; ++kt)
#pragma unroll
        for (int i = 0; i < 16; ++i) {
          const int kl = kt * 32 + crow(i, h);
          const int key = j * 64 + kl;
          float s = st[kt][i] * 0.125f + (cq - sm.c[kl]);
          s = (key <= query) ? s : -1e30f;
          st[kt][i] = s;
          mx = fmaxf(mx, s);
        }
      mx = fmaxf(mx, __shfl_xor(mx, 32));
      const float m_new = fmaxf(m_run, mx);
      const float alpha = __expf(m_run - m_new);
      float ps = 0.f;
#pragma unroll
      for (int kt = 0; kt < 2; ++kt)
#pragma unroll
        for (int i = 0; i < 16; ++i) {
          const float s = st[kt][i];
          const float p = (s > -1e29f) ? __expf(s - m_new) : 0.f;
          st[kt][i] = p;
          ps += p;
        }
      ps += __shfl_xor(ps, 32);
      l_run = l_run * alpha + ps;
      m_run = m_new;
#pragma unroll
      for (int dt = 0; dt < 2; ++dt)
#pragma unroll
        for (int i = 0; i < 16; ++i) o[dt][i] *= alpha;
      attn_pv(sm, st, o);
      done = (sbound + cq - sm.c[0] < m_run - 104.f) ? 1 : 0;
    }
  }
  lsum = l_run;
}
DI void fox_scan_phase(const Params& P, char* smem) {
  double* sp = (double*)smem;
  const float* flog = (const float*)(wsp(P) + OFF_FLOG);
  float* c = (float*)(wsp(P) + OFF_C);
  const int tid = tidx();
  for (int seq = bidx(); seq < 64; seq += gridDim.x) {
    const float* src = flog + (size_t)seq * S_ + tid * 32;
    double tot = 0.0;
    for (int i = 0; i < 32; ++i) tot += (double)src[i];
    __syncthreads();
    sp[tid] = tot;
    __syncthreads();
    double pre = 0.0;
    for (int i = 0; i < tid; ++i) pre += sp[i];
    float* dst = c + (size_t)seq * S_ + tid * 32;
    for (int i = 0; i < 32; ++i) {
      pre += (double)src[i];
      dst[i] = (float)pre;
    }
  }
}

DI void fox_attn_phase(const Params& P, char* smem, int rep) {
  AttnSmem& sm = *(AttnSmem*)smem;
  const bf16_t* Q = (const bf16_t*)(wsp(P) + OFF_R);
  const bf16_t* K = Q + (size_t)M_ * D_;
  const bf16_t* VT = K + (size_t)M_ * D_;
  const float* c = (const float*)(wsp(P) + OFF_C);
  bf16_t* obuf = (bf16_t*)(wsp(P) + OFF_OBUF);
  const int lane = tidx() & 63, wave = tidx() >> 6, r = lane & 31, h = lane >> 5;
  float gqm = 0.f, gkm = 0.f;
  for (int d = 0; d < 64; ++d) {
    gqm = fmaxf(gqm, fabsf(inp(P, 10)[d]));
    gkm = fmaxf(gkm, fabsf(inp(P, 11)[d]));
  }
  const float sbound = 8.16f * gqm * gkm;
  for (int it = bidx(); it < 4096; it += gridDim.x) {
    const int qt = 63 - (it >> 6), bh = it & 63;
    const int q0 = qt * 128, qw = q0 + wave * 32, query = qw + r;
    bf16x8 qf[4];
    load_qf(Q + ((size_t)bh * S_ + query) * 64, qf);
    const float cq = c[(size_t)bh * S_ + query];
    f32x16 o[2];
    float l;
    fox_pass(K + (size_t)bh * S_ * 64, VT + (size_t)bh * 64 * S_, c + (size_t)bh * S_, cq, sbound, qw, 2 * qt + 1, qf, o, l, sm);
    const float inv = 1.f / l;
    const int b = bh >> 4, hh = bh & 15;
    bf16_t* dst = obuf + ((size_t)b * S_ + query) * D_ + hh * 64;
#pragma unroll
    for (int dt = 0; dt < 2; ++dt)
#pragma unroll
      for (int a = 0; a < 4; ++a) {
        bf16_t* p = dst + dt * 32 + 8 * a + 4 * h;
        u32x2 g = *(const u32x2*)p;
        if (rep) *(u32x2*)p = g;
        else
        store4bf(p, o[dt][4 * a] * inv * bflo(g.x), o[dt][4 * a + 1] * inv * bfhi(g.x), o[dt][4 * a + 2] * inv * bflo(g.y),
                 o[dt][4 * a + 3] * inv * bfhi(g.y));
      }
  }
}

DI void sb_attn_phase(const Params& P, char* smem) {
  AttnSmem& sm = *(AttnSmem*)smem;
  const bf16_t* Q = (const bf16_t*)(wsp(P) + OFF_R);
  const bf16_t* K = Q + (size_t)M_ * D_;
  const bf16_t* VT = K + (size_t)M_ * D_;
  bf16_t* obuf = (bf16_t*)(wsp(P) + OFF_OBUF);
  const int tid = tidx(), lane = tid & 63, wave = tid >> 6, r = lane & 31, h = lane >> 5;
  bf16x8 tdiag[2], ones;
#pragma unroll
  for (int s2 = 0; s2 < 2; ++s2)
#pragma unroll
    for (int jj = 0; jj < 8; ++jj) {
      const int kj = 16 * s2 + 8 * (jj >> 2) + 4 * h + (jj & 3);
      tdiag[s2][jj] = (kj > r) ? (short)0x3f80 : (short)0;
    }
#pragma unroll
  for (int jj = 0; jj < 8; ++jj) ones[jj] = (short)0x3f80;

  for (int it = bidx(); it < 4096; it += gridDim.x) {
    const int qt = 63 - (it >> 6), bh = it & 63;
    const int q0 = qt * 128, qw = q0 + wave * 32, query = qw + r;
    const bf16_t* Kb = K + (size_t)bh * S_ * 64;
    const bf16_t* VTb = VT + (size_t)bh * 64 * S_;
    bf16x8 qf[4];
    load_qf(Q + ((size_t)bh * S_ + query) * 64, qf);
    f32x16 o[2];
    zero16(o[0]);
    zero16(o[1]);
    float R = 0.f;
    u32x4 kr[2], vr[2];
    const int jhi = 2 * qt + 1;
    attn_load(Kb, 64, VTb, S_, jhi, kr, vr);
    for (int j = jhi; j >= 0; --j) {
      if (__syncthreads_and(R < -110.f)) break;
      attn_store(sm, kr, vr);
      __syncthreads();
      if (j > 0) attn_load(Kb, 64, VTb, S_, j - 1, kr, vr);
      if (j * 64 < qw + 31) {
        f32x16 st[2], Lv[2], lat[2];
        attn_qk(sm, qf, st);
        float tot = 0.f;
#pragma unroll
        for (int kt = 0; kt < 2; ++kt)
#pragma unroll
          for (int i = 0; i < 16; ++i) {
            const int key = j * 64 + kt * 32 + crow(i, h);
            const float z = st[kt][i] * 0.125f;
            const float sp = fmaxf(z, 0.f) + __logf(1.f + __expf(-fabsf(z)));
            const float L = (key < query) ? -sp : 0.f;
            st[kt][i] = z;
            Lv[kt][i] = L;
            tot += L;
          }
        tot += __shfl_xor(tot, 32);
        bf16x8 hi[2][2], lo[2][2];
#pragma unroll
        for (int kt = 0; kt < 2; ++kt)
#pragma unroll
          for (int s2 = 0; s2 < 2; ++s2) {
            float hv[8], lv[8];
#pragma unroll
            for (int q = 0; q < 8; ++q) {
              const float L = Lv[kt][8 * s2 + q];
              hv[q] = bf2f(f2bf(L));
              lv[q] = L - hv[q];
            }
            hi[kt][s2] = pack8(hv[0], hv[1], hv[2], hv[3], hv[4], hv[5], hv[6], hv[7]);
            lo[kt][s2] = pack8(lv[0], lv[1], lv[2], lv[3], lv[4], lv[5], lv[6], lv[7]);
          }
        zero16(lat[0]);
        zero16(lat[1]);
#pragma unroll
        for (int s2 = 0; s2 < 2; ++s2) {
          lat[0] = MFMA(tdiag[s2], hi[0][s2], lat[0]);
          lat[0] = MFMA(tdiag[s2], lo[0][s2], lat[0]);
          lat[0] = MFMA(ones, hi[1][s2], lat[0]);
          lat[0] = MFMA(ones, lo[1][s2], lat[0]);
          lat[1] = MFMA(tdiag[s2], hi[1][s2], lat[1]);
          lat[1] = MFMA(tdiag[s2], lo[1][s2], lat[1]);
        }
#pragma unroll
        for (int kt = 0; kt < 2; ++kt)
#pragma unroll
          for (int i = 0; i < 16; ++i) {
            const int key = j * 64 + kt * 32 + crow(i, h);
            const float e = st[kt][i] + Lv[kt][i] + lat[kt][i] + R;
            st[kt][i] = (key < query) ? __expf(e) : 0.f;
          }
        R += tot;
        attn_pv(sm, st, o);
      }
    }
    const int b = bh >> 4, hh = bh & 15;
    bf16_t* dst = obuf + ((size_t)b * S_ + query) * D_ + hh * 64;
#pragma unroll
    for (int dt = 0; dt < 2; ++dt)
#pragma unroll
      for (int a = 0; a < 4; ++a)
        store4bf(dst + dt * 32 + 8 * a + 4 * h, o[dt][4 * a], o[dt][4 * a + 1], o[dt][4 * a + 2], o[dt][4 * a + 3]);
  }
}

DI void nsa_compress_phase(const Params& P, char* smem) {
  bf16_t* sW = (bf16_t*)smem;
  bf16_t* sX = sW + 128 * 72;
  const bf16_t* KC = (const bf16_t*)(wsp(P) + OFF_R + 64 * MiB);
  const bf16_t* VC = (const bf16_t*)(wsp(P) + OFF_R + 112 * MiB);
  const float* cb = (const float*)(wsp(P) + OFF_CBIAS);
  const int wave = tidx() >> 6, wn = wave >> 1, wm = wave & 1;
  for (int t = bidx(); t < 64; t += gridDim.x) {
    const int isv = t >> 5, kv = (t >> 1) & 15, mt = t & 1;
    const bf16_t* Wt = (const bf16_t*)(wsp(P) + (isv ? OFF_WCV : OFF_WCK));
    const bf16_t* X = (isv ? VC : KC) + ((size_t)kv * S_ + (size_t)mt * 256 * 16) * 64;
    f32x16 acc[2][2][2];
    gemm_tile<2>(Wt, 2048, X, 1024, 2048, sW, sX, acc);
    EpiCmp epi;
    epi.cb = cb + isv * 64;
    epi.gk = inp(P, 19);
    epi.isv = isv;
    epi.dst = isv ? (bf16_t*)(wsp(P) + OFF_VCMPT) + (size_t)kv * 64 * 512 : (bf16_t*)(wsp(P) + OFF_KCMP) + (size_t)kv * 512 * 64;
    epi(acc[0], wn * 64, mt * 256 + wm * 128);
    epi(acc[1], wn * 64, mt * 256 + wm * 128 + 64);
  }
}

struct CmpSmem {
  AttnSmem a;
  float imp[32 * 132];
};

DI void nsa_cmp_phase(const Params& P, char* smem) {
  CmpSmem& sm = *(CmpSmem*)smem;
  const bf16_t* Q = (const bf16_t*)(wsp(P) + OFF_R);
  const bf16_t* KCMP = (const bf16_t*)(wsp(P) + OFF_KCMP);
  const bf16_t* VCMPT = (const bf16_t*)(wsp(P) + OFF_VCMPT);
  const float* gates = (const float*)(wsp(P) + OFF_GATES);
  bf16_t* obuf = (bf16_t*)(wsp(P) + OFF_OBUF);
  u32x4* sel = (u32x4*)(wsp(P) + OFF_SEL);
  const int tid = tidx(), lane = tid & 63, wave = tid >> 6, r = lane & 31, h = lane >> 5;
  for (int it = bidx(); it < 4096; it += gridDim.x) {
    const int tt = 255 - (it >> 4), kv = it & 15, b = kv >> 2, g = kv & 3;
    const int t0 = tt * 32, head = g * 4 + wave, query = t0 + r;
    const bf16_t* Kb = KCMP + (size_t)kv * 512 * 64;
    const bf16_t* VTb = VCMPT + (size_t)kv * 64 * 512;
    bf16x8 qf[4];
    load_qf(Q + ((size_t)(b * 16 + head) * S_ + query) * 64, qf);
    const int ntiles = ((t0 >> 4) >> 6) + 1;
    __syncthreads();
    for (int e = tid; e < 32 * 132; e += 256) sm.imp[e] = 0.f;
    float m_run = -1e30f, l_run = 0.f;
    u32x4 kr[2], vr[2];
    for (int jt = 0; jt < ntiles; ++jt) {
      attn_load(Kb, 64, VTb, 512, jt, kr, vr);
      __syncthreads();
      attn_store(sm.a, kr, vr);
      __syncthreads();
      f32x16 st[2];
      attn_qk(sm.a, qf, st);
      float mx = -1e30f;
#pragma unroll
      for (int kt = 0; kt < 2; ++kt)
#pragma unroll
        for (int i = 0; i < 16; ++i) {
          const int n = jt * 64 + kt * 32 + crow(i, h);
          const float s = (16 * n + 31 <= query) ? st[kt][i] * 0.125f : -1e30f;
          st[kt][i] = s;
          mx = fmaxf(mx, s);
        }
      mx = fmaxf(mx, __shfl_xor(mx, 32));
      const float m_new = fmaxf(m_run, mx);
      float ps = 0.f;
#pragma unroll
      for (int kt = 0; kt < 2; ++kt)
#pragma unroll
        for (int i = 0; i < 16; ++i) ps += (st[kt][i] > -1e29f) ? __expf(st[kt][i] - m_new) : 0.f;
      ps += __shfl_xor(ps, 32);
      l_run = l_run * __expf(m_run - m_new) + ps;
      m_run = m_new;
    }
    const float linv = l_run > 0.f ? 1.f / l_run : 0.f;
    f32x16 o[2];
    zero16(o[0]);
    zero16(o[1]);
    for (int jt = 0; jt < ntiles; ++jt) {
      attn_load(Kb, 64, VTb, 512, jt, kr, vr);
      __syncthreads();
      attn_store(sm.a, kr, vr);
      __syncthreads();
      f32x16 st[2];
      attn_qk(sm.a, qf, st);
#pragma unroll
      for (int kt = 0; kt < 2; ++kt)
#pragma unroll
        for (int i = 0; i < 16; ++i) {
          const int n = jt * 64 + kt * 32 + crow(i, h);
          st[kt][i] = (16 * n + 31 <= query) ? __expf(st[kt][i] * 0.125f - m_run) * linv : 0.f;
        }
      attn_pv(sm.a, st, o);
      for (int w = 0; w < 4; ++w) {
        if (wave == w) {
          float* ip = sm.imp + r * 132 + jt * 16 + h;
#pragma unroll
          for (int kt = 0; kt < 2; ++kt)
#pragma unroll
            for (int a = 0; a < 4; ++a) {
              const float G = st[kt][4 * a] + st[kt][4 * a + 1] + st[kt][4 * a + 2] + st[kt][4 * a + 3];
              const float x = __shfl_xor(st[kt][4 * a + 3], 32);
              ip[kt * 8 + 2 * a] += G + (h ? x : 0.f);
              if (!h) ip[kt * 8 + 2 * a + 2] += x;
            }
        }
        __syncthreads();
      }
    }
    {
      const size_t m = (size_t)b * S_ + query;
      float gc = gates[m * 48 + head * 3 + 0];
#if ABL == 3
      gc = 0.f;
#endif
      bf16_t* dst = obuf + m * D_ + head * 64;
#pragma unroll
      for (int dt = 0; dt < 2; ++dt)
#pragma unroll
        for (int a = 0; a < 4; ++a)
          store4bf(dst + dt * 32 + 8 * a + 4 * h, o[dt][4 * a] * gc, o[dt][4 * a + 1] * gc, o[dt][4 * a + 2] * gc,
                   o[dt][4 * a + 3] * gc);
    }
    for (int tk = 0; tk < 8; ++tk) {
      const int tl = wave * 8 + tk, t = t0 + tl, cur = t >> 6;
      const float* ip = sm.imp + tl * 132;
      const int j0 = lane, j1 = lane + 64;
      const bool f0 = (j0 == 0) || (j0 == cur) || (j0 == cur - 1);
      const bool f1 = (j1 == cur) || (j1 == cur - 1);
      const float v0 = f0 ? 1e9f : (j0 <= cur ? ip[j0] : -1.f);
      const float v1 = f1 ? 1e9f : (j1 <= cur ? ip[j1] : -1.f);
      int r0 = 0, r1 = 0;
      for (int jp = 0; jp <= cur; ++jp) {
        const bool fp = (jp == 0) || (jp == cur) || (jp == cur - 1);
        const float vp = fp ? 1e9f : ip[jp];
        r0 += (vp > v0 || (vp == v0 && jp < j0)) ? 1 : 0;
        r1 += (vp > v1 || (vp == v1 && jp < j1)) ? 1 : 0;
      }
      const unsigned long long m0 = __ballot(j0 <= cur && r0 < 16);
      const unsigned long long m1 = __ballot(j1 <= cur && r1 < 16);
      if (lane == 0) {
        u32x4 w;
        w.x = (unsigned)m0;
        w.y = (unsigned)(m0 >> 32);
        w.z = (unsigned)m1;
        w.w = (unsigned)(m1 >> 32);
        sel[(size_t)kv * S_ + t] = w;
      }
    }
  }
}

DI void nsa_attn_phase(const Params& P, char* smem, int rep) {
  AttnSmem& sm = *(AttnSmem*)smem;
  char* R = wsp(P) + OFF_R;
  const bf16_t* Q = (const bf16_t*)R;
  const bf16_t* KS = (const bf16_t*)(R + 80 * MiB);
  const bf16_t* KW = (const bf16_t*)(R + 96 * MiB);
  const bf16_t* VST = (const bf16_t*)(R + 128 * MiB);
  const bf16_t* VWT = (const bf16_t*)(R + 144 * MiB);
  const float* gates = (const float*)(wsp(P) + OFF_GATES);
  const u32x4* sel = (const u32x4*)(wsp(P) + OFF_SEL);
  bf16_t* obuf = (bf16_t*)(wsp(P) + OFF_OBUF);
  const int lane = tidx() & 63, wave = tidx() >> 6, r = lane & 31, h = lane >> 5;
  for (int it = bidx(); it < 4096; it += gridDim.x) {
    const int qt = 63 - (it >> 6), bh = it & 63, b = bh >> 4, head = bh & 15, kv = b * 4 + (head >> 2);
    const int q0 = qt * 128, qw = q0 + wave * 32, query = qw + r;
    bf16x8 qf[4];
    load_qf(Q + ((size_t)bh * S_ + query) * 64, qf);
    const u32x4 selw = sel[(size_t)kv * S_ + query];
    const size_t m = (size_t)b * S_ + query;
    float gs = gates[m * 48 + head * 3 + 1], gw = gates[m * 48 + head * 3 + 2];
    if (rep) { gs = 0.f; gw = 0.f; }
#if ABL == 1
    gs = 0.f;
#elif ABL == 2
    gw = 0.f;
#endif
    f32x16 o[2], ow[2];
    float l;
    const int jlo = (q0 > 511 ? q0 - 511 : 0) >> 6;
    flash_pass<1>(KW + (size_t)kv * S_ * 64, VWT + (size_t)kv * 64 * S_, nullptr, 0.f, selw, qw, jlo, 2 * qt + 1, qf, o, l, sm);
    {
      const float sc = gw / l;
#pragma unroll
      for (int dt = 0; dt < 2; ++dt)
#pragma unroll
        for (int i = 0; i < 16; ++i) ow[dt][i] = o[dt][i] * sc;
    }
    flash_pass<2>(KS + (size_t)kv * S_ * 64, VST + (size_t)kv * 64 * S_, nullptr, 0.f, selw, qw, 0, 2 * qt + 1, qf, o, l, sm);
    const float sc = gs / l;
    bf16_t* dst = obuf + m * D_ + head * 64;
#pragma unroll
    for (int dt = 0; dt < 2; ++dt)
#pragma unroll
      for (int a = 0; a < 4; ++a) {
        bf16_t* p = dst + dt * 32 + 8 * a + 4 * h;
        u32x2 g = *(const u32x2*)p;
        store4bf(p, ow[dt][4 * a] + o[dt][4 * a] * sc + bflo(g.x), ow[dt][4 * a + 1] + o[dt][4 * a + 1] * sc + bfhi(g.x),
                 ow[dt][4 * a + 2] + o[dt][4 * a + 2] * sc + bflo(g.y), ow[dt][4 * a + 3] + o[dt][4 * a + 3] * sc + bfhi(g.y));
      }
  }
}

struct GlaSmem {
  float glow[64 * 16];
  float tot[2 * 128];
  float ssq[2 * 64];
  bf16_t q[64 * 136];
  bf16_t ki[64 * 136];
  bf16_t a[64 * 72];
};

DI void gla_compute_b(const Params& P, GlaSmem& sm, int b, int hg, int t0, float (&bv)[32], float& blast) {
  const int tid = tidx(), d = tid & 127, half = tid >> 7;
  const float* glow = (const float*)(wsp(P) + OFF_GLOW) + ((size_t)b * S_ + t0) * 16;
  __syncthreads();
  for (int e = tid; e < 1024; e += 256) sm.glow[e] = glow[e];
  const int col = hg * 128 + d;
  float w[16];
#pragma unroll
  for (int q = 0; q < 16; ++q) w[q] = inp(P, 22)[q * 512 + col];
  const float bias = inp(P, 23)[col];
  __syncthreads();
  float run = 0.f;
#pragma unroll
  for (int cc = 0; cc < 32; ++cc) {
    const float* gl = sm.glow + (half * 32 + cc) * 16;
    float z = 0.f;
#pragma unroll
    for (int q = 0; q < 16; ++q) z += gl[q] * w[q];
    z += bias;
    run += logsigmoidf_(z) * (1.f / 16.f);
    bv[cc] = run;
    if ((cc & 3) == 3) __builtin_amdgcn_sched_barrier(0);
  }
  sm.tot[half * 128 + d] = run;
  __syncthreads();
  const float t0v = sm.tot[d], t1v = sm.tot[128 + d];
  if (half) {
#pragma unroll
    for (int cc = 0; cc < 32; ++cc) bv[cc] += t0v;
  }
  blast = t0v + t1v;
}

DI void gla_u_phase(const Params& P, char* smem) {
  GlaSmem& sm = *(GlaSmem*)smem;
  char* R = wsp(P) + OFF_R;
  const bf16_t* KG = (const bf16_t*)(R + 32 * MiB);
  const bf16_t* VTG = (const bf16_t*)(R + 64 * MiB);
  bf16_t* UT = (bf16_t*)(R + 128 * MiB);
  float* decay = (float*)(wsp(P) + OFF_DECAY);
  bf16_t* sKT = sm.q;
  const int tid = tidx(), lane = tid & 63, wave = tid >> 6, r = lane & 31, h = lane >> 5;
  const int d = tid & 127, half = tid >> 7;
  for (int it = bidx(); it < 2048; it += gridDim.x) {
    const int n = it & 127, bhg = it >> 7, b = bhg >> 2, hg = bhg & 3, t0 = n * 64;
    float bv[32], blast;
    gla_compute_b(P, sm, b, hg, t0, bv, blast);
#pragma unroll
    for (int cc = 0; cc < 32; ++cc) {
      const int c = half * 32 + cc;
      const float k = bf2f(KG[((size_t)b * S_ + t0 + c) * 512 + hg * 128 + d]);
      sKT[d * 72 + c] = f2bf(k * __expf(blast - bv[cc]));
      if ((cc & 7) == 7) __builtin_amdgcn_sched_barrier(0);
    }
    if (half == 0) decay[(size_t)it * 128 + d] = __expf(blast);
    __syncthreads();
#pragma unroll 1
    for (int m2 = 0; m2 < 2; ++m2) {
      const int e0 = (2 * wave + m2) * 32;
      f32x16 acc[4];
#pragma unroll
      for (int q = 0; q < 4; ++q) zero16(acc[q]);
      const bf16_t* vrow = VTG + ((size_t)b * 1024 + hg * 256 + e0 + r) * S_ + t0;
#pragma unroll
      for (int kk = 0; kk < 4; ++kk) {
        bf16x8 a = *(const bf16x8*)(vrow + kk * 16 + h * 8);
#pragma unroll
        for (int nt = 0; nt < 4; ++nt) {
          bf16x8 bb = *(const bf16x8*)(sKT + (nt * 32 + r) * 72 + kk * 16 + h * 8);
          acc[nt] = MFMA(a, bb, acc[nt]);
        }
        __builtin_amdgcn_sched_barrier(0);
      }
      bf16_t* ub = UT + ((size_t)it * 256 + e0 + 4 * h) * 128 + r;
#pragma unroll
      for (int nt = 0; nt < 4; ++nt) {
#pragma unroll
        for (int i = 0; i < 16; ++i) ub[((i & 3) + 8 * (i >> 2)) * 128 + nt * 32] = f2bf(acc[nt][i]);
        __builtin_amdgcn_sched_barrier(0);
      }
    }
  }
}

DI void gla_scan_phase(const Params& P, int rep) {
  bf16_t* UT = (bf16_t*)(wsp(P) + OFF_R + 128 * MiB);
  const float* decay = (const float*)(wsp(P) + OFF_DECAY);
  for (int gid = bidx() * 256 + tidx(); gid < 16 * 256 * 128; gid += gridDim.x * 256) {
    const int bhg = gid >> 15, e = (gid >> 7) & 255, d = gid & 127;
    float state = 0.f;
    for (int n0 = 0; n0 < 128; n0 += 8) {
      float u[8], dc[8];
#pragma unroll
      for (int q = 0; q < 8; ++q) {
        const size_t it = (size_t)bhg * 128 + n0 + q;
        u[q] = bf2f(UT[(it * 256 + e) * 128 + d]);
        dc[q] = decay[it * 128 + d];
      }
#pragma unroll
      for (int q = 0; q < 8; ++q) {
        const size_t it = (size_t)bhg * 128 + n0 + q;
        UT[(it * 256 + e) * 128 + d] = rep ? f2bf(u[q]) : f2bf(state);
        state = dc[q] * state + u[q];
      }
    }
  }
}

DI void gla_out_phase(const Params& P, char* smem, int rep) {
  GlaSmem& sm = *(GlaSmem*)smem;
  char* R = wsp(P) + OFF_R;
  const bf16_t* QG = (const bf16_t*)R;
  const bf16_t* KG = (const bf16_t*)(R + 32 * MiB);
  const bf16_t* VTG = (const bf16_t*)(R + 64 * MiB);
  const bf16_t* UT = (const bf16_t*)(R + 128 * MiB);
  bf16_t* obuf = (bf16_t*)(wsp(P) + OFF_OBUF);
  const float* gout = inp(P, 24);
  const int tid = tidx(), lane = tid & 63, wave = tid >> 6, r = lane & 31, h = lane >> 5;
  const int d = tid & 127, half = tid >> 7;
  for (int it = bidx(); it < 2048; it += gridDim.x) {
    const int n = it & 127, bhg = it >> 7, b = bhg >> 2, hg = bhg & 3, t0 = n * 64;
    float bv[32], blast;
    gla_compute_b(P, sm, b, hg, t0, bv, blast);
#pragma unroll
    for (int cc = 0; cc < 32; ++cc) {
      const int c = half * 32 + cc;
      const size_t off = ((size_t)b * S_ + t0 + c) * 512 + hg * 128 + d;
      const float q = bf2f(QG[off]), k = bf2f(KG[off]);
      sm.q[c * 136 + d] = f2bf(q * 0.08838834764831845f * __expf(bv[cc]));
      sm.ki[c * 136 + d] = f2bf(k * __expf(-bv[cc]));
      if ((cc & 3) == 3) __builtin_amdgcn_sched_barrier(0);
    }
    __syncthreads();
    {
      const int ct = wave >> 1, stt = wave & 1;
      f32x16 acc;
      zero16(acc);
      if (stt <= ct) {
#pragma unroll
        for (int kk = 0; kk < 8; ++kk) {
          bf16x8 a = *(const bf16x8*)(sm.q + (ct * 32 + r) * 136 + kk * 16 + h * 8);
          bf16x8 bb = *(const bf16x8*)(sm.ki + (stt * 32 + r) * 136 + kk * 16 + h * 8);
          acc = MFMA(a, bb, acc);
        }
      }
#pragma unroll
      for (int i = 0; i < 16; ++i) {
        const int c = ct * 32 + crow(i, h), s = stt * 32 + r;
        sm.a[c * 72 + s] = f2bf(s <= c ? acc[i] : 0.f);
      }
    }
    __syncthreads();
    const int ctok = wave & 1, eh = wave >> 1;
    f32x16 acc[4];
#pragma unroll
    for (int q = 0; q < 4; ++q) zero16(acc[q]);
#pragma unroll
    for (int kk = 0; kk < 4; ++kk) {
      bf16x8 bb = *(const bf16x8*)(sm.a + (ctok * 32 + r) * 72 + kk * 16 + h * 8);
#pragma unroll
      for (int mt = 0; mt < 4; ++mt) {
        bf16x8 a = *(const bf16x8*)(VTG + ((size_t)b * 1024 + hg * 256 + eh * 128 + mt * 32 + r) * S_ + t0 + kk * 16 + h * 8);
        acc[mt] = MFMA(a, bb, acc[mt]);
      }
      if (kk & 1) __builtin_amdgcn_sched_barrier(0);
    }
#pragma unroll
    for (int kk = 0; kk < 8; ++kk) {
      bf16x8 bb = *(const bf16x8*)(sm.q + (ctok * 32 + r) * 136 + kk * 16 + h * 8);
#pragma unroll
      for (int mt = 0; mt < 4; ++mt) {
        bf16x8 a = *(const bf16x8*)(UT + ((size_t)it * 256 + eh * 128 + mt * 32 + r) * 128 + kk * 16 + h * 8);
        acc[mt] = MFMA(a, bb, acc[mt]);
      }
      if (kk & 1) __builtin_amdgcn_sched_barrier(0);
    }
    float ss = 0.f;
#pragma unroll
    for (int mt = 0; mt < 4; ++mt)
#pragma unroll
      for (int i = 0; i < 16; ++i) ss += acc[mt][i] * acc[mt][i];
    ss += __shfl_xor(ss, 32);
    if (h == 0) sm.ssq[eh * 64 + ctok * 32 + r] = ss;
    __syncthreads();
    const float tot = sm.ssq[ctok * 32 + r] + sm.ssq[64 + ctok * 32 + r];
    const float rinv = rsqrtf(tot * (1.f / 256.f) + 1e-6f);
    bf16_t* dst = obuf + ((size_t)b * S_ + t0 + ctok * 32 + r) * D_ + hg * 256 + eh * 128;
#pragma unroll
    for (int mt = 0; mt < 4; ++mt)
#pragma unroll
      for (int a = 0; a < 4; ++a) {
        const int el = mt * 32 + 8 * a + 4 * h;
        const float* gp = gout + eh * 128 + el;
        bf16_t* p = dst + el;
        u32x2 g = *(const u32x2*)p;
        if (rep) *(u32x2*)p = g;
        else
        store4bf(p, acc[mt][4 * a] * rinv * gp[0] * bflo(g.x), acc[mt][4 * a + 1] * rinv * gp[1] * bfhi(g.x),
                 acc[mt][4 * a + 2] * rinv * gp[2] * bflo(g.y), acc[mt][4 * a + 3] * rinv * gp[3] * bfhi(g.y));
      }
  }
}

#define XB_TMO 128
#define XB_XCNT(j) (256 + 64 * (j))
#define XB_XSUB(j) (1280 + 64 * (j))
#define XB_XGEN(j) (2304 + 64 * (j))
#define XB_TOP 3328
#define XB_TOPGEN 3392
#define XCD_BAR_WORDS 3456
#define XB_SPIN_CAP (1u << 21)
#define LAS __attribute__((address_space(3)))
DI unsigned xb_ld(unsigned* p) { return __hip_atomic_load(p, __ATOMIC_RELAXED, __HIP_MEMORY_SCOPE_AGENT); }
DI unsigned xb_add(unsigned* p, unsigned v) { return __hip_atomic_fetch_add(p, v, __ATOMIC_RELAXED, __HIP_MEMORY_SCOPE_AGENT); }
DI unsigned xb_xcc_id() { return (unsigned)__builtin_amdgcn_s_getreg((3 << 11) | 20) & 0xFu; }
#define XB_SPIN(cond, bar)                                           \
  do {                                                               \
    unsigned _sp = 0;                                                \
    while (cond) {                                                   \
      __builtin_amdgcn_s_sleep(1);                                   \
      if ((++_sp & 255u) == 0u) {                                    \
        if (xb_ld(&(bar)[XB_TMO])) break;                            \
        if (_sp > XB_SPIN_CAP) {                                     \
          atomicAdd(&(bar)[XB_TMO], 1u);                             \
          break;                                                     \
        }                                                            \
      }                                                              \
    }                                                                \
  } while (0)
struct XcdBarrier {
  unsigned* bar;
  unsigned x;
  volatile LAS unsigned* st;
};
DI XcdBarrier xcd_barrier_post(unsigned* bar, volatile LAS unsigned* st) {
  XcdBarrier b;
  b.bar = bar;
  b.x = xb_xcc_id();
  b.st = st;
  if (threadIdx.x == 0) (void)xb_add(&bar[XB_XCNT(b.x)], 1u);
  return b;
}
DI void xcd_barrier_complete(unsigned* bar, unsigned x, unsigned& nloc, unsigned& nx) {
  const unsigned G = gridDim.x * gridDim.y * gridDim.z;
  unsigned sum, cnt, mine, sp = 0u;
  for (;;) {
    sum = 0u;
    cnt = 0u;
    mine = 0u;
#pragma unroll
    for (unsigned j = 0; j < 16; ++j) {
      const unsigned c = xb_ld(&bar[XB_XCNT(j)]);
      sum += c;
      cnt += (c > 0u) ? 1u : 0u;
      mine = (j == x) ? c : mine;
    }
    if (sum == G) break;
    __builtin_amdgcn_s_sleep(1);
    if ((++sp & 255u) == 0u) {
      if (xb_ld(&bar[XB_TMO])) break;
      if (sp > XB_SPIN_CAP) {
        atomicAdd(&bar[XB_TMO], 1u);
        break;
      }
    }
  }
  nloc = mine > 0u ? mine : 1u;
  nx = cnt > 0u ? cnt : 1u;
}
DI void xcd_barrier(const XcdBarrier& b) {
  asm volatile("s_waitcnt vmcnt(0)" ::: "memory");
  __syncthreads();
  if (threadIdx.x == 0) {
    unsigned* bar = b.bar;
    __builtin_amdgcn_s_waitcnt(0);
    unsigned nloc = b.st[0], nx = b.st[1];
    if (nloc == 0u) {
      xcd_barrier_complete(bar, b.x, nloc, nx);
      b.st[0] = nloc;
      b.st[1] = nx;
    }
    const unsigned old = xb_add(&bar[XB_XSUB(b.x)], 1u);
    const unsigned gen = old / nloc;
    if (old + 1u == (gen + 1u) * nloc) {
      __builtin_amdgcn_fence(__ATOMIC_RELEASE, "agent");
      asm volatile("s_waitcnt vmcnt(0)" ::: "memory");
      const unsigned og = xb_add(&bar[XB_TOP], 1u);
      const unsigned tg = og / nx;
      if (og + 1u == (tg + 1u) * nx) xb_add(&bar[XB_TOPGEN], 1u);
      else XB_SPIN(xb_ld(&bar[XB_TOPGEN]) == tg, bar);
      __builtin_amdgcn_fence(__ATOMIC_ACQUIRE, "agent");
      xb_add(&bar[XB_XGEN(b.x)], 1u);
      asm volatile("s_waitcnt vmcnt(0)" ::: "memory");
    } else {
      XB_SPIN(xb_ld(&bar[XB_XGEN(b.x)]) == gen, bar);
      __builtin_amdgcn_fence(__ATOMIC_ACQUIRE, "agent");
      asm volatile("s_waitcnt vmcnt(0)" ::: "memory");
    }
  }
  __syncthreads();
}

DI void run_phase(const Params& P, int ph, char* smem, int rep) {
  char* ws = wsp(P);
  float* ssq = (float*)(ws + OFF_SSQ);
  bf16_t* xb = (bf16_t*)(ws + OFF_XB);
  bf16_t* obuf = (bf16_t*)(ws + OFF_OBUF);
  bf16_t* act = (bf16_t*)(ws + OFF_R);
  if (ph == 0) {
    init_phase(P);
    prep_layer(P, 0, smem);
    return;
  }
  int L, lp;
  if (ph <= 8) { L = 0; lp = ph - 1; }
  else if (ph <= 18) { L = 1; lp = ph - 10; }
  else if (ph <= 28) { L = 2; lp = ph - 20; }
  else { L = 3; lp = ph - 30; }
  if (lp < 0) {
    prep_layer(P, L, smem);
    return;
  }
  const int nmix = (L == 0) ? 2 : (L == 1 ? 3 : (L == 2 ? 3 : 1));
  const float* s0 = ssq + (size_t)(3 * L) * M_ * 16;
  const float* s1 = s0 + (size_t)M_ * 16;
  const float* s2 = s1 + (size_t)M_ * 16;
  if (lp == 0 || lp == 4 + nmix) {
    const bool f2 = lp != 0;
    EpiFfn1 e;
    e.ssq = f2 ? s2 : s0;
    e.act = act;
    gemm_phase<2>((const bf16_t*)(ws + (f2 ? OFF_W2 : OFF_W1)), 2 * F_, xb, D_, D_, smem, e);
  } else if (lp == 1 || lp == 5 + nmix) {
    const bool f2 = lp != 1;
    EpiResid e;
    e.xin = (L == 0 && !f2 && !rep) ? inp(P, 0) : outp(P);
    e.xout = outp(P);
    e.xb = xb;
    e.ssqn = ssq + (size_t)(3 * L + (f2 ? 3 : 1)) * M_ * 16;
    e.scale = rep ? 0.f : 0.5f;
    gemm_phase<2>((const bf16_t*)(ws + (f2 ? OFF_W2D : OFF_W1D)), D_, act, F_, F_, smem, e);
  } else if (lp == 3 + nmix) {
    EpiResid e;
    e.xin = outp(P);
    e.xout = outp(P);
    e.xb = xb;
    e.ssqn = ssq + (size_t)(3 * L + 2) * M_ * 16;
    e.scale = rep ? 0.f : 1.f;
    gemm_phase<2>((const bf16_t*)(ws + OFF_WMO), D_, obuf, D_, D_, smem, e);
  } else if (lp == 2) {
    const bf16_t* wmi = (const bf16_t*)(ws + OFF_WMI);
    char* R = ws + OFF_R;
    if (L == 0 || L == 3) {
      EpiQKV e;
      e.ssq = s1;
      e.gq = inp(P, 10);
      e.gk = inp(P, 11);
      e.bfv = inp(P, 9);
      e.Q = (bf16_t*)R;
      e.K = (bf16_t*)(R + 64 * MiB);
      e.VT = (bf16_t*)(R + 128 * MiB);
      e.obuf = obuf;
      e.flog = (float*)(ws + OFF_FLOG);
      e.fox = (L == 0);
      gemm_phase<2>(wmi, L == 0 ? 4224 : 3072, xb, D_, D_, smem, e);
    } else if (L == 1) {
      EpiNSA e;
      e.ssq = s1;
      e.gq = inp(P, 18);
      e.gk = inp(P, 19);
      e.Q = (bf16_t*)R;
      e.KC = (bf16_t*)(R + 64 * MiB);
      e.KS = (bf16_t*)(R + 80 * MiB);
      e.KW = (bf16_t*)(R + 96 * MiB);
      e.VC = (bf16_t*)(R + 112 * MiB);
      e.VST = (bf16_t*)(R + 128 * MiB);
      e.VWT = (bf16_t*)(R + 144 * MiB);
      e.gates = (float*)(ws + OFF_GATES);
      gemm_phase<1>(wmi, 2688, xb, D_, D_, smem, e);
    } else {
      EpiGLA e;
      e.ssq = s1;
      e.QG = (bf16_t*)R;
      e.KG = (bf16_t*)(R + 32 * MiB);
      e.VTG = (bf16_t*)(R + 64 * MiB);
      e.obuf = obuf;
      e.glow = (float*)(ws + OFF_GLOW);
      gemm_phase<2>(wmi, 3200, xb, D_, D_, smem, e);
    }
  } else {
    const int mp = lp - 3;
    if (L == 0) {
      if (mp == 0) {
        fox_scan_phase(P, smem);
      }
      else {
        fox_attn_phase(P, smem, rep);
      }
    } else if (L == 1) {
      if (mp == 0) nsa_compress_phase(P, smem);
      else if (mp == 1) nsa_cmp_phase(P, smem);
      else {
        nsa_attn_phase(P, smem, rep);
      }
    } else if (L == 2) {
      if (mp == 0) gla_u_phase(P, smem);
      else if (mp == 1) gla_scan_phase(P, rep);
      else gla_out_phase(P, smem, rep);
    } else {
      sb_attn_phase(P, smem);
    }
  }
}

__global__ void __launch_bounds__(256, 2) mega_kernel(Params P, int ph_lo, int ph_hi) {
  __shared__ __attribute__((aligned(16))) char smem[57344];
  __shared__ __attribute__((aligned(16))) unsigned xbw[4];
  if (threadIdx.x == 0) { xbw[0] = 0u; xbw[1] = 0u; xbw[2] = 0u; xbw[3] = 0u; }
  __syncthreads();
  XcdBarrier xb = xcd_barrier_post((unsigned*)(P.ws + OFF_XBAR), (volatile LAS unsigned*)xbw);
  for (int ph = ph_lo; ph < ph_hi; ++ph) {
    run_phase(P, ph, smem, 0);
    if (ph + 1 < ph_hi) {
      if (ph == ph_lo) {
        asm volatile("s_waitcnt vmcnt(0)" ::: "memory");
        cg::this_grid().sync();
        __builtin_amdgcn_fence(__ATOMIC_ACQUIRE, "agent");
        asm volatile("s_waitcnt vmcnt(0)" ::: "memory");
        __syncthreads();
      } else {
        xcd_barrier(xb);
      }
    }
  }
}

extern "C" void kernel_launch(void* const* d_in, const int* in_sizes, int n_in, void* d_out, int out_size, void* d_ws,
                              size_t ws_size, hipStream_t stream) {
  static int grid_blocks = 0;
  if (!grid_blocks) {
    int dev = 0, cus = 0, per_cu = 0;
    hipGetDevice(&dev);
    hipDeviceGetAttribute(&cus, hipDeviceAttributeMultiprocessorCount, dev);
    hipOccupancyMaxActiveBlocksPerMultiprocessor(&per_cu, mega_kernel, 256, 0);
    if (per_cu > 2) per_cu = 2;
    if (per_cu < 1) per_cu = 1;
    grid_blocks = cus * per_cu;
  }
  Params p{};
  for (int i = 0; i < 28; ++i) p.in[i] = (const float*)d_in[i];
  p.out = (float*)d_out;
  p.ws = (char*)d_ws;
  hipMemsetAsync((char*)d_ws + OFF_XBAR, 0, XCD_BAR_WORDS * sizeof(unsigned), stream);
#if ONE_LAUNCH
  int lo = 0, hi = NPH_RUN;
  void* args[] = {&p, &lo, &hi};
  hipError_t e = hipLaunchCooperativeKernel((void*)mega_kernel, dim3(grid_blocks), dim3(256), args, 0, stream);
  if (e != hipSuccess) fprintf(stderr, "cooperative launch failed: %s (grid %d)\n", hipGetErrorString(e), grid_blocks);
#else
  for (int ph = 0; ph < NPH_RUN; ++ph) mega_kernel<<<grid_blocks, 256, 0, stream>>>(p, ph, ph + 1);
#endif
}
```

```cpp
#include <hip/hip_runtime.h>
#include <hip/hip_cooperative_groups.h>
#include <cstdio>
namespace cg = cooperative_groups;

#ifndef ONE_LAUNCH
#define ONE_LAUNCH 1
#endif

#define ABL 0
#ifndef NPH_RUN
#define NPH_RUN 37
#endif
#define DI __device__ __forceinline__
typedef unsigned short bf16_t;
typedef __attribute__((ext_vector_type(8))) short bf16x8;
typedef __attribute__((ext_vector_type(4))) short bf16x4;
typedef __attribute__((ext_vector_type(16))) float f32x16;
typedef __attribute__((ext_vector_type(2))) __bf16 bf2_t;
typedef __attribute__((ext_vector_type(4))) unsigned u32x4;
typedef __attribute__((ext_vector_type(2))) unsigned u32x2;
typedef __attribute__((ext_vector_type(4))) float f32x4;
DI int tidx() { int t = threadIdx.x; asm volatile("" : "+v"(t)); return t; }
DI int bidx() { int t = blockIdx.x; asm volatile("" : "+s"(t)); return t; }

#define MFMA(a, b, c) __builtin_amdgcn_mfma_f32_32x32x16_bf16((a), (b), (c), 0, 0, 0)

constexpr int S_ = 8192;
constexpr int M_ = 32768;
constexpr int D_ = 1024;
constexpr int F_ = 2816;
constexpr int NPH = 37;
constexpr size_t MiB = 1048576;
constexpr size_t OFF_W1 = 0, OFF_W1D = 11 * MiB, OFF_W2 = 17 * MiB, OFF_W2D = 28 * MiB, OFF_WMI = 34 * MiB,
                 OFF_WMO = 43 * MiB, OFF_WCK = 45 * MiB, OFF_WCV = 46 * MiB;
constexpr size_t OFF_XB = 48 * MiB, OFF_OBUF = 112 * MiB, OFF_SSQ = 460 * MiB, OFF_FLOG = 178 * MiB, OFF_C = 180 * MiB,
                 OFF_GATES = 182 * MiB, OFF_SEL = 188 * MiB, OFF_GLOW = 190 * MiB, OFF_DECAY = 192 * MiB,
                 OFF_KCMP = 193 * MiB, OFF_VCMPT = 194 * MiB, OFF_CBIAS = 195 * MiB, OFF_XBAR = 196 * MiB, OFF_R = 200 * MiB;

struct Params {
  const float* in[28];
  float* out;
  char* ws;
};

#define GAS __attribute__((address_space(1)))
DI const float* inp(const Params& P, int k) {
  asm volatile("" : "+s"(k));
  GAS const float* p = (GAS const float*)P.in[k];
  asm volatile("" : "+s"(p));
  return (const float*)p;
}
DI char* wsp(const Params& P) {
  GAS char* w = (GAS char*)P.ws;
  asm volatile("" : "+s"(w));
  return (char*)w;
}
DI float* outp(const Params& P) {
  GAS float* w = (GAS float*)P.out;
  asm volatile("" : "+s"(w));
  return (float*)w;
}
DI unsigned pack2(float a, float b) {
  bf2_t v;
  v[0] = (__bf16)a;
  v[1] = (__bf16)b;
  return __builtin_bit_cast(unsigned, v);
}
DI bf16_t f2bf(float a) { return (bf16_t)(pack2(a, 0.f) & 0xffffu); }
DI float bf2f(bf16_t v) { return __uint_as_float(((unsigned)v) << 16); }
DI float bflo(unsigned u) { return __uint_as_float(u << 16); }
DI float bfhi(unsigned u) { return __uint_as_float(u & 0xffff0000u); }
DI int crow(int i, int h) { return (i & 3) + 8 * (i >> 2) + 4 * h; }
DI float sigmoidf_(float x) { return __builtin_amdgcn_rcpf(1.f + __expf(-x)); }
DI float logsigmoidf_(float z) { return fminf(z, 0.f) - log1pf(__expf(-fabsf(z))); }
DI float row_rstd(const float* ssq, int m) {
  const f32x4* p = (const f32x4*)(ssq + (size_t)m * 16);
  f32x4 a = p[0], b = p[1], c = p[2], d = p[3];
  float s = a.x;
  s += a.y; s += a.z; s += a.w;
  s += b.x; s += b.y; s += b.z; s += b.w;
  s += c.x; s += c.y; s += c.z; s += c.w;
  s += d.x; s += d.y; s += d.z; s += d.w;
  return rsqrtf(s * (1.f / 1024.f) + 1e-6f);
}
DI void store4bf(bf16_t* p, float a, float b, float c, float d) {
  u32x2 u;
  u.x = pack2(a, b);
  u.y = pack2(c, d);
  *(u32x2*)p = u;
}
DI bf16x8 pack8(float a0, float a1, float a2, float a3, float a4, float a5, float a6, float a7) {
  u32x4 u;
  u.x = pack2(a0, a1);
  u.y = pack2(a2, a3);
  u.z = pack2(a4, a5);
  u.w = pack2(a6, a7);
  return __builtin_bit_cast(bf16x8, u);
}
DI bf16x8 cat4(bf16x4 lo, bf16x4 hi) { return __builtin_shufflevector(lo, hi, 0, 1, 2, 3, 4, 5, 6, 7); }
DI void zero16(f32x16& v) {
#pragma unroll
  for (int i = 0; i < 16; ++i) v[i] = 0.f;
}

template <int MH>
DI void gemm_tile(const bf16_t* Wg, int ldw, const bf16_t* Xg, int ldx, int K, bf16_t* sW, bf16_t* sX,
                  f32x16 (&acc)[MH][2][2]) {
  const int tid = tidx(), lane = tid & 63, wave = tid >> 6, wn = wave >> 1, wm = wave & 1, r = lane & 31,
            h = lane >> 5;
#pragma unroll
  for (int a = 0; a < MH; ++a)
#pragma unroll
    for (int b = 0; b < 2; ++b)
#pragma unroll
      for (int c = 0; c < 2; ++c) zero16(acc[a][b][c]);
  u32x4 rw[4], rx[4 * MH];
  const int nk = K >> 6;
  const int row0 = tid >> 3, cc = tid & 7;
  const bf16_t* wp = Wg + (size_t)row0 * ldw + cc * 8;
  const bf16_t* xp = Xg + (size_t)row0 * ldx + cc * 8;
#pragma unroll
  for (int i = 0; i < 4; ++i) rw[i] = *(const u32x4*)(wp + (size_t)(32 * i) * ldw);
#pragma unroll
  for (int i = 0; i < 4 * MH; ++i) rx[i] = *(const u32x4*)(xp + (size_t)(32 * i) * ldx);
  for (int kt = 0; kt < nk; ++kt) {
    __syncthreads();
#pragma unroll
    for (int i = 0; i < 4; ++i) *(u32x4*)(sW + (row0 + 32 * i) * 72 + cc * 8) = rw[i];
#pragma unroll
    for (int i = 0; i < 4 * MH; ++i) *(u32x4*)(sX + (row0 + 32 * i) * 72 + cc * 8) = rx[i];
    __syncthreads();
    if (kt + 1 < nk) {
      const int k0 = (kt + 1) * 64;
#pragma unroll
      for (int i = 0; i < 4; ++i) rw[i] = *(const u32x4*)(wp + (size_t)(32 * i) * ldw + k0);
#pragma unroll
      for (int i = 0; i < 4 * MH; ++i) rx[i] = *(const u32x4*)(xp + (size_t)(32 * i) * ldx + k0);
    }
    __builtin_amdgcn_sched_barrier(0);
#pragma unroll
    for (int kk = 0; kk < 4; ++kk) {
      bf16x8 a0 = *(const bf16x8*)(sW + (wn * 64 + r) * 72 + kk * 16 + h * 8);
      bf16x8 a1 = *(const bf16x8*)(sW + (wn * 64 + 32 + r) * 72 + kk * 16 + h * 8);
#pragma unroll
      for (int mq = 0; mq < 2 * MH; ++mq) {
        bf16x8 b = *(const bf16x8*)(sX + (wm * 64 * MH + mq * 32 + r) * 72 + kk * 16 + h * 8);
        acc[mq >> 1][0][mq & 1] = MFMA(a0, b, acc[mq >> 1][0][mq & 1]);
        acc[mq >> 1][1][mq & 1] = MFMA(a1, b, acc[mq >> 1][1][mq & 1]);
      }
    }
  }
}

template <int MH, class Epi>
DI void gemm_phase(const bf16_t* Wt, int Npad, const bf16_t* X, int ldx, int K, char* smem, const Epi& epi) {
  bf16_t* sW = (bf16_t*)smem;
  bf16_t* sX = sW + 128 * 72;
  const int NT = Npad >> 7, MT = M_ / (128 * MH);
  const int wave = tidx() >> 6, wn = wave >> 1, wm = wave & 1;
  const int nblk = gridDim.x;
  const int lb = ((nblk & 7) == 0) ? ((bidx() & 7) * (nblk >> 3) + (bidx() >> 3)) : bidx();
  for (int t = lb; t < NT * MT; t += nblk) {
    const int nt = t % NT, mt = t / NT;
    f32x16 acc[MH][2][2];
    gemm_tile<MH>(Wt + (size_t)nt * 128 * K, K, X + (size_t)mt * 128 * MH * ldx, ldx, K, sW, sX, acc);
#pragma unroll
    for (int mh = 0; mh < MH; ++mh) epi(acc[mh], nt * 128 + wn * 64, mt * 128 * MH + wm * 64 * MH + mh * 64);
  }
}

struct EpiFfn1 {
  const float* ssq;
  bf16_t* act;
  DI void operator()(f32x16 (&acc)[2][2], int nb, int mb) const {
    const int lane = tidx() & 63, r = lane & 31, h = lane >> 5;
    const int jb = (nb >> 6) * 32;
#pragma unroll
    for (int mi = 0; mi < 2; ++mi) {
      const int m = mb + mi * 32 + r;
      const float rstd = row_rstd(ssq, m);
#pragma unroll
      for (int a = 0; a < 4; ++a) {
        float v[4];
#pragma unroll
        for (int q = 0; q < 4; ++q) {
          float g = acc[0][mi][4 * a + q] * rstd, u = acc[1][mi][4 * a + q] * rstd;
          v[q] = g * sigmoidf_(g) * u;
        }
        store4bf(act + (size_t)m * F_ + jb + 8 * a + 4 * h, v[0], v[1], v[2], v[3]);
      }
    }
  }
};

struct EpiResid {
  const float* xin;
  float* xout;
  bf16_t* xb;
  float* ssqn;
  float scale;
  DI void operator()(f32x16 (&acc)[2][2], int nb, int mb) const {
    const int lane = tidx() & 63, r = lane & 31, h = lane >> 5;
#pragma unroll
    for (int mi = 0; mi < 2; ++mi) {
      const int m = mb + mi * 32 + r;
      float part = 0.f;
#pragma unroll
      for (int ni = 0; ni < 2; ++ni)
#pragma unroll
        for (int a = 0; a < 4; ++a) {
          const int n = nb + ni * 32 + 8 * a + 4 * h;
          f32x4 xi = *(const f32x4*)(xin + (size_t)m * D_ + n);
          f32x4 xo;
          xo.x = xi.x + scale * acc[ni][mi][4 * a + 0];
          xo.y = xi.y + scale * acc[ni][mi][4 * a + 1];
          xo.z = xi.z + scale * acc[ni][mi][4 * a + 2];
          xo.w = xi.w + scale * acc[ni][mi][4 * a + 3];
          *(f32x4*)(xout + (size_t)m * D_ + n) = xo;
          store4bf(xb + (size_t)m * D_ + n, xo.x, xo.y, xo.z, xo.w);
          part += xo.x * xo.x + xo.y * xo.y + xo.z * xo.z + xo.w * xo.w;
        }
      part += __shfl_xor(part, 32);
      if (h == 0) ssqn[(size_t)m * 16 + (nb >> 6)] = part;
    }
  }
};

struct EpiQKV {
  const float* ssq;
  const float* gq;
  const float* gk;
  const float* bfv;
  bf16_t* Q;
  bf16_t* K;
  bf16_t* VT;
  bf16_t* obuf;
  float* flog;
  int fox;
  DI void operator()(f32x16 (&acc)[2][2], int nb, int mb) const {
    const int lane = tidx() & 63, r = lane & 31, h = lane >> 5;
#pragma unroll
    for (int mi = 0; mi < 2; ++mi) {
      const int m = mb + mi * 32 + r, b = m >> 13, t = m & 8191;
      const float rstd = row_rstd(ssq, m);
      if (nb < 2048) {
        const int isk = nb >= 1024, hh = (nb & 1023) >> 6;
        float v[2][16];
        float ss = 0.f;
#pragma unroll
        for (int ni = 0; ni < 2; ++ni)
#pragma unroll
          for (int i = 0; i < 16; ++i) {
            v[ni][i] = acc[ni][mi][i] * rstd;
            ss += v[ni][i] * v[ni][i];
          }
        if (fox) {
          ss += __shfl_xor(ss, 32);
          const float rinv = rsqrtf(ss * (1.f / 64.f) + 1e-6f);
          const float* g = isk ? gk : gq;
#pragma unroll
          for (int ni = 0; ni < 2; ++ni)
#pragma unroll
            for (int i = 0; i < 16; ++i) v[ni][i] *= rinv * g[ni * 32 + crow(i, h)];
        }
        bf16_t* dst = (isk ? K : Q) + ((size_t)(b * 16 + hh) * S_ + t) * 64;
#pragma unroll
        for (int ni = 0; ni < 2; ++ni)
#pragma unroll
          for (int a = 0; a < 4; ++a)
            store4bf(dst + ni * 32 + 8 * a + 4 * h, v[ni][4 * a], v[ni][4 * a + 1], v[ni][4 * a + 2], v[ni][4 * a + 3]);
      } else if (nb < 3072) {
        const int hh = (nb - 2048) >> 6;
#pragma unroll
        for (int ni = 0; ni < 2; ++ni)
#pragma unroll
          for (int i = 0; i < 16; ++i) {
            const int d = ni * 32 + crow(i, h);
            VT[((size_t)(b * 16 + hh) * 64 + d) * S_ + t] = f2bf(acc[ni][mi][i] * rstd);
          }
      } else if (fox && nb < 4096) {
        const int hh = (nb - 3072) >> 6;
#pragma unroll
        for (int ni = 0; ni < 2; ++ni)
#pragma unroll
          for (int a = 0; a < 4; ++a)
            store4bf(obuf + (size_t)m * D_ + hh * 64 + ni * 32 + 8 * a + 4 * h, sigmoidf_(acc[ni][mi][4 * a] * rstd),
                     sigmoidf_(acc[ni][mi][4 * a + 1] * rstd), sigmoidf_(acc[ni][mi][4 * a + 2] * rstd),
                     sigmoidf_(acc[ni][mi][4 * a + 3] * rstd));
      } else if (fox && nb == 4096) {
#pragma unroll
        for (int i = 0; i < 8; ++i) {
          const int hh = crow(i, h);
          flog[(size_t)(b * 16 + hh) * S_ + t] = logsigmoidf_(acc[0][mi][i] * rstd + bfv[hh]);
        }
      }
    }
  }
};

struct EpiNSA {
  const float* ssq;
  const float* gq;
  const float* gk;
  bf16_t* Q;
  bf16_t* KC;
  bf16_t* KS;
  bf16_t* KW;
  bf16_t* VC;
  bf16_t* VST;
  bf16_t* VWT;
  float* gates;
  DI void operator()(f32x16 (&acc)[2][2], int nb, int mb) const {
    const int lane = tidx() & 63, r = lane & 31, h = lane >> 5;
    if (nb > 2560) return;
#pragma unroll
    for (int mi = 0; mi < 2; ++mi) {
      const int m = mb + mi * 32 + r, b = m >> 13, t = m & 8191;
      const float rstd = row_rstd(ssq, m);
      if (nb == 2560) {
#pragma unroll
        for (int ni = 0; ni < 2; ++ni)
#pragma unroll
          for (int i = 0; i < 16; ++i) {
            const int nl = ni * 32 + crow(i, h);
            if (nl < 48) gates[(size_t)m * 48 + nl] = sigmoidf_(acc[ni][mi][i] * rstd);
          }
        continue;
      }
      int seg = -1, hh;
      if (nb < 1024) {
        hh = nb >> 6;
      } else {
        seg = (nb - 1024) >> 8;
        hh = ((nb - 1024) & 255) >> 6;
      }
      const int kv = b * 4 + hh;
      if (seg == 1) {
        bf16_t* dst = VC + ((size_t)kv * S_ + t) * 64;
#pragma unroll
        for (int ni = 0; ni < 2; ++ni)
#pragma unroll
          for (int a = 0; a < 4; ++a)
            store4bf(dst + ni * 32 + 8 * a + 4 * h, acc[ni][mi][4 * a] * rstd, acc[ni][mi][4 * a + 1] * rstd,
                     acc[ni][mi][4 * a + 2] * rstd, acc[ni][mi][4 * a + 3] * rstd);
      } else if (seg == 3 || seg == 5) {
        bf16_t* dst = (seg == 3 ? VST : VWT);
#pragma unroll
        for (int ni = 0; ni < 2; ++ni)
#pragma unroll
          for (int i = 0; i < 16; ++i) {
            const int d = ni * 32 + crow(i, h);
            dst[((size_t)kv * 64 + d) * S_ + t] = f2bf(acc[ni][mi][i] * rstd);
          }
      } else {
        float v[2][16];
        float ss = 0.f;
#pragma unroll
        for (int ni = 0; ni < 2; ++ni)
#pragma unroll
          for (int i = 0; i < 16; ++i) {
            v[ni][i] = acc[ni][mi][i] * rstd;
            ss += v[ni][i] * v[ni][i];
          }
        ss += __shfl_xor(ss, 32);
        const float rinv = rsqrtf(ss * (1.f / 64.f) + 1e-6f);
        const float* g = (seg < 0) ? gq : gk;
        const float tf = (float)t;
#pragma unroll
        for (int i = 0; i < 16; ++i) {
          const int fi = crow(i, h);
          const float x1 = v[0][i] * rinv * g[fi], x2 = v[1][i] * rinv * g[32 + fi];
          const float inv = exp2f(-(float)fi * 0.41524101186092034f);
          const float ang = tf * inv;
          const float Chi = 0.15915494f, Clo = 6.4206383e-9f;
          const float p = ang * Chi;
          const float e = __builtin_fmaf(ang, Chi, -p);
          const float fr = (p - floorf(p)) + (e + ang * Clo);
          const float sn = __builtin_amdgcn_sinf(fr), cs = __builtin_amdgcn_cosf(fr);
          v[0][i] = x1 * cs - x2 * sn;
          v[1][i] = x2 * cs + x1 * sn;
          if ((i & 1) == 1) __builtin_amdgcn_sched_barrier(0);
        }
        bf16_t* dst;
        if (seg < 0)
          dst = Q + ((size_t)(b * 16 + hh) * S_ + t) * 64;
        else
          dst = (seg == 0 ? KC : (seg == 2 ? KS : KW)) + ((size_t)kv * S_ + t) * 64;
#pragma unroll
        for (int ni = 0; ni < 2; ++ni)
#pragma unroll
          for (int a = 0; a < 4; ++a)
            store4bf(dst + ni * 32 + 8 * a + 4 * h, v[ni][4 * a], v[ni][4 * a + 1], v[ni][4 * a + 2], v[ni][4 * a + 3]);
      }
    }
  }
};

struct EpiGLA {
  const float* ssq;
  bf16_t* QG;
  bf16_t* KG;
  bf16_t* VTG;
  bf16_t* obuf;
  float* glow;
  DI void operator()(f32x16 (&acc)[2][2], int nb, int mb) const {
    const int lane = tidx() & 63, r = lane & 31, h = lane >> 5;
    if (nb > 3072) return;
#pragma unroll
    for (int mi = 0; mi < 2; ++mi) {
      const int m = mb + mi * 32 + r, b = m >> 13, t = m & 8191;
      const float rstd = row_rstd(ssq, m);
      if (nb < 1024) {
        bf16_t* dst = (nb < 512 ? QG + (size_t)m * 512 + nb : KG + (size_t)m * 512 + (nb - 512));
#pragma unroll
        for (int ni = 0; ni < 2; ++ni)
#pragma unroll
          for (int a = 0; a < 4; ++a)
            store4bf(dst + ni * 32 + 8 * a + 4 * h, acc[ni][mi][4 * a] * rstd, acc[ni][mi][4 * a + 1] * rstd,
                     acc[ni][mi][4 * a + 2] * rstd, acc[ni][mi][4 * a + 3] * rstd);
      } else if (nb < 2048) {
#pragma unroll
        for (int ni = 0; ni < 2; ++ni)
#pragma unroll
          for (int i = 0; i < 16; ++i) {
            const int e = nb - 1024 + ni * 32 + crow(i, h);
            VTG[((size_t)b * 1024 + e) * S_ + t] = f2bf(acc[ni][mi][i] * rstd);
          }
      } else if (nb < 3072) {
#pragma unroll
        for (int ni = 0; ni < 2; ++ni)
#pragma unroll
          for (int a = 0; a < 4; ++a) {
            float v[4];
#pragma unroll
            for (int q = 0; q < 4; ++q) {
              float z = acc[ni][mi][4 * a + q] * rstd;
              v[q] = z * sigmoidf_(z);
            }
            store4bf(obuf + (size_t)m * D_ + (nb - 2048) + ni * 32 + 8 * a + 4 * h, v[0], v[1], v[2], v[3]);
          }
      } else {
#pragma unroll
        for (int i = 0; i < 8; ++i) glow[(size_t)m * 16 + crow(i, h)] = acc[0][mi][i] * rstd;
      }
    }
  }
};

struct EpiCmp {
  const float* cb;
  const float* gk;
  bf16_t* dst;
  int isv;
  DI void operator()(f32x16 (&acc)[2][2], int nb, int mb) const {
    const int lane = tidx() & 63, r = lane & 31, h = lane >> 5;
    if (nb != 0) return;
#pragma unroll
    for (int mi = 0; mi < 2; ++mi) {
      const int n = mb + mi * 32 + r;
      const bool ok = n < 511;
      float v[2][16];
      float ss = 0.f;
#pragma unroll
      for (int ni = 0; ni < 2; ++ni)
#pragma unroll
        for (int i = 0; i < 16; ++i) {
          v[ni][i] = ok ? acc[ni][mi][i] + cb[ni * 32 + crow(i, h)] : 0.f;
          ss += v[ni][i] * v[ni][i];
        }
      if (!isv) {
        ss += __shfl_xor(ss, 32);
        const float rinv = rsqrtf(ss * (1.f / 64.f) + 1e-6f);
#pragma unroll
        for (int ni = 0; ni < 2; ++ni)
#pragma unroll
          for (int a = 0; a < 4; ++a) {
            const int e = ni * 32 + 8 * a + 4 * h;
            store4bf(dst + (size_t)n * 64 + e, v[ni][4 * a] * rinv * gk[e], v[ni][4 * a + 1] * rinv * gk[e + 1],
                     v[ni][4 * a + 2] * rinv * gk[e + 2], v[ni][4 * a + 3] * rinv * gk[e + 3]);
          }
      } else {
#pragma unroll
        for (int ni = 0; ni < 2; ++ni)
#pragma unroll
          for (int i = 0; i < 16; ++i) dst[(size_t)(ni * 32 + crow(i, h)) * 512 + n] = f2bf(v[ni][i]);
      }
    }
  }
};

template <class Src>
DI void prep_job(bf16_t* dst, int Npad, int K, float* sT, Src src) {
  const int tid = tidx();
  const int NT = Npad >> 6, KT = K >> 6;
  for (int t = bidx(); t < NT * KT; t += gridDim.x) {
    const int nt = t % NT, kt = t / NT;
    __syncthreads();
#pragma unroll 4
    for (int i = 0; i < 16; ++i) {
      const int e = tid + 256 * i, kk = e >> 6, nn = e & 63;
      sT[kk * 65 + nn] = src(kt * 64 + kk, nt * 64 + nn);
    }
    __syncthreads();
#pragma unroll 4
    for (int i = 0; i < 8; ++i) {
      const int e = tid + 256 * i, nn = e >> 5, kp = e & 31;
      *(unsigned*)(dst + (size_t)(nt * 64 + nn) * K + kt * 64 + 2 * kp) = pack2(sT[(2 * kp) * 65 + nn], sT[(2 * kp + 1) * 65 + nn]);
    }
  }
}

DI void prep_layer(const Params& P, int L, char* smem) {
  float* sT = (float*)smem;
  char* ws = wsp(P);
  const float* ng = inp(P, 1) + (size_t)L * 3 * D_;
  for (int f = 0; f < 2; ++f) {
    const float* wg = inp(P, f ? 5 : 2) + (size_t)L * D_ * F_;
    const float* wu = inp(P, f ? 6 : 3) + (size_t)L * D_ * F_;
    const float* wd = inp(P, f ? 7 : 4) + (size_t)L * D_ * F_;
    const float* g = ng + (f ? 2 * D_ : 0);
    prep_job((bf16_t*)(ws + (f ? OFF_W2 : OFF_W1)), 2 * F_, D_, sT, [=](int k, int n) {
      const int grp = n >> 6, rr = n & 63;
      const float* s = rr < 32 ? wg : wu;
      return s[(size_t)k * F_ + grp * 32 + (rr & 31)] * g[k];
    });
    prep_job((bf16_t*)(ws + (f ? OFF_W2D : OFF_W1D)), D_, F_, sT, [=](int k, int n) { return wd[(size_t)k * D_ + n]; });
  }
  const float* g1 = ng + D_;
  bf16_t* wmi = (bf16_t*)(ws + OFF_WMI);
  bf16_t* wmo = (bf16_t*)(ws + OFF_WMO);
  if (L == 0) {
    const float* w = inp(P, 8);
    prep_job(wmi, 4224, D_, sT, [=](int k, int n) {
      int c = n < 3072 ? n : (n < 4096 ? n + 16 : (n < 4112 ? n - 1024 : -1));
      return c < 0 ? 0.f : w[(size_t)k * 4112 + c] * g1[k];
    });
    const float* wo = inp(P, 12);
    prep_job(wmo, D_, D_, sT, [=](int k, int n) { return wo[(size_t)k * D_ + n]; });
  } else if (L == 1) {
    const float* w = inp(P, 13);
    prep_job(wmi, 2688, D_, sT, [=](int k, int n) { return n < 2608 ? w[(size_t)k * 2608 + n] * g1[k] : 0.f; });
    const float* wo = inp(P, 20);
    prep_job(wmo, D_, D_, sT, [=](int k, int n) { return wo[(size_t)k * D_ + n]; });
    const float* wck = inp(P, 16);
    const float* wcv = inp(P, 17);
    prep_job((bf16_t*)(ws + OFF_WCK), 128, 2048, sT, [=](int k, int n) { return n < 64 ? wck[(size_t)k * 64 + n] : 0.f; });
    prep_job((bf16_t*)(ws + OFF_WCV), 128, 2048, sT, [=](int k, int n) { return n < 64 ? wcv[(size_t)k * 64 + n] : 0.f; });
    if (bidx() == 0 && tidx() < 128) {
      const int e = tidx() & 63, which = tidx() >> 6;
      const float* pos = which ? inp(P, 15) : inp(P, 14);
      const float* wc = which ? inp(P, 17) : inp(P, 16);
      float s = 0.f;
      for (int kd = 0; kd < 2048; ++kd) s += pos[kd] * wc[(size_t)kd * 64 + e];
      ((float*)(ws + OFF_CBIAS))[which * 64 + e] = s;
    }
  } else if (L == 2) {
    const float* w = inp(P, 21);
    prep_job(wmi, 3200, D_, sT, [=](int k, int n) {
      int c = n < 2048 ? n : (n < 3072 ? n + 16 : (n < 3088 ? n - 1024 : -1));
      return c < 0 ? 0.f : w[(size_t)k * 3088 + c] * g1[k];
    });
    const float* wo = inp(P, 25);
    prep_job(wmo, D_, D_, sT, [=](int k, int n) { return wo[(size_t)k * D_ + n]; });
  } else {
    const float* w = inp(P, 26);
    prep_job(wmi, 3072, D_, sT, [=](int k, int n) { return w[(size_t)k * 3072 + n] * g1[k]; });
    const float* wo = inp(P, 27);
    prep_job(wmo, D_, D_, sT, [=](int k, int n) { return wo[(size_t)k * D_ + n]; });
  }
}

DI void init_phase(const Params& P) {
  const int tid = tidx(), lane = tid & 63, wave = tid >> 6;
  float* ssq = (float*)(wsp(P) + OFF_SSQ);
  bf16_t* xb = (bf16_t*)(wsp(P) + OFF_XB);
  const float* x = inp(P, 0);
  for (int row = bidx() * 4 + wave; row < M_; row += gridDim.x * 4) {
    float s = 0.f;
#pragma unroll
    for (int i = 0; i < 4; ++i) {
      const int c = (i * 64 + lane) * 4;
      f32x4 v = *(const f32x4*)(x + (size_t)row * D_ + c);
      s += v.x * v.x + v.y * v.y + v.z * v.z + v.w * v.w;
      store4bf(xb + (size_t)row * D_ + c, v.x, v.y, v.z, v.w);
    }
#pragma unroll
    for (int o = 32; o >= 1; o >>= 1) s += __shfl_xor(s, o);
    if (lane < 16) ssq[(size_t)row * 16 + lane] = (lane == 0) ? s : 0.f;
  }
}

struct AttnSmem {
  bf16_t k[64 * 72];
  bf16_t v[64 * 72];
  float c[64];
};

DI void attn_load(const bf16_t* Kb, int ldk, const bf16_t* VTb, int ldv, int j, u32x4 (&kr)[2], u32x4 (&vr)[2]) {
  const int tid = tidx();
#pragma unroll
  for (int i = 0; i < 2; ++i) {
    const int c = tid + 256 * i, row = c >> 3, cc = c & 7;
    kr[i] = *(const u32x4*)(Kb + (size_t)(j * 64 + row) * ldk + cc * 8);
    vr[i] = *(const u32x4*)(VTb + (size_t)row * ldv + j * 64 + cc * 8);
  }
}
DI void attn_store(AttnSmem& sm, const u32x4 (&kr)[2], const u32x4 (&vr)[2]) {
  const int tid = tidx();
#pragma unroll
  for (int i = 0; i < 2; ++i) {
    const int c = tid + 256 * i, row = c >> 3, cc = c & 7;
    *(u32x4*)(sm.k + row * 72 + cc * 8) = kr[i];
    *(u32x4*)(sm.v + row * 72 + cc * 8) = vr[i];
  }
}
DI void attn_qk(const AttnSmem& sm, const bf16x8 (&qf)[4], f32x16 (&st)[2]) {
  const int lane = tidx() & 63, r = lane & 31, h = lane >> 5;
#pragma unroll
  for (int kt = 0; kt < 2; ++kt) {
    zero16(st[kt]);
#pragma unroll
    for (int kk = 0; kk < 4; ++kk) {
      bf16x8 a = *(const bf16x8*)(sm.k + (kt * 32 + r) * 72 + kk * 16 + h * 8);
      st[kt] = MFMA(a, qf[kk], st[kt]);
    }
  }
}
DI void attn_pv(const AttnSmem& sm, const f32x16 (&st)[2], f32x16 (&o)[2]) {
  const int lane = tidx() & 63, r = lane & 31, h = lane >> 5;
#pragma unroll
  for (int kt = 0; kt < 2; ++kt)
#pragma unroll
    for (int s2 = 0; s2 < 2; ++s2) {
      bf16x8 pk = pack8(st[kt][8 * s2], st[kt][8 * s2 + 1], st[kt][8 * s2 + 2], st[kt][8 * s2 + 3], st[kt][8 * s2 + 4],
                        st[kt][8 * s2 + 5], st[kt][8 * s2 + 6], st[kt][8 * s2 + 7]);
#pragma unroll
      for (int dt = 0; dt < 2; ++dt) {
        const bf16_t* p = sm.v + (dt * 32 + r) * 72 + kt * 32 + 16 * s2 + 4 * h;
        bf16x8 a = cat4(*(const bf16x4*)p, *(const bf16x4*)(p + 8));
        o[dt] = MFMA(a, pk, o[dt]);
      }
    }
}
DI void load_qf(const bf16_t* Qrow, bf16x8 (&qf)[4]) {
  const int h = (tidx() & 63) >> 5;
#pragma unroll
  for (int kk = 0; kk < 4; ++kk) qf[kk] = *(const bf16x8*)(Qrow + kk * 16 + h * 8);
}

template <int MODE>
DI void flash_pass(const bf16_t* Kb, const bf16_t* VTb, const float* cB, float cq, u32x4 selw, int qw, int jlo, int jhi,
                   const bf16x8 (&qf)[4], f32x16 (&o)[2], float& lsum, AttnSmem& sm) {
  const int tid = tidx(), lane = tid & 63, r = lane & 31, h = lane >> 5;
  const int query = qw + r;
  float m_run = -1e30f, l_run = 0.f;
  zero16(o[0]);
  zero16(o[1]);
  u32x4 kr[2], vr[2];
  float cr = 0.f;
  attn_load(Kb, 64, VTb, S_, jlo, kr, vr);
  if (MODE == 0 && tid < 64) cr = cB[jlo * 64 + tid];
  for (int j = jlo; j <= jhi; ++j) {
    __syncthreads();
    attn_store(sm, kr, vr);
    if (MODE == 0 && tid < 64) sm.c[tid] = cr;
    __syncthreads();
    if (j < jhi) {
      attn_load(Kb, 64, VTb, S_, j + 1, kr, vr);
      if (MODE == 0 && tid < 64) cr = cB[(j + 1) * 64 + tid];
    }
    bool active = (j * 64 <= qw + 31);
    bool bit = true;
    if (MODE == 1) active = active && (j * 64 + 63 >= qw - 511);
    if (MODE == 2) {
      const int wi = j >> 5;
      const unsigned w = wi == 0 ? selw.x : (wi == 1 ? selw.y : (wi == 2 ? selw.z : selw.w));
      bit = (w >> (j & 31)) & 1u;
      active = active && (__ballot(bit) != 0ull);
    }
    if (active) {
      f32x16 st[2];
      attn_qk(sm, qf, st);
      const float SC = 0.125f * 1.4426950408889634f;
      const bool interior = (MODE != 0) && (j * 64 + 63 <= qw) && (MODE != 1 || (qw + 31 - j * 64 < 512));
      float mx = -1e30f;
      if (interior) {
#pragma unroll
        for (int kt = 0; kt < 2; ++kt)
#pragma unroll
          for (int i = 0; i < 16; ++i) {
            const float s = st[kt][i] * SC;
            st[kt][i] = s;
            mx = fmaxf(mx, s);
          }
        if (MODE == 2 && !bit) mx = -1e30f;
      } else {
#pragma unroll
        for (int kt = 0; kt < 2; ++kt)
#pragma unroll
          for (int i = 0; i < 16; ++i) {
            const int kl = kt * 32 + crow(i, h);
            const int key = j * 64 + kl;
            float s = st[kt][i] * SC;
            bool ok = key <= query;
            if (MODE == 0) s += (cq - sm.c[kl]) * 1.4426950408889634f;
            if (MODE == 1) ok = ok && (query - key < 512);
            if (MODE == 2) ok = ok && bit;
            s = ok ? s : -1e30f;
            st[kt][i] = s;
            mx = fmaxf(mx, s);
          }
      }
      mx = fmaxf(mx, __shfl_xor(mx, 32));
      const float m_new = fmaxf(m_run, mx);
      const float alpha = __builtin_amdgcn_exp2f(m_run - m_new);
      float ps = 0.f;
      if (interior) {
#pragma unroll
        for (int kt = 0; kt < 2; ++kt)
#pragma unroll
          for (int i = 0; i < 16; ++i) {
            float p = __builtin_amdgcn_exp2f(st[kt][i] - m_new);
            if (MODE == 2) p = bit ? p : 0.f;
            st[kt][i] = p;
            ps += p;
          }
      } else {
#pragma unroll
        for (int kt = 0; kt < 2; ++kt)
#pragma unroll
          for (int i = 0; i < 16; ++i) {
            const float s = st[kt][i];
            const float p = (s > -1e29f) ? __builtin_amdgcn_exp2f(s - m_new) : 0.f;
            st[kt][i] = p;
            ps += p;
          }
      }
      ps += __shfl_xor(ps, 32);
      l_run = l_run * alpha + ps;
      if (__ballot(m_new > m_run) != 0ull) {
#pragma unroll
        for (int dt = 0; dt < 2; ++dt)
#pragma unroll
          for (int i = 0; i < 16; ++i) o[dt][i] *= alpha;
      }
      m_run = m_new;
      attn_pv(sm, st, o);
    }
  }
  lsum = l_run;
}

DI void fox_pass(const bf16_t* Kb, const bf16_t* VTb, const float* cB, float cq, float sbound, int qw, int jhi,
                 const bf16x8 (&qf)[4], f32x16 (&o)[2], float& lsum, AttnSmem& sm) {
  const int tid = tidx(), lane = tid & 63, r = lane & 31, h = lane >> 5;
  const int query = qw + r;
  float m_run = -1e30f, l_run = 0.f;
  zero16(o[0]);
  zero16(o[1]);
  u32x4 kr[2], vr[2];
  float cr = 0.f;
  int done = 0;
  attn_load(Kb, 64, VTb, S_, jhi, kr, vr);
  if (tid < 64) cr = cB[jhi * 64 + tid];
  for (int j = jhi; j >= 0; --j) {
    if (__syncthreads_and(done)) break;
    attn_store(sm, kr, vr);
    if (tid < 64) sm.c[tid] = cr;
    __syncthreads();
    if (j > 0) {
      attn_load(Kb, 64, VTb, S_, j - 1, kr, vr);
      if (tid < 64) cr = cB[(j - 1) * 64 + tid];
    }
    if (j * 64 <= qw + 31) {
      f32x16 st[2];
      attn_qk(sm, qf, st);
      float mx = -1e30f;
#pragma unroll
      for (int kt = 0; kt < 2; ++kt)
#pragma unroll
        for (int i = 0; i < 16; ++i) {
          const int kl = kt * 32 + crow(i, h);
          const int key = j * 64 + kl;
          float s = st[kt][i] * 0.125f + (cq - sm.c[kl]);
          s = (key <= query) ? s : -1e30f;
          st[kt][i] = s;
          mx = fmaxf(mx, s);
        }
      mx = fmaxf(mx, __shfl_xor(mx, 32));
      const float m_new = fmaxf(m_run, mx);
      const float alpha = __expf(m_run - m_new);
      float ps = 0.f;
#pragma unroll
      for (int kt = 0; kt < 2; ++kt)
#pragma unroll
        for (int i = 0; i < 16; ++i) {
          const float s = st[kt][i];
          const float p = (s > -1e29f) ? __expf(s - m_new) : 0.f;
          st[kt][i] = p;
          ps += p;
        }
      ps += __shfl_xor(ps, 32);
      l_run = l_run * alpha + ps;
      m_run = m_new;
#pragma unroll
      for (int dt = 0; dt < 2; ++dt)
#pragma unroll
        for (int i = 0; i < 16; ++i) o[dt][i] *= alpha;
      attn_pv(sm, st, o);
      done = (sbound + cq - sm.c[0] < m_run - 104.f) ? 1 : 0;
    }
  }
  lsum = l_run;
}
DI void fox_scan_phase(const Params& P, char* smem) {
  double* sp = (double*)smem;
  const float* flog = (const float*)(wsp(P) + OFF_FLOG);
  float* c = (float*)(wsp(P) + OFF_C);
  const int tid = tidx();
  for (int seq = bidx(); seq < 64; seq += gridDim.x) {
    const float* src = flog + (size_t)seq * S_ + tid * 32;
    double tot = 0.0;
    for (int i = 0; i < 32; ++i) tot += (double)src[i];
    __syncthreads();
    sp[tid] = tot;
    __syncthreads();
    double pre = 0.0;
    for (int i = 0; i < tid; ++i) pre += sp[i];
    float* dst = c + (size_t)seq * S_ + tid * 32;
    for (int i = 0; i < 32; ++i) {
      pre += (double)src[i];
      dst[i] = (float)pre;
    }
  }
}

DI void fox_attn_phase(const Params& P, char* smem, int rep) {
  AttnSmem& sm = *(AttnSmem*)smem;
  const bf16_t* Q = (const bf16_t*)(wsp(P) + OFF_R);
  const bf16_t* K = Q + (size_t)M_ * D_;
  const bf16_t* VT = K + (size_t)M_ * D_;
  const float* c = (const float*)(wsp(P) + OFF_C);
  bf16_t* obuf = (bf16_t*)(wsp(P) + OFF_OBUF);
  const int lane = tidx() & 63, wave = tidx() >> 6, r = lane & 31, h = lane >> 5;
  float gqm = 0.f, gkm = 0.f;
  for (int d = 0; d < 64; ++d) {
    gqm = fmaxf(gqm, fabsf(inp(P, 10)[d]));
    gkm = fmaxf(gkm, fabsf(inp(P, 11)[d]));
  }
  const float sbound = 8.16f * gqm * gkm;
  for (int it = bidx(); it < 4096; it += gridDim.x) {
    const int qt = 63 - (it >> 6), bh = it & 63;
    const int q0 = qt * 128, qw = q0 + wave * 32, query = qw + r;
    bf16x8 qf[4];
    load_qf(Q + ((size_t)bh * S_ + query) * 64, qf);
    const float cq = c[(size_t)bh * S_ + query];
    f32x16 o[2];
    float l;
    fox_pass(K + (size_t)bh * S_ * 64, VT + (size_t)bh * 64 * S_, c + (size_t)bh * S_, cq, sbound, qw, 2 * qt + 1, qf, o, l, sm);
    const float inv = 1.f / l;
    const int b = bh >> 4, hh = bh & 15;
    bf16_t* dst = obuf + ((size_t)b * S_ + query) * D_ + hh * 64;
#pragma unroll
    for (int dt = 0; dt < 2; ++dt)
#pragma unroll
      for (int a = 0; a < 4; ++a) {
        bf16_t* p = dst + dt * 32 + 8 * a + 4 * h;
        u32x2 g = *(const u32x2*)p;
        if (rep) *(u32x2*)p = g;
        else
        store4bf(p, o[dt][4 * a] * inv * bflo(g.x), o[dt][4 * a + 1] * inv * bfhi(g.x), o[dt][4 * a + 2] * inv * bflo(g.y),
                 o[dt][4 * a + 3] * inv * bfhi(g.y));
      }
  }
}

DI void sb_attn_phase(const Params& P, char* smem) {
  AttnSmem& sm = *(AttnSmem*)smem;
  const bf16_t* Q = (const bf16_t*)(wsp(P) + OFF_R);
  const bf16_t* K = Q + (size_t)M_ * D_;
  const bf16_t* VT = K + (size_t)M_ * D_;
  bf16_t* obuf = (bf16_t*)(wsp(P) + OFF_OBUF);
  const int tid = tidx(), lane = tid & 63, wave = tid >> 6, r = lane & 31, h = lane >> 5;
  bf16x8 tdiag[2], ones;
#pragma unroll
  for (int s2 = 0; s2 < 2; ++s2)
#pragma unroll
    for (int jj = 0; jj < 8; ++jj) {
      const int kj = 16 * s2 + 8 * (jj >> 2) + 4 * h + (jj & 3);
      tdiag[s2][jj] = (kj > r) ? (short)0x3f80 : (short)0;
    }
#pragma unroll
  for (int jj = 0; jj < 8; ++jj) ones[jj] = (short)0x3f80;

  for (int it = bidx(); it < 4096; it += gridDim.x) {
    const int qt = 63 - (it >> 6), bh = it & 63;
    const int q0 = qt * 128, qw = q0 + wave * 32, query = qw + r;
    const bf16_t* Kb = K + (size_t)bh * S_ * 64;
    const bf16_t* VTb = VT + (size_t)bh * 64 * S_;
    bf16x8 qf[4];
    load_qf(Q + ((size_t)bh * S_ + query) * 64, qf);
    f32x16 o[2];
    zero16(o[0]);
    zero16(o[1]);
    float R = 0.f;
    u32x4 kr[2], vr[2];
    const int jhi = 2 * qt + 1;
    attn_load(Kb, 64, VTb, S_, jhi, kr, vr);
    for (int j = jhi; j >= 0; --j) {
      if (__syncthreads_and(R < -110.f)) break;
      attn_store(sm, kr, vr);
      __syncthreads();
      if (j > 0) attn_load(Kb, 64, VTb, S_, j - 1, kr, vr);
      if (j * 64 < qw + 31) {
        f32x16 st[2], Lv[2], lat[2];
        attn_qk(sm, qf, st);
        float tot = 0.f;
#pragma unroll
        for (int kt = 0; kt < 2; ++kt)
#pragma unroll
          for (int i = 0; i < 16; ++i) {
            const int key = j * 64 + kt * 32 + crow(i, h);
            const float z = st[kt][i] * 0.125f;
            const float sp = fmaxf(z, 0.f) + __logf(1.f + __expf(-fabsf(z)));
            const float L = (key < query) ? -sp : 0.f;
            st[kt][i] = z;
            Lv[kt][i] = L;
            tot += L;
          }
        tot += __shfl_xor(tot, 32);
        bf16x8 hi[2][2], lo[2][2];
#pragma unroll
        for (int kt = 0; kt < 2; ++kt)
#pragma unroll
          for (int s2 = 0; s2 < 2; ++s2) {
            float hv[8], lv[8];
#pragma unroll
            for (int q = 0; q < 8; ++q) {
              const float L = Lv[kt][8 * s2 + q];
              hv[q] = bf2f(f2bf(L));
              lv[q] = L - hv[q];
            }
            hi[kt][s2] = pack8(hv[0], hv[1], hv[2], hv[3], hv[4], hv[5], hv[6], hv[7]);
            lo[kt][s2] = pack8(lv[0], lv[1], lv[2], lv[3], lv[4], lv[5], lv[6], lv[7]);
          }
        zero16(lat[0]);
        zero16(lat[1]);
#pragma unroll
        for (int s2 = 0; s2 < 2; ++s2) {
          lat[0] = MFMA(tdiag[s2], hi[0][s2], lat[0]);
          lat[0] = MFMA(tdiag[s2], lo[0][s2], lat[0]);
          lat[0] = MFMA(ones, hi[1][s2], lat[0]);
          lat[0] = MFMA(ones, lo[1][s2], lat[0]);
          lat[1] = MFMA(tdiag[s2], hi[1][s2], lat[1]);
          lat[1] = MFMA(tdiag[s2], lo[1][s2], lat[1]);
        }
#pragma unroll
        for (int kt = 0; kt < 2; ++kt)
#pragma unroll
          for (int i = 0; i < 16; ++i) {
            const int key = j * 64 + kt * 32 + crow(i, h);
            const float e = st[kt][i] + Lv[kt][i] + lat[kt][i] + R;
            st[kt][i] = (key < query) ? __expf(e) : 0.f;
          }
        R += tot;
        attn_pv(sm, st, o);
      }
    }
    const int b = bh >> 4, hh = bh & 15;
    bf16_t* dst = obuf + ((size_t)b * S_ + query) * D_ + hh * 64;
#pragma unroll
    for (int dt = 0; dt < 2; ++dt)
#pragma unroll
      for (int a = 0; a < 4; ++a)
        store4bf(dst + dt * 32 + 8 * a + 4 * h, o[dt][4 * a], o[dt][4 * a + 1], o[dt][4 * a + 2], o[dt][4 * a + 3]);
  }
}

DI void nsa_compress_phase(const Params& P, char* smem) {
  bf16_t* sW = (bf16_t*)smem;
  bf16_t* sX = sW + 128 * 72;
  const bf16_t* KC = (const bf16_t*)(wsp(P) + OFF_R + 64 * MiB);
  const bf16_t* VC = (const bf16_t*)(wsp(P) + OFF_R + 112 * MiB);
  const float* cb = (const float*)(wsp(P) + OFF_CBIAS);
  const int wave = tidx() >> 6, wn = wave >> 1, wm = wave & 1;
  for (int t = bidx(); t < 64; t += gridDim.x) {
    const int isv = t >> 5, kv = (t >> 1) & 15, mt = t & 1;
    const bf16_t* Wt = (const bf16_t*)(wsp(P) + (isv ? OFF_WCV : OFF_WCK));
    const bf16_t* X = (isv ? VC : KC) + ((size_t)kv * S_ + (size_t)mt * 256 * 16) * 64;
    f32x16 acc[2][2][2];
    gemm_tile<2>(Wt, 2048, X, 1024, 2048, sW, sX, acc);
    EpiCmp epi;
    epi.cb = cb + isv * 64;
    epi.gk = inp(P, 19);
    epi.isv = isv;
    epi.dst = isv ? (bf16_t*)(wsp(P) + OFF_VCMPT) + (size_t)kv * 64 * 512 : (bf16_t*)(wsp(P) + OFF_KCMP) + (size_t)kv * 512 * 64;
    epi(acc[0], wn * 64, mt * 256 + wm * 128);
    epi(acc[1], wn * 64, mt * 256 + wm * 128 + 64);
  }
}

struct CmpSmem {
  AttnSmem a;
  float imp[32 * 132];
};

DI void nsa_cmp_phase(const Params& P, char* smem) {
  CmpSmem& sm = *(CmpSmem*)smem;
  const bf16_t* Q = (const bf16_t*)(wsp(P) + OFF_R);
  const bf16_t* KCMP = (const bf16_t*)(wsp(P) + OFF_KCMP);
  const bf16_t* VCMPT = (const bf16_t*)(wsp(P) + OFF_VCMPT);
  const float* gates = (const float*)(wsp(P) + OFF_GATES);
  bf16_t* obuf = (bf16_t*)(wsp(P) + OFF_OBUF);
  u32x4* sel = (u32x4*)(wsp(P) + OFF_SEL);
  const int tid = tidx(), lane = tid & 63, wave = tid >> 6, r = lane & 31, h = lane >> 5;
  for (int it = bidx(); it < 4096; it += gridDim.x) {
    const int tt = 255 - (it >> 4), kv = it & 15, b = kv >> 2, g = kv & 3;
    const int t0 = tt * 32, head = g * 4 + wave, query = t0 + r;
    const bf16_t* Kb = KCMP + (size_t)kv * 512 * 64;
    const bf16_t* VTb = VCMPT + (size_t)kv * 64 * 512;
    bf16x8 qf[4];
    load_qf(Q + ((size_t)(b * 16 + head) * S_ + query) * 64, qf);
    const int ntiles = ((t0 >> 4) >> 6) + 1;
    __syncthreads();
    for (int e = tid; e < 32 * 132; e += 256) sm.imp[e] = 0.f;
    float m_run = -1e30f, l_run = 0.f;
    u32x4 kr[2], vr[2];
    for (int jt = 0; jt < ntiles; ++jt) {
      attn_load(Kb, 64, VTb, 512, jt, kr, vr);
      __syncthreads();
      attn_store(sm.a, kr, vr);
      __syncthreads();
      f32x16 st[2];
      attn_qk(sm.a, qf, st);
      float mx = -1e30f;
#pragma unroll
      for (int kt = 0; kt < 2; ++kt)
#pragma unroll
        for (int i = 0; i < 16; ++i) {
          const int n = jt * 64 + kt * 32 + crow(i, h);
          const float s = (16 * n + 31 <= query) ? st[kt][i] * 0.125f : -1e30f;
          st[kt][i] = s;
          mx = fmaxf(mx, s);
        }
      mx = fmaxf(mx, __shfl_xor(mx, 32));
      const float m_new = fmaxf(m_run, mx);
      float ps = 0.f;
#pragma unroll
      for (int kt = 0; kt < 2; ++kt)
#pragma unroll
        for (int i = 0; i < 16; ++i) ps += (st[kt][i] > -1e29f) ? __expf(st[kt][i] - m_new) : 0.f;
      ps += __shfl_xor(ps, 32);
      l_run = l_run * __expf(m_run - m_new) + ps;
      m_run = m_new;
    }
    const float linv = l_run > 0.f ? 1.f / l_run : 0.f;
    f32x16 o[2];
    zero16(o[0]);
    zero16(o[1]);
    for (int jt = 0; jt < ntiles; ++jt) {
      attn_load(Kb, 64, VTb, 512, jt, kr, vr);
      __syncthreads();
      attn_store(sm.a, kr, vr);
      __syncthreads();
      f32x16 st[2];
      attn_qk(sm.a, qf, st);
#pragma unroll
      for (int kt = 0; kt < 2; ++kt)
#pragma unroll
        for (int i = 0; i < 16; ++i) {
          const int n = jt * 64 + kt * 32 + crow(i, h);
          st[kt][i] = (16 * n + 31 <= query) ? __expf(st[kt][i] * 0.125f - m_run) * linv : 0.f;
        }
      attn_pv(sm.a, st, o);
      for (int w = 0; w < 4; ++w) {
        if (wave == w) {
          float* ip = sm.imp + r * 132 + jt * 16 + h;
#pragma unroll
          for (int kt = 0; kt < 2; ++kt)
#pragma unroll
            for (int a = 0; a < 4; ++a) {
              const float G = st[kt][4 * a] + st[kt][4 * a + 1] + st[kt][4 * a + 2] + st[kt][4 * a + 3];
              const float x = __shfl_xor(st[kt][4 * a + 3], 32);
              ip[kt * 8 + 2 * a] += G + (h ? x : 0.f);
              if (!h) ip[kt * 8 + 2 * a + 2] += x;
            }
        }
        __syncthreads();
      }
    }
    {
      const size_t m = (size_t)b * S_ + query;
      float gc = gates[m * 48 + head * 3 + 0];
#if ABL == 3
      gc = 0.f;
#endif
      bf16_t* dst = obuf + m * D_ + head * 64;
#pragma unroll
      for (int dt = 0; dt < 2; ++dt)
#pragma unroll
        for (int a = 0; a < 4; ++a)
          store4bf(dst + dt * 32 + 8 * a + 4 * h, o[dt][4 * a] * gc, o[dt][4 * a + 1] * gc, o[dt][4 * a + 2] * gc,
                   o[dt][4 * a + 3] * gc);
    }
    for (int tk = 0; tk < 8; ++tk) {
      const int tl = wave * 8 + tk, t = t0 + tl, cur = t >> 6;
      const float* ip = sm.imp + tl * 132;
      const int j0 = lane, j1 = lane + 64;
      const bool f0 = (j0 == 0) || (j0 == cur) || (j0 == cur - 1);
      const bool f1 = (j1 == cur) || (j1 == cur - 1);
      const float v0 = f0 ? 1e9f : (j0 <= cur ? ip[j0] : -1.f);
      const float v1 = f1 ? 1e9f : (j1 <= cur ? ip[j1] : -1.f);
      int r0 = 0, r1 = 0;
      for (int jp = 0; jp <= cur; ++jp) {
        const bool fp = (jp == 0) || (jp == cur) || (jp == cur - 1);
        const float vp = fp ? 1e9f : ip[jp];
        r0 += (vp > v0 || (vp == v0 && jp < j0)) ? 1 : 0;
        r1 += (vp > v1 || (vp == v1 && jp < j1)) ? 1 : 0;
      }
      const unsigned long long m0 = __ballot(j0 <= cur && r0 < 16);
      const unsigned long long m1 = __ballot(j1 <= cur && r1 < 16);
      if (lane == 0) {
        u32x4 w;
        w.x = (unsigned)m0;
        w.y = (unsigned)(m0 >> 32);
        w.z = (unsigned)m1;
        w.w = (unsigned)(m1 >> 32);
        sel[(size_t)kv * S_ + t] = w;
      }
    }
  }
}

DI void nsa_attn_phase(const Params& P, char* smem, int rep) {
  AttnSmem& sm = *(AttnSmem*)smem;
  char* R = wsp(P) + OFF_R;
  const bf16_t* Q = (const bf16_t*)R;
  const bf16_t* KS = (const bf16_t*)(R + 80 * MiB);
  const bf16_t* KW = (const bf16_t*)(R + 96 * MiB);
  const bf16_t* VST = (const bf16_t*)(R + 128 * MiB);
  const bf16_t* VWT = (const bf16_t*)(R + 144 * MiB);
  const float* gates = (const float*)(wsp(P) + OFF_GATES);
  const u32x4* sel = (const u32x4*)(wsp(P) + OFF_SEL);
  bf16_t* obuf = (bf16_t*)(wsp(P) + OFF_OBUF);
  const int lane = tidx() & 63, wave = tidx() >> 6, r = lane & 31, h = lane >> 5;
  for (int it = bidx(); it < 4096; it += gridDim.x) {
    const int qt = 63 - (it >> 6), jx = it & 7, jy = (it >> 3) & 7;
    const int kv = jx * 2 + (jy >> 2), b = kv >> 2, head = (kv & 3) * 4 + (jy & 3), bh = b * 16 + head;
    const int q0 = qt * 128, qw = q0 + wave * 32, query = qw + r;
    bf16x8 qf[4];
    load_qf(Q + ((size_t)bh * S_ + query) * 64, qf);
    const u32x4 selw = sel[(size_t)kv * S_ + query];
    const size_t m = (size_t)b * S_ + query;
    float gs = gates[m * 48 + head * 3 + 1], gw = gates[m * 48 + head * 3 + 2];
    if (rep) { gs = 0.f; gw = 0.f; }
#if ABL == 1
    gs = 0.f;
#elif ABL == 2
    gw = 0.f;
#endif
    f32x16 o[2], ow[2];
    float l;
    const int jlo = (q0 > 511 ? q0 - 511 : 0) >> 6;
    flash_pass<1>(KW + (size_t)kv * S_ * 64, VWT + (size_t)kv * 64 * S_, nullptr, 0.f, selw, qw, jlo, 2 * qt + 1, qf, o, l, sm);
    {
      const float sc = gw / l;
#pragma unroll
      for (int dt = 0; dt < 2; ++dt)
#pragma unroll
        for (int i = 0; i < 16; ++i) ow[dt][i] = o[dt][i] * sc;
    }
    flash_pass<2>(KS + (size_t)kv * S_ * 64, VST + (size_t)kv * 64 * S_, nullptr, 0.f, selw, qw, 0, 2 * qt + 1, qf, o, l, sm);
    const float sc = gs / l;
    bf16_t* dst = obuf + m * D_ + head * 64;
#pragma unroll
    for (int dt = 0; dt < 2; ++dt)
#pragma unroll
      for (int a = 0; a < 4; ++a) {
        bf16_t* p = dst + dt * 32 + 8 * a + 4 * h;
        u32x2 g = *(const u32x2*)p;
        store4bf(p, ow[dt][4 * a] + o[dt][4 * a] * sc + bflo(g.x), ow[dt][4 * a + 1] + o[dt][4 * a + 1] * sc + bfhi(g.x),
                 ow[dt][4 * a + 2] + o[dt][4 * a + 2] * sc + bflo(g.y), ow[dt][4 * a + 3] + o[dt][4 * a + 3] * sc + bfhi(g.y));
      }
  }
}

struct GlaSmem {
  float glow[64 * 16];
  float tot[2 * 128];
  float ssq[2 * 64];
  bf16_t q[64 * 136];
  bf16_t ki[64 * 136];
  bf16_t a[64 * 72];
};

DI void gla_compute_b(const Params& P, GlaSmem& sm, int b, int hg, int t0, float (&bv)[32], float& blast) {
  const int tid = tidx(), d = tid & 127, half = tid >> 7;
  const float* glow = (const float*)(wsp(P) + OFF_GLOW) + ((size_t)b * S_ + t0) * 16;
  __syncthreads();
  for (int e = tid; e < 1024; e += 256) sm.glow[e] = glow[e];
  const int col = hg * 128 + d;
  float w[16];
#pragma unroll
  for (int q = 0; q < 16; ++q) w[q] = inp(P, 22)[q * 512 + col];
  const float bias = inp(P, 23)[col];
  __syncthreads();
  float run = 0.f;
#pragma unroll
  for (int cc = 0; cc < 32; ++cc) {
    const float* gl = sm.glow + (half * 32 + cc) * 16;
    float z = 0.f;
#pragma unroll
    for (int q = 0; q < 16; ++q) z += gl[q] * w[q];
    z += bias;
    run += logsigmoidf_(z) * (1.f / 16.f);
    bv[cc] = run;
    if ((cc & 3) == 3) __builtin_amdgcn_sched_barrier(0);
  }
  sm.tot[half * 128 + d] = run;
  __syncthreads();
  const float t0v = sm.tot[d], t1v = sm.tot[128 + d];
  if (half) {
#pragma unroll
    for (int cc = 0; cc < 32; ++cc) bv[cc] += t0v;
  }
  blast = t0v + t1v;
}

DI void gla_u_phase(const Params& P, char* smem) {
  GlaSmem& sm = *(GlaSmem*)smem;
  char* R = wsp(P) + OFF_R;
  const bf16_t* KG = (const bf16_t*)(R + 32 * MiB);
  const bf16_t* VTG = (const bf16_t*)(R + 64 * MiB);
  bf16_t* UT = (bf16_t*)(R + 128 * MiB);
  float* decay = (float*)(wsp(P) + OFF_DECAY);
  bf16_t* sKT = sm.q;
  const int tid = tidx(), lane = tid & 63, wave = tid >> 6, r = lane & 31, h = lane >> 5;
  const int d = tid & 127, half = tid >> 7;
  for (int it = bidx(); it < 2048; it += gridDim.x) {
    const int n = it & 127, bhg = it >> 7, b = bhg >> 2, hg = bhg & 3, t0 = n * 64;
    float bv[32], blast;
    gla_compute_b(P, sm, b, hg, t0, bv, blast);
#pragma unroll
    for (int cc = 0; cc < 32; ++cc) {
      const int c = half * 32 + cc;
      const float k = bf2f(KG[((size_t)b * S_ + t0 + c) * 512 + hg * 128 + d]);
      sKT[d * 72 + c] = f2bf(k * __expf(blast - bv[cc]));
      if ((cc & 7) == 7) __builtin_amdgcn_sched_barrier(0);
    }
    if (half == 0) decay[(size_t)it * 128 + d] = __expf(blast);
    __syncthreads();
#pragma unroll 1
    for (int m2 = 0; m2 < 2; ++m2) {
      const int e0 = (2 * wave + m2) * 32;
      f32x16 acc[4];
#pragma unroll
      for (int q = 0; q < 4; ++q) zero16(acc[q]);
      const bf16_t* vrow = VTG + ((size_t)b * 1024 + hg * 256 + e0 + r) * S_ + t0;
#pragma unroll
      for (int kk = 0; kk < 4; ++kk) {
        bf16x8 a = *(const bf16x8*)(vrow + kk * 16 + h * 8);
#pragma unroll
        for (int nt = 0; nt < 4; ++nt) {
          bf16x8 bb = *(const bf16x8*)(sKT + (nt * 32 + r) * 72 + kk * 16 + h * 8);
          acc[nt] = MFMA(a, bb, acc[nt]);
        }
        __builtin_amdgcn_sched_barrier(0);
      }
      bf16_t* ub = UT + ((size_t)it * 256 + e0 + 4 * h) * 128 + r;
#pragma unroll
      for (int nt = 0; nt < 4; ++nt) {
#pragma unroll
        for (int i = 0; i < 16; ++i) ub[((i & 3) + 8 * (i >> 2)) * 128 + nt * 32] = f2bf(acc[nt][i]);
        __builtin_amdgcn_sched_barrier(0);
      }
    }
  }
}

DI void gla_scan_phase(const Params& P, int rep) {
  bf16_t* UT = (bf16_t*)(wsp(P) + OFF_R + 128 * MiB);
  const float* decay = (const float*)(wsp(P) + OFF_DECAY);
  for (int gid = bidx() * 256 + tidx(); gid < 16 * 256 * 128; gid += gridDim.x * 256) {
    const int bhg = gid >> 15, e = (gid >> 7) & 255, d = gid & 127;
    float state = 0.f;
    for (int n0 = 0; n0 < 128; n0 += 8) {
      float u[8], dc[8];
#pragma unroll
      for (int q = 0; q < 8; ++q) {
        const size_t it = (size_t)bhg * 128 + n0 + q;
        u[q] = bf2f(UT[(it * 256 + e) * 128 + d]);
        dc[q] = decay[it * 128 + d];
      }
#pragma unroll
      for (int q = 0; q < 8; ++q) {
        const size_t it = (size_t)bhg * 128 + n0 + q;
        UT[(it * 256 + e) * 128 + d] = rep ? f2bf(u[q]) : f2bf(state);
        state = dc[q] * state + u[q];
      }
    }
  }
}

DI void gla_out_phase(const Params& P, char* smem, int rep) {
  GlaSmem& sm = *(GlaSmem*)smem;
  char* R = wsp(P) + OFF_R;
  const bf16_t* QG = (const bf16_t*)R;
  const bf16_t* KG = (const bf16_t*)(R + 32 * MiB);
  const bf16_t* VTG = (const bf16_t*)(R + 64 * MiB);
  const bf16_t* UT = (const bf16_t*)(R + 128 * MiB);
  bf16_t* obuf = (bf16_t*)(wsp(P) + OFF_OBUF);
  const float* gout = inp(P, 24);
  const int tid = tidx(), lane = tid & 63, wave = tid >> 6, r = lane & 31, h = lane >> 5;
  const int d = tid & 127, half = tid >> 7;
  for (int it = bidx(); it < 2048; it += gridDim.x) {
    const int n = it & 127, bhg = it >> 7, b = bhg >> 2, hg = bhg & 3, t0 = n * 64;
    float bv[32], blast;
    gla_compute_b(P, sm, b, hg, t0, bv, blast);
#pragma unroll
    for (int cc = 0; cc < 32; ++cc) {
      const int c = half * 32 + cc;
      const size_t off = ((size_t)b * S_ + t0 + c) * 512 + hg * 128 + d;
      const float q = bf2f(QG[off]), k = bf2f(KG[off]);
      sm.q[c * 136 + d] = f2bf(q * 0.08838834764831845f * __expf(bv[cc]));
      sm.ki[c * 136 + d] = f2bf(k * __expf(-bv[cc]));
      if ((cc & 3) == 3) __builtin_amdgcn_sched_barrier(0);
    }
    __syncthreads();
    {
      const int ct = wave >> 1, stt = wave & 1;
      f32x16 acc;
      zero16(acc);
      if (stt <= ct) {
#pragma unroll
        for (int kk = 0; kk < 8; ++kk) {
          bf16x8 a = *(const bf16x8*)(sm.q + (ct * 32 + r) * 136 + kk * 16 + h * 8);
          bf16x8 bb = *(const bf16x8*)(sm.ki + (stt * 32 + r) * 136 + kk * 16 + h * 8);
          acc = MFMA(a, bb, acc);
        }
      }
#pragma unroll
      for (int i = 0; i < 16; ++i) {
        const int c = ct * 32 + crow(i, h), s = stt * 32 + r;
        sm.a[c * 72 + s] = f2bf(s <= c ? acc[i] : 0.f);
      }
    }
    __syncthreads();
    const int ctok = wave & 1, eh = wave >> 1;
    f32x16 acc[4];
#pragma unroll
    for (int q = 0; q < 4; ++q) zero16(acc[q]);
#pragma unroll
    for (int kk = 0; kk < 4; ++kk) {
      bf16x8 bb = *(const bf16x8*)(sm.a + (ctok * 32 + r) * 72 + kk * 16 + h * 8);
#pragma unroll
      for (int mt = 0; mt < 4; ++mt) {
        bf16x8 a = *(const bf16x8*)(VTG + ((size_t)b * 1024 + hg * 256 + eh * 128 + mt * 32 + r) * S_ + t0 + kk * 16 + h * 8);
        acc[mt] = MFMA(a, bb, acc[mt]);
      }
      if (kk & 1) __builtin_amdgcn_sched_barrier(0);
    }
#pragma unroll
    for (int kk = 0; kk < 8; ++kk) {
      bf16x8 bb = *(const bf16x8*)(sm.q + (ctok * 32 + r) * 136 + kk * 16 + h * 8);
#pragma unroll
      for (int mt = 0; mt < 4; ++mt) {
        bf16x8 a = *(const bf16x8*)(UT + ((size_t)it * 256 + eh * 128 + mt * 32 + r) * 128 + kk * 16 + h * 8);
        acc[mt] = MFMA(a, bb, acc[mt]);
      }
      if (kk & 1) __builtin_amdgcn_sched_barrier(0);
    }
    float ss = 0.f;
#pragma unroll
    for (int mt = 0; mt < 4; ++mt)
#pragma unroll
      for (int i = 0; i < 16; ++i) ss += acc[mt][i] * acc[mt][i];
    ss += __shfl_xor(ss, 32);
    if (h == 0) sm.ssq[eh * 64 + ctok * 32 + r] = ss;
    __syncthreads();
    const float tot = sm.ssq[ctok * 32 + r] + sm.ssq[64 + ctok * 32 + r];
    const float rinv = rsqrtf(tot * (1.f / 256.f) + 1e-6f);
    bf16_t* dst = obuf + ((size_t)b * S_ + t0 + ctok * 32 + r) * D_ + hg * 256 + eh * 128;
#pragma unroll
    for (int mt = 0; mt < 4; ++mt)
#pragma unroll
      for (int a = 0; a < 4; ++a) {
        const int el = mt * 32 + 8 * a + 4 * h;
        const float* gp = gout + eh * 128 + el;
        bf16_t* p = dst + el;
        u32x2 g = *(const u32x2*)p;
        if (rep) *(u32x2*)p = g;
        else
        store4bf(p, acc[mt][4 * a] * rinv * gp[0] * bflo(g.x), acc[mt][4 * a + 1] * rinv * gp[1] * bfhi(g.x),
                 acc[mt][4 * a + 2] * rinv * gp[2] * bflo(g.y), acc[mt][4 * a + 3] * rinv * gp[3] * bfhi(g.y));
      }
  }
}

#define XB_TMO 128
#define XB_XCNT(j) (256 + 64 * (j))
#define XB_XSUB(j) (1280 + 64 * (j))
#define XB_XGEN(j) (2304 + 64 * (j))
#define XB_TOP 3328
#define XB_TOPGEN 3392
#define XCD_BAR_WORDS 3456
#define XB_SPIN_CAP (1u << 21)
#define LAS __attribute__((address_space(3)))
DI unsigned xb_ld(unsigned* p) { return __hip_atomic_load(p, __ATOMIC_RELAXED, __HIP_MEMORY_SCOPE_AGENT); }
DI unsigned xb_add(unsigned* p, unsigned v) { return __hip_atomic_fetch_add(p, v, __ATOMIC_RELAXED, __HIP_MEMORY_SCOPE_AGENT); }
DI unsigned xb_xcc_id() { return (unsigned)__builtin_amdgcn_s_getreg((3 << 11) | 20) & 0xFu; }
#define XB_SPIN(cond, bar)                                           \
  do {                                                               \
    unsigned _sp = 0;                                                \
    while (cond) {                                                   \
      __builtin_amdgcn_s_sleep(1);                                   \
      if ((++_sp & 255u) == 0u) {                                    \
        if (xb_ld(&(bar)[XB_TMO])) break;                            \
        if (_sp > XB_SPIN_CAP) {                                     \
          atomicAdd(&(bar)[XB_TMO], 1u);                             \
          break;                                                     \
        }                                                            \
      }                                                              \
    }                                                                \
  } while (0)
struct XcdBarrier {
  unsigned* bar;
  unsigned x;
  volatile LAS unsigned* st;
};
DI XcdBarrier xcd_barrier_post(unsigned* bar, volatile LAS unsigned* st) {
  XcdBarrier b;
  b.bar = bar;
  b.x = xb_xcc_id();
  b.st = st;
  if (threadIdx.x == 0) (void)xb_add(&bar[XB_XCNT(b.x)], 1u);
  return b;
}
DI void xcd_barrier_complete(unsigned* bar, unsigned x, unsigned& nloc, unsigned& nx) {
  const unsigned G = gridDim.x * gridDim.y * gridDim.z;
  unsigned sum, cnt, mine, sp = 0u;
  for (;;) {
    sum = 0u;
    cnt = 0u;
    mine = 0u;
#pragma unroll
    for (unsigned j = 0; j < 16; ++j) {
      const unsigned c = xb_ld(&bar[XB_XCNT(j)]);
      sum += c;
      cnt += (c > 0u) ? 1u : 0u;
      mine = (j == x) ? c : mine;
    }
    if (sum == G) break;
    __builtin_amdgcn_s_sleep(1);
    if ((++sp & 255u) == 0u) {
      if (xb_ld(&bar[XB_TMO])) break;
      if (sp > XB_SPIN_CAP) {
        atomicAdd(&bar[XB_TMO], 1u);
        break;
      }
    }
  }
  nloc = mine > 0u ? mine : 1u;
  nx = cnt > 0u ? cnt : 1u;
}
DI void xcd_barrier(const XcdBarrier& b) {
  asm volatile("s_waitcnt vmcnt(0)" ::: "memory");
  __syncthreads();
  if (threadIdx.x == 0) {
    unsigned* bar = b.bar;
    __builtin_amdgcn_s_waitcnt(0);
    unsigned nloc = b.st[0], nx = b.st[1];
    if (nloc == 0u) {
      xcd_barrier_complete(bar, b.x, nloc, nx);
      b.st[0] = nloc;
      b.st[1] = nx;
    }
    const unsigned old = xb_add(&bar[XB_XSUB(b.x)], 1u);
    const unsigned gen = old / nloc;
    if (old + 1u == (gen + 1u) * nloc) {
      __builtin_amdgcn_fence(__ATOMIC_RELEASE, "agent");
      asm volatile("s_waitcnt vmcnt(0)" ::: "memory");
      const unsigned og = xb_add(&bar[XB_TOP], 1u);
      const unsigned tg = og / nx;
      if (og + 1u == (tg + 1u) * nx) xb_add(&bar[XB_TOPGEN], 1u);
      else XB_SPIN(xb_ld(&bar[XB_TOPGEN]) == tg, bar);
      __builtin_amdgcn_fence(__ATOMIC_ACQUIRE, "agent");
      xb_add(&bar[XB_XGEN(b.x)], 1u);
      asm volatile("s_waitcnt vmcnt(0)" ::: "memory");
    } else {
      XB_SPIN(xb_ld(&bar[XB_XGEN(b.x)]) == gen, bar);
      __builtin_amdgcn_fence(__ATOMIC_ACQUIRE, "agent");
      asm volatile("s_waitcnt vmcnt(0)" ::: "memory");
    }
  }
  __syncthreads();
}

DI void run_phase(const Params& P, int ph, char* smem, int rep) {
  char* ws = wsp(P);
  float* ssq = (float*)(ws + OFF_SSQ);
  bf16_t* xb = (bf16_t*)(ws + OFF_XB);
  bf16_t* obuf = (bf16_t*)(ws + OFF_OBUF);
  bf16_t* act = (bf16_t*)(ws + OFF_R);
  if (ph == 0) {
    init_phase(P);
    prep_layer(P, 0, smem);
    return;
  }
  int L, lp;
  if (ph <= 8) { L = 0; lp = ph - 1; }
  else if (ph <= 18) { L = 1; lp = ph - 10; }
  else if (ph <= 28) { L = 2; lp = ph - 20; }
  else { L = 3; lp = ph - 30; }
  if (lp < 0) {
    prep_layer(P, L, smem);
    return;
  }
  const int nmix = (L == 0) ? 2 : (L == 1 ? 3 : (L == 2 ? 3 : 1));
  const float* s0 = ssq + (size_t)(3 * L) * M_ * 16;
  const float* s1 = s0 + (size_t)M_ * 16;
  const float* s2 = s1 + (size_t)M_ * 16;
  if (lp == 0 || lp == 4 + nmix) {
    const bool f2 = lp != 0;
    EpiFfn1 e;
    e.ssq = f2 ? s2 : s0;
    e.act = act;
    gemm_phase<2>((const bf16_t*)(ws + (f2 ? OFF_W2 : OFF_W1)), 2 * F_, xb, D_, D_, smem, e);
  } else if (lp == 1 || lp == 5 + nmix) {
    const bool f2 = lp != 1;
    EpiResid e;
    e.xin = (L == 0 && !f2 && !rep) ? inp(P, 0) : outp(P);
    e.xout = outp(P);
    e.xb = xb;
    e.ssqn = ssq + (size_t)(3 * L + (f2 ? 3 : 1)) * M_ * 16;
    e.scale = rep ? 0.f : 0.5f;
    gemm_phase<2>((const bf16_t*)(ws + (f2 ? OFF_W2D : OFF_W1D)), D_, act, F_, F_, smem, e);
  } else if (lp == 3 + nmix) {
    EpiResid e;
    e.xin = outp(P);
    e.xout = outp(P);
    e.xb = xb;
    e.ssqn = ssq + (size_t)(3 * L + 2) * M_ * 16;
    e.scale = rep ? 0.f : 1.f;
    gemm_phase<2>((const bf16_t*)(ws + OFF_WMO), D_, obuf, D_, D_, smem, e);
  } else if (lp == 2) {
    const bf16_t* wmi = (const bf16_t*)(ws + OFF_WMI);
    char* R = ws + OFF_R;
    if (L == 0 || L == 3) {
      EpiQKV e;
      e.ssq = s1;
      e.gq = inp(P, 10);
      e.gk = inp(P, 11);
      e.bfv = inp(P, 9);
      e.Q = (bf16_t*)R;
      e.K = (bf16_t*)(R + 64 * MiB);
      e.VT = (bf16_t*)(R + 128 * MiB);
      e.obuf = obuf;
      e.flog = (float*)(ws + OFF_FLOG);
      e.fox = (L == 0);
      gemm_phase<2>(wmi, L == 0 ? 4224 : 3072, xb, D_, D_, smem, e);
    } else if (L == 1) {
      EpiNSA e;
      e.ssq = s1;
      e.gq = inp(P, 18);
      e.gk = inp(P, 19);
      e.Q = (bf16_t*)R;
      e.KC = (bf16_t*)(R + 64 * MiB);
      e.KS = (bf16_t*)(R + 80 * MiB);
      e.KW = (bf16_t*)(R + 96 * MiB);
      e.VC = (bf16_t*)(R + 112 * MiB);
      e.VST = (bf16_t*)(R + 128 * MiB);
      e.VWT = (bf16_t*)(R + 144 * MiB);
      e.gates = (float*)(ws + OFF_GATES);
      gemm_phase<1>(wmi, 2688, xb, D_, D_, smem, e);
    } else {
      EpiGLA e;
      e.ssq = s1;
      e.QG = (bf16_t*)R;
      e.KG = (bf16_t*)(R + 32 * MiB);
      e.VTG = (bf16_t*)(R + 64 * MiB);
      e.obuf = obuf;
      e.glow = (float*)(ws + OFF_GLOW);
      gemm_phase<2>(wmi, 3200, xb, D_, D_, smem, e);
    }
  } else {
    const int mp = lp - 3;
    if (L == 0) {
      if (mp == 0) {
        fox_scan_phase(P, smem);
      }
      else {
        fox_attn_phase(P, smem, rep);
      }
    } else if (L == 1) {
      if (mp == 0) nsa_compress_phase(P, smem);
      else if (mp == 1) nsa_cmp_phase(P, smem);
      else {
        nsa_attn_phase(P, smem, rep);
      }
    } else if (L == 2) {
      if (mp == 0) gla_u_phase(P, smem);
      else if (mp == 1) gla_scan_phase(P, rep);
      else gla_out_phase(P, smem, rep);
    } else {
      sb_attn_phase(P, smem);
    }
  }
}

__global__ void __launch_bounds__(256, 2) mega_kernel(Params P, int ph_lo, int ph_hi) {
  __shared__ __attribute__((aligned(16))) char smem[57344];
  __shared__ __attribute__((aligned(16))) unsigned xbw[4];
  if (threadIdx.x == 0) { xbw[0] = 0u; xbw[1] = 0u; xbw[2] = 0u; xbw[3] = 0u; }
  __syncthreads();
  XcdBarrier xb = xcd_barrier_post((unsigned*)(P.ws + OFF_XBAR), (volatile LAS unsigned*)xbw);
  for (int ph = ph_lo; ph < ph_hi; ++ph) {
    run_phase(P, ph, smem, 0);
    if (ph + 1 < ph_hi) {
      if (ph == ph_lo) {
        asm volatile("s_waitcnt vmcnt(0)" ::: "memory");
        cg::this_grid().sync();
        __builtin_amdgcn_fence(__ATOMIC_ACQUIRE, "agent");
        asm volatile("s_waitcnt vmcnt(0)" ::: "memory");
        __syncthreads();
      } else {
        xcd_barrier(xb);
      }
    }
  }
}

extern "C" void kernel_launch(void* const* d_in, const int* in_sizes, int n_in, void* d_out, int out_size, void* d_ws,
                              size_t ws_size, hipStream_t stream) {
  static int grid_blocks = 0;
  if (!grid_blocks) {
    int dev = 0, cus = 0, per_cu = 0;
    hipGetDevice(&dev);
    hipDeviceGetAttribute(&cus, hipDeviceAttributeMultiprocessorCount, dev);
    hipOccupancyMaxActiveBlocksPerMultiprocessor(&per_cu, mega_kernel, 256, 0);
    if (per_cu > 2) per_cu = 2;
    if (per_cu < 1) per_cu = 1;
    grid_blocks = cus * per_cu;
  }
  Params p{};
  for (int i = 0; i < 28; ++i) p.in[i] = (const float*)d_in[i];
  p.out = (float*)d_out;
  p.ws = (char*)d_ws;
  hipMemsetAsync((char*)d_ws + OFF_XBAR, 0, XCD_BAR_WORDS * sizeof(unsigned), stream);
#if ONE_LAUNCH
  int lo = 0, hi = NPH_RUN;
  void* args[] = {&p, &lo, &hi};
  hipError_t e = hipLaunchCooperativeKernel((void*)mega_kernel, dim3(grid_blocks), dim3(256), args, 0, stream);
  if (e != hipSuccess) fprintf(stderr, "cooperative launch failed: %s (grid %d)\n", hipGetErrorString(e), grid_blocks);
#else
  for (int ph = 0; ph < NPH_RUN; ++ph) mega_kernel<<<grid_blocks, 256, 0, stream>>>(p, ph, ph + 1);
#endif
}
```

```cpp
#include <hip/hip_runtime.h>
#include <hip/hip_cooperative_groups.h>
#include <cstdio>
namespace cg = cooperative_groups;

#ifndef ONE_LAUNCH
#define ONE_LAUNCH 1
#endif

#define ABL 0
#ifndef NPH_RUN
#define NPH_RUN 37
#endif
#define DI __device__ __forceinline__
typedef unsigned short bf16_t;
typedef __attribute__((ext_vector_type(8))) short bf16x8;
typedef __attribute__((ext_vector_type(4))) short bf16x4;
typedef __attribute__((ext_vector_type(16))) float f32x16;
typedef __attribute__((ext_vector_type(2))) __bf16 bf2_t;
typedef __attribute__((ext_vector_type(4))) unsigned u32x4;
typedef __attribute__((ext_vector_type(2))) unsigned u32x2;
typedef __attribute__((ext_vector_type(4))) float f32x4;
DI int tidx() { int t = threadIdx.x; asm volatile("" : "+v"(t)); return t; }
DI int bidx() { int t = blockIdx.x; asm volatile("" : "+s"(t)); return t; }

#define MFMA(a, b, c) __builtin_amdgcn_mfma_f32_32x32x16_bf16((a), (b), (c), 0, 0, 0)

constexpr int S_ = 8192;
constexpr int M_ = 32768;
constexpr int D_ = 1024;
constexpr int F_ = 2816;
constexpr int NPH = 37;
constexpr size_t MiB = 1048576;
constexpr size_t OFF_W1 = 0, OFF_W1D = 11 * MiB, OFF_W2 = 17 * MiB, OFF_W2D = 28 * MiB, OFF_WMI = 34 * MiB,
                 OFF_WMO = 43 * MiB, OFF_WCK = 45 * MiB, OFF_WCV = 46 * MiB;
constexpr size_t OFF_XB = 48 * MiB, OFF_OBUF = 112 * MiB, OFF_SSQ = 460 * MiB, OFF_FLOG = 178 * MiB, OFF_C = 180 * MiB,
                 OFF_GATES = 182 * MiB, OFF_SEL = 188 * MiB, OFF_GLOW = 190 * MiB, OFF_DECAY = 192 * MiB,
                 OFF_KCMP = 193 * MiB, OFF_VCMPT = 194 * MiB, OFF_CBIAS = 195 * MiB, OFF_XBAR = 196 * MiB, OFF_R = 200 * MiB;

struct Params {
  const float* in[28];
  float* out;
  char* ws;
};

#define GAS __attribute__((address_space(1)))
DI const float* inp(const Params& P, int k) {
  asm volatile("" : "+s"(k));
  GAS const float* p = (GAS const float*)P.in[k];
  asm volatile("" : "+s"(p));
  return (const float*)p;
}
DI char* wsp(const Params& P) {
  GAS char* w = (GAS char*)P.ws;
  asm volatile("" : "+s"(w));
  return (char*)w;
}
DI float* outp(const Params& P) {
  GAS float* w = (GAS float*)P.out;
  asm volatile("" : "+s"(w));
  return (float*)w;
}
DI unsigned pack2(float a, float b) {
  bf2_t v;
  v[0] = (__bf16)a;
  v[1] = (__bf16)b;
  return __builtin_bit_cast(unsigned, v);
}
DI bf16_t f2bf(float a) { return (bf16_t)(pack2(a, 0.f) & 0xffffu); }
DI float bf2f(bf16_t v) { return __uint_as_float(((unsigned)v) << 16); }
DI float bflo(unsigned u) { return __uint_as_float(u << 16); }
DI float bfhi(unsigned u) { return __uint_as_float(u & 0xffff0000u); }
DI int crow(int i, int h) { return (i & 3) + 8 * (i >> 2) + 4 * h; }
DI float sigmoidf_(float x) { return __builtin_amdgcn_rcpf(1.f + __expf(-x)); }
DI float logsigmoidf_(float z) { return fminf(z, 0.f) - log1pf(__expf(-fabsf(z))); }
DI float row_rstd(const float* ssq, int m) {
  const f32x4* p = (const f32x4*)(ssq + (size_t)m * 16);
  f32x4 a = p[0], b = p[1], c = p[2], d = p[3];
  float s = a.x;
  s += a.y; s += a.z; s += a.w;
  s += b.x; s += b.y; s += b.z; s += b.w;
  s += c.x; s += c.y; s += c.z; s += c.w;
  s += d.x; s += d.y; s += d.z; s += d.w;
  return rsqrtf(s * (1.f / 1024.f) + 1e-6f);
}
DI void store4bf(bf16_t* p, float a, float b, float c, float d) {
  u32x2 u;
  u.x = pack2(a, b);
  u.y = pack2(c, d);
  *(u32x2*)p = u;
}
DI bf16x8 pack8(float a0, float a1, float a2, float a3, float a4, float a5, float a6, float a7) {
  u32x4 u;
  u.x = pack2(a0, a1);
  u.y = pack2(a2, a3);
  u.z = pack2(a4, a5);
  u.w = pack2(a6, a7);
  return __builtin_bit_cast(bf16x8, u);
}
DI bf16x8 cat4(bf16x4 lo, bf16x4 hi) { return __builtin_shufflevector(lo, hi, 0, 1, 2, 3, 4, 5, 6, 7); }
DI void zero16(f32x16& v) {
#pragma unroll
  for (int i = 0; i < 16; ++i) v[i] = 0.f;
}

template <int MH>
DI void gemm_tile(const bf16_t* Wg, int ldw, const bf16_t* Xg, int ldx, int K, bf16_t* sW, bf16_t* sX,
                  f32x16 (&acc)[MH][2][2]) {
  const int tid = tidx(), lane = tid & 63, wave = tid >> 6, wn = wave >> 1, wm = wave & 1, r = lane & 31,
            h = lane >> 5;
#pragma unroll
  for (int a = 0; a < MH; ++a)
#pragma unroll
    for (int b = 0; b < 2; ++b)
#pragma unroll
      for (int c = 0; c < 2; ++c) zero16(acc[a][b][c]);
  u32x4 rw[4], rx[4 * MH];
  const int nk = K >> 6;
  const int row0 = tid >> 3, cc = tid & 7;
  const bf16_t* wp = Wg + (size_t)row0 * ldw + cc * 8;
  const bf16_t* xp = Xg + (size_t)row0 * ldx + cc * 8;
#pragma unroll
  for (int i = 0; i < 4; ++i) rw[i] = *(const u32x4*)(wp + (size_t)(32 * i) * ldw);
#pragma unroll
  for (int i = 0; i < 4 * MH; ++i) rx[i] = *(const u32x4*)(xp + (size_t)(32 * i) * ldx);
  for (int kt = 0; kt < nk; ++kt) {
    __syncthreads();
#pragma unroll
    for (int i = 0; i < 4; ++i) *(u32x4*)(sW + (row0 + 32 * i) * 72 + cc * 8) = rw[i];
#pragma unroll
    for (int i = 0; i < 4 * MH; ++i) *(u32x4*)(sX + (row0 + 32 * i) * 72 + cc * 8) = rx[i];
    __syncthreads();
    if (kt + 1 < nk) {
      const int k0 = (kt + 1) * 64;
#pragma unroll
      for (int i = 0; i < 4; ++i) rw[i] = *(const u32x4*)(wp + (size_t)(32 * i) * ldw + k0);
#pragma unroll
      for (int i = 0; i < 4 * MH; ++i) rx[i] = *(const u32x4*)(xp + (size_t)(32 * i) * ldx + k0);
    }
    __builtin_amdgcn_sched_barrier(0);
#pragma unroll
    for (int kk = 0; kk < 4; ++kk) {
      bf16x8 a0 = *(const bf16x8*)(sW + (wn * 64 + r) * 72 + kk * 16 + h * 8);
      bf16x8 a1 = *(const bf16x8*)(sW + (wn * 64 + 32 + r) * 72 + kk * 16 + h * 8);
#pragma unroll
      for (int mq = 0; mq < 2 * MH; ++mq) {
        bf16x8 b = *(const bf16x8*)(sX + (wm * 64 * MH + mq * 32 + r) * 72 + kk * 16 + h * 8);
        acc[mq >> 1][0][mq & 1] = MFMA(a0, b, acc[mq >> 1][0][mq & 1]);
        acc[mq >> 1][1][mq & 1] = MFMA(a1, b, acc[mq >> 1][1][mq & 1]);
      }
    }
  }
}

template <int MH, class Epi>
DI void gemm_phase(const bf16_t* Wt, int Npad, const bf16_t* X, int ldx, int K, char* smem, const Epi& epi) {
  bf16_t* sW = (bf16_t*)smem;
  bf16_t* sX = sW + 128 * 72;
  const int NT = Npad >> 7, MT = M_ / (128 * MH);
  const int wave = tidx() >> 6, wn = wave >> 1, wm = wave & 1;
  const int nblk = gridDim.x;
  const int lb = ((nblk & 7) == 0) ? ((bidx() & 7) * (nblk >> 3) + (bidx() >> 3)) : bidx();
  const bool part2d = ((nblk & 7) == 0) && ((NT & 3) == 0) && (NT >= 16) && ((MT & 1) == 0);
  const int xg = bidx() & 7, nper = NT >> 2, mper = MT >> 1;
  const int q0 = part2d ? (bidx() >> 3) : lb, qstep = part2d ? (nblk >> 3) : nblk, qend = part2d ? nper * mper : NT * MT;
  for (int t = q0; t < qend; t += qstep) {
    int nt, mt;
    if (part2d) {
      nt = (xg >> 1) * nper + t % nper;
      mt = (xg & 1) * mper + t / nper;
    } else {
      nt = t % NT;
      mt = t / NT;
    }
    f32x16 acc[MH][2][2];
    gemm_tile<MH>(Wt + (size_t)nt * 128 * K, K, X + (size_t)mt * 128 * MH * ldx, ldx, K, sW, sX, acc);
#pragma unroll
    for (int mh = 0; mh < MH; ++mh) epi(acc[mh], nt * 128 + wn * 64, mt * 128 * MH + wm * 64 * MH + mh * 64);
  }
}

struct EpiFfn1 {
  const float* ssq;
  bf16_t* act;
  DI void operator()(f32x16 (&acc)[2][2], int nb, int mb) const {
    const int lane = tidx() & 63, r = lane & 31, h = lane >> 5;
    const int jb = (nb >> 6) * 32;
#pragma unroll
    for (int mi = 0; mi < 2; ++mi) {
      const int m = mb + mi * 32 + r;
      const float rstd = row_rstd(ssq, m);
#pragma unroll
      for (int a = 0; a < 4; ++a) {
        float v[4];
#pragma unroll
        for (int q = 0; q < 4; ++q) {
          float g = acc[0][mi][4 * a + q] * rstd, u = acc[1][mi][4 * a + q] * rstd;
          v[q] = g * sigmoidf_(g) * u;
        }
        store4bf(act + (size_t)m * F_ + jb + 8 * a + 4 * h, v[0], v[1], v[2], v[3]);
      }
    }
  }
};

struct EpiResid {
  const float* xin;
  float* xout;
  bf16_t* xb;
  float* ssqn;
  float scale;
  DI void operator()(f32x16 (&acc)[2][2], int nb, int mb) const {
    const int lane = tidx() & 63, r = lane & 31, h = lane >> 5;
#pragma unroll
    for (int mi = 0; mi < 2; ++mi) {
      const int m = mb + mi * 32 + r;
      float part = 0.f;
#pragma unroll
      for (int ni = 0; ni < 2; ++ni)
#pragma unroll
        for (int a = 0; a < 4; ++a) {
          const int n = nb + ni * 32 + 8 * a + 4 * h;
          f32x4 xi = *(const f32x4*)(xin + (size_t)m * D_ + n);
          f32x4 xo;
          xo.x = xi.x + scale * acc[ni][mi][4 * a + 0];
          xo.y = xi.y + scale * acc[ni][mi][4 * a + 1];
          xo.z = xi.z + scale * acc[ni][mi][4 * a + 2];
          xo.w = xi.w + scale * acc[ni][mi][4 * a + 3];
          *(f32x4*)(xout + (size_t)m * D_ + n) = xo;
          store4bf(xb + (size_t)m * D_ + n, xo.x, xo.y, xo.z, xo.w);
          part += xo.x * xo.x + xo.y * xo.y + xo.z * xo.z + xo.w * xo.w;
        }
      part += __shfl_xor(part, 32);
      if (h == 0) ssqn[(size_t)m * 16 + (nb >> 6)] = part;
    }
  }
};

struct EpiQKV {
  const float* ssq;
  const float* gq;
  const float* gk;
  const float* bfv;
  bf16_t* Q;
  bf16_t* K;
  bf16_t* VT;
  bf16_t* obuf;
  float* flog;
  int fox;
  DI void operator()(f32x16 (&acc)[2][2], int nb, int mb) const {
    const int lane = tidx() & 63, r = lane & 31, h = lane >> 5;
#pragma unroll
    for (int mi = 0; mi < 2; ++mi) {
      const int m = mb + mi * 32 + r, b = m >> 13, t = m & 8191;
      const float rstd = row_rstd(ssq, m);
      if (nb < 2048) {
        const int isk = nb >= 1024, hh = (nb & 1023) >> 6;
        float v[2][16];
        float ss = 0.f;
#pragma unroll
        for (int ni = 0; ni < 2; ++ni)
#pragma unroll
          for (int i = 0; i < 16; ++i) {
            v[ni][i] = acc[ni][mi][i] * rstd;
            ss += v[ni][i] * v[ni][i];
          }
        if (fox) {
          ss += __shfl_xor(ss, 32);
          const float rinv = rsqrtf(ss * (1.f / 64.f) + 1e-6f);
          const float* g = isk ? gk : gq;
#pragma unroll
          for (int ni = 0; ni < 2; ++ni)
#pragma unroll
            for (int i = 0; i < 16; ++i) v[ni][i] *= rinv * g[ni * 32 + crow(i, h)];
        }
        bf16_t* dst = (isk ? K : Q) + ((size_t)(b * 16 + hh) * S_ + t) * 64;
#pragma unroll
        for (int ni = 0; ni < 2; ++ni)
#pragma unroll
          for (int a = 0; a < 4; ++a)
            store4bf(dst + ni * 32 + 8 * a + 4 * h, v[ni][4 * a], v[ni][4 * a + 1], v[ni][4 * a + 2], v[ni][4 * a + 3]);
      } else if (nb < 3072) {
        const int hh = (nb - 2048) >> 6;
#pragma unroll
        for (int ni = 0; ni < 2; ++ni)
#pragma unroll
          for (int i = 0; i < 16; ++i) {
            const int d = ni * 32 + crow(i, h);
            VT[((size_t)(b * 16 + hh) * 64 + d) * S_ + t] = f2bf(acc[ni][mi][i] * rstd);
          }
      } else if (fox && nb < 4096) {
        const int hh = (nb - 3072) >> 6;
#pragma unroll
        for (int ni = 0; ni < 2; ++ni)
#pragma unroll
          for (int a = 0; a < 4; ++a)
            store4bf(obuf + (size_t)m * D_ + hh * 64 + ni * 32 + 8 * a + 4 * h, sigmoidf_(acc[ni][mi][4 * a] * rstd),
                     sigmoidf_(acc[ni][mi][4 * a + 1] * rstd), sigmoidf_(acc[ni][mi][4 * a + 2] * rstd),
                     sigmoidf_(acc[ni][mi][4 * a + 3] * rstd));
      } else if (fox && nb == 4096) {
#pragma unroll
        for (int i = 0; i < 8; ++i) {
          const int hh = crow(i, h);
          flog[(size_t)(b * 16 + hh) * S_ + t] = logsigmoidf_(acc[0][mi][i] * rstd + bfv[hh]);
        }
      }
    }
  }
};

struct EpiNSA {
  const float* ssq;
  const float* gq;
  const float* gk;
  bf16_t* Q;
  bf16_t* KC;
  bf16_t* KS;
  bf16_t* KW;
  bf16_t* VC;
  bf16_t* VST;
  bf16_t* VWT;
  float* gates;
  DI void operator()(f32x16 (&acc)[2][2], int nb, int mb) const {
    const int lane = tidx() & 63, r = lane & 31, h = lane >> 5;
    if (nb > 2560) return;
#pragma unroll
    for (int mi = 0; mi < 2; ++mi) {
      const int m = mb + mi * 32 + r, b = m >> 13, t = m & 8191;
      const float rstd = row_rstd(ssq, m);
      if (nb == 2560) {
#pragma unroll
        for (int ni = 0; ni < 2; ++ni)
#pragma unroll
          for (int i = 0; i < 16; ++i) {
            const int nl = ni * 32 + crow(i, h);
            if (nl < 48) gates[(size_t)m * 48 + nl] = sigmoidf_(acc[ni][mi][i] * rstd);
          }
        continue;
      }
      int seg = -1, hh;
      if (nb < 1024) {
        hh = nb >> 6;
      } else {
        seg = (nb - 1024) >> 8;
        hh = ((nb - 1024) & 255) >> 6;
      }
      const int kv = b * 4 + hh;
      if (seg == 1) {
        bf16_t* dst = VC + ((size_t)kv * S_ + t) * 64;
#pragma unroll
        for (int ni = 0; ni < 2; ++ni)
#pragma unroll
          for (int a = 0; a < 4; ++a)
            store4bf(dst + ni * 32 + 8 * a + 4 * h, acc[ni][mi][4 * a] * rstd, acc[ni][mi][4 * a + 1] * rstd,
                     acc[ni][mi][4 * a + 2] * rstd, acc[ni][mi][4 * a + 3] * rstd);
      } else if (seg == 3 || seg == 5) {
        bf16_t* dst = (seg == 3 ? VST : VWT);
#pragma unroll
        for (int ni = 0; ni < 2; ++ni)
#pragma unroll
          for (int i = 0; i < 16; ++i) {
            const int d = ni * 32 + crow(i, h);
            dst[((size_t)kv * 64 + d) * S_ + t] = f2bf(acc[ni][mi][i] * rstd);
          }
      } else {
        float v[2][16];
        float ss = 0.f;
#pragma unroll
        for (int ni = 0; ni < 2; ++ni)
#pragma unroll
          for (int i = 0; i < 16; ++i) {
            v[ni][i] = acc[ni][mi][i] * rstd;
            ss += v[ni][i] * v[ni][i];
          }
        ss += __shfl_xor(ss, 32);
        const float rinv = rsqrtf(ss * (1.f / 64.f) + 1e-6f);
        const float* g = (seg < 0) ? gq : gk;
        const float tf = (float)t;
#pragma unroll
        for (int i = 0; i < 16; ++i) {
          const int fi = crow(i, h);
          const float x1 = v[0][i] * rinv * g[fi], x2 = v[1][i] * rinv * g[32 + fi];
          const float inv = exp2f(-(float)fi * 0.41524101186092034f);
          const float ang = tf * inv;
          const float Chi = 0.15915494f, Clo = 6.4206383e-9f;
          const float p = ang * Chi;
          const float e = __builtin_fmaf(ang, Chi, -p);
          const float fr = (p - floorf(p)) + (e + ang * Clo);
          const float sn = __builtin_amdgcn_sinf(fr), cs = __builtin_amdgcn_cosf(fr);
          v[0][i] = x1 * cs - x2 * sn;
          v[1][i] = x2 * cs + x1 * sn;
          if ((i & 1) == 1) __builtin_amdgcn_sched_barrier(0);
        }
        bf16_t* dst;
        if (seg < 0)
          dst = Q + ((size_t)(b * 16 + hh) * S_ + t) * 64;
        else
          dst = (seg == 0 ? KC : (seg == 2 ? KS : KW)) + ((size_t)kv * S_ + t) * 64;
#pragma unroll
        for (int ni = 0; ni < 2; ++ni)
#pragma unroll
          for (int a = 0; a < 4; ++a)
            store4bf(dst + ni * 32 + 8 * a + 4 * h, v[ni][4 * a], v[ni][4 * a + 1], v[ni][4 * a + 2], v[ni][4 * a + 3]);
      }
    }
  }
};

struct EpiGLA {
  const float* ssq;
  bf16_t* QG;
  bf16_t* KG;
  bf16_t* VTG;
  bf16_t* obuf;
  float* glow;
  DI void operator()(f32x16 (&acc)[2][2], int nb, int mb) const {
    const int lane = tidx() & 63, r = lane & 31, h = lane >> 5;
    if (nb > 3072) return;
#pragma unroll
    for (int mi = 0; mi < 2; ++mi) {
      const int m = mb + mi * 32 + r, b = m >> 13, t = m & 8191;
      const float rstd = row_rstd(ssq, m);
      if (nb < 1024) {
        bf16_t* dst = (nb < 512 ? QG + (size_t)m * 512 + nb : KG + (size_t)m * 512 + (nb - 512));
#pragma unroll
        for (int ni = 0; ni < 2; ++ni)
#pragma unroll
          for (int a = 0; a < 4; ++a)
            store4bf(dst + ni * 32 + 8 * a + 4 * h, acc[ni][mi][4 * a] * rstd, acc[ni][mi][4 * a + 1] * rstd,
                     acc[ni][mi][4 * a + 2] * rstd, acc[ni][mi][4 * a + 3] * rstd);
      } else if (nb < 2048) {
#pragma unroll
        for (int ni = 0; ni < 2; ++ni)
#pragma unroll
          for (int i = 0; i < 16; ++i) {
            const int e = nb - 1024 + ni * 32 + crow(i, h);
            VTG[((size_t)b * 1024 + e) * S_ + t] = f2bf(acc[ni][mi][i] * rstd);
          }
      } else if (nb < 3072) {
#pragma unroll
        for (int ni = 0; ni < 2; ++ni)
#pragma unroll
          for (int a = 0; a < 4; ++a) {
            float v[4];
#pragma unroll
            for (int q = 0; q < 4; ++q) {
              float z = acc[ni][mi][4 * a + q] * rstd;
              v[q] = z * sigmoidf_(z);
            }
            store4bf(obuf + (size_t)m * D_ + (nb - 2048) + ni * 32 + 8 * a + 4 * h, v[0], v[1], v[2], v[3]);
          }
      } else {
#pragma unroll
        for (int i = 0; i < 8; ++i) glow[(size_t)m * 16 + crow(i, h)] = acc[0][mi][i] * rstd;
      }
    }
  }
};

struct EpiCmp {
  const float* cb;
  const float* gk;
  bf16_t* dst;
  int isv;
  DI void operator()(f32x16 (&acc)[2][2], int nb, int mb) const {
    const int lane = tidx() & 63, r = lane & 31, h = lane >> 5;
    if (nb != 0) return;
#pragma unroll
    for (int mi = 0; mi < 2; ++mi) {
      const int n = mb + mi * 32 + r;
      const bool ok = n < 511;
      float v[2][16];
      float ss = 0.f;
#pragma unroll
      for (int ni = 0; ni < 2; ++ni)
#pragma unroll
        for (int i = 0; i < 16; ++i) {
          v[ni][i] = ok ? acc[ni][mi][i] + cb[ni * 32 + crow(i, h)] : 0.f;
          ss += v[ni][i] * v[ni][i];
        }
      if (!isv) {
        ss += __shfl_xor(ss, 32);
        const float rinv = rsqrtf(ss * (1.f / 64.f) + 1e-6f);
#pragma unroll
        for (int ni = 0; ni < 2; ++ni)
#pragma unroll
          for (int a = 0; a < 4; ++a) {
            const int e = ni * 32 + 8 * a + 4 * h;
            store4bf(dst + (size_t)n * 64 + e, v[ni][4 * a] * rinv * gk[e], v[ni][4 * a + 1] * rinv * gk[e + 1],
                     v[ni][4 * a + 2] * rinv * gk[e + 2], v[ni][4 * a + 3] * rinv * gk[e + 3]);
          }
      } else {
#pragma unroll
        for (int ni = 0; ni < 2; ++ni)
#pragma unroll
          for (int i = 0; i < 16; ++i) dst[(size_t)(ni * 32 + crow(i, h)) * 512 + n] = f2bf(v[ni][i]);
      }
    }
  }
};

template <class Src>
DI void prep_job(bf16_t* dst, int Npad, int K, float* sT, Src src) {
  const int tid = tidx();
  const int NT = Npad >> 6, KT = K >> 6;
  for (int t = bidx(); t < NT * KT; t += gridDim.x) {
    const int nt = t % NT, kt = t / NT;
    __syncthreads();
#pragma unroll 4
    for (int i = 0; i < 16; ++i) {
      const int e = tid + 256 * i, kk = e >> 6, nn = e & 63;
      sT[kk * 65 + nn] = src(kt * 64 + kk, nt * 64 + nn);
    }
    __syncthreads();
#pragma unroll 4
    for (int i = 0; i < 8; ++i) {
      const int e = tid + 256 * i, nn = e >> 5, kp = e & 31;
      *(unsigned*)(dst + (size_t)(nt * 64 + nn) * K + kt * 64 + 2 * kp) = pack2(sT[(2 * kp) * 65 + nn], sT[(2 * kp + 1) * 65 + nn]);
    }
  }
}

DI void prep_layer(const Params& P, int L, char* smem) {
  float* sT = (float*)smem;
  char* ws = wsp(P);
  const float* ng = inp(P, 1) + (size_t)L * 3 * D_;
  for (int f = 0; f < 2; ++f) {
    const float* wg = inp(P, f ? 5 : 2) + (size_t)L * D_ * F_;
    const float* wu = inp(P, f ? 6 : 3) + (size_t)L * D_ * F_;
    const float* wd = inp(P, f ? 7 : 4) + (size_t)L * D_ * F_;
    const float* g = ng + (f ? 2 * D_ : 0);
    prep_job((bf16_t*)(ws + (f ? OFF_W2 : OFF_W1)), 2 * F_, D_, sT, [=](int k, int n) {
      const int grp = n >> 6, rr = n & 63;
      const float* s = rr < 32 ? wg : wu;
      return s[(size_t)k * F_ + grp * 32 + (rr & 31)] * g[k];
    });
    prep_job((bf16_t*)(ws + (f ? OFF_W2D : OFF_W1D)), D_, F_, sT, [=](int k, int n) { return wd[(size_t)k * D_ + n]; });
  }
  const float* g1 = ng + D_;
  bf16_t* wmi = (bf16_t*)(ws + OFF_WMI);
  bf16_t* wmo = (bf16_t*)(ws + OFF_WMO);
  if (L == 0) {
    const float* w = inp(P, 8);
    prep_job(wmi, 4224, D_, sT, [=](int k, int n) {
      int c = n < 3072 ? n : (n < 4096 ? n + 16 : (n < 4112 ? n - 1024 : -1));
      return c < 0 ? 0.f : w[(size_t)k * 4112 + c] * g1[k];
    });
    const float* wo = inp(P, 12);
    prep_job(wmo, D_, D_, sT, [=](int k, int n) { return wo[(size_t)k * D_ + n]; });
  } else if (L == 1) {
    const float* w = inp(P, 13);
    prep_job(wmi, 2688, D_, sT, [=](int k, int n) { return n < 2608 ? w[(size_t)k * 2608 + n] * g1[k] : 0.f; });
    const float* wo = inp(P, 20);
    prep_job(wmo, D_, D_, sT, [=](int k, int n) { return wo[(size_t)k * D_ + n]; });
    const float* wck = inp(P, 16);
    const float* wcv = inp(P, 17);
    prep_job((bf16_t*)(ws + OFF_WCK), 128, 2048, sT, [=](int k, int n) { return n < 64 ? wck[(size_t)k * 64 + n] : 0.f; });
    prep_job((bf16_t*)(ws + OFF_WCV), 128, 2048, sT, [=](int k, int n) { return n < 64 ? wcv[(size_t)k * 64 + n] : 0.f; });
    if (bidx() == 0 && tidx() < 128) {
      const int e = tidx() & 63, which = tidx() >> 6;
      const float* pos = which ? inp(P, 15) : inp(P, 14);
      const float* wc = which ? inp(P, 17) : inp(P, 16);
      float s = 0.f;
      for (int kd = 0; kd < 2048; ++kd) s += pos[kd] * wc[(size_t)kd * 64 + e];
      ((float*)(ws + OFF_CBIAS))[which * 64 + e] = s;
    }
  } else if (L == 2) {
    const float* w = inp(P, 21);
    prep_job(wmi, 3200, D_, sT, [=](int k, int n) {
      int c = n < 2048 ? n : (n < 3072 ? n + 16 : (n < 3088 ? n - 1024 : -1));
      return c < 0 ? 0.f : w[(size_t)k * 3088 + c] * g1[k];
    });
    const float* wo = inp(P, 25);
    prep_job(wmo, D_, D_, sT, [=](int k, int n) { return wo[(size_t)k * D_ + n]; });
  } else {
    const float* w = inp(P, 26);
    prep_job(wmi, 3072, D_, sT, [=](int k, int n) { return w[(size_t)k * 3072 + n] * g1[k]; });
    const float* wo = inp(P, 27);
    prep_job(wmo, D_, D_, sT, [=](int k, int n) { return wo[(size_t)k * D_ + n]; });
  }
}

DI void init_phase(const Params& P) {
  const int tid = tidx(), lane = tid & 63, wave = tid >> 6;
  float* ssq = (float*)(wsp(P) + OFF_SSQ);
  bf16_t* xb = (bf16_t*)(wsp(P) + OFF_XB);
  const float* x = inp(P, 0);
  for (int row = bidx() * 4 + wave; row < M_; row += gridDim.x * 4) {
    float s = 0.f;
#pragma unroll
    for (int i = 0; i < 4; ++i) {
      const int c = (i * 64 + lane) * 4;
      f32x4 v = *(const f32x4*)(x + (size_t)row * D_ + c);
      s += v.x * v.x + v.y * v.y + v.z * v.z + v.w * v.w;
      store4bf(xb + (size_t)row * D_ + c, v.x, v.y, v.z, v.w);
    }
#pragma unroll
    for (int o = 32; o >= 1; o >>= 1) s += __shfl_xor(s, o);
    if (lane < 16) ssq[(size_t)row * 16 + lane] = (lane == 0) ? s : 0.f;
  }
}

struct AttnSmem {
  bf16_t k[64 * 72];
  bf16_t v[64 * 72];
  float c[64];
};

DI void attn_load(const bf16_t* Kb, int ldk, const bf16_t* VTb, int ldv, int j, u32x4 (&kr)[2], u32x4 (&vr)[2]) {
  const int tid = tidx();
#pragma unroll
  for (int i = 0; i < 2; ++i) {
    const int c = tid + 256 * i, row = c >> 3, cc = c & 7;
    kr[i] = *(const u32x4*)(Kb + (size_t)(j * 64 + row) * ldk + cc * 8);
    vr[i] = *(const u32x4*)(VTb + (size_t)row * ldv + j * 64 + cc * 8);
  }
}
DI void attn_store(AttnSmem& sm, const u32x4 (&kr)[2], const u32x4 (&vr)[2]) {
  const int tid = tidx();
#pragma unroll
  for (int i = 0; i < 2; ++i) {
    const int c = tid + 256 * i, row = c >> 3, cc = c & 7;
    *(u32x4*)(sm.k + row * 72 + cc * 8) = kr[i];
    *(u32x4*)(sm.v + row * 72 + cc * 8) = vr[i];
  }
}
DI void attn_qk(const AttnSmem& sm, const bf16x8 (&qf)[4], f32x16 (&st)[2]) {
  const int lane = tidx() & 63, r = lane & 31, h = lane >> 5;
#pragma unroll
  for (int kt = 0; kt < 2; ++kt) {
    zero16(st[kt]);
#pragma unroll
    for (int kk = 0; kk < 4; ++kk) {
      bf16x8 a = *(const bf16x8*)(sm.k + (kt * 32 + r) * 72 + kk * 16 + h * 8);
      st[kt] = MFMA(a, qf[kk], st[kt]);
    }
  }
}
DI void attn_pv(const AttnSmem& sm, const f32x16 (&st)[2], f32x16 (&o)[2]) {
  const int lane = tidx() & 63, r = lane & 31, h = lane >> 5;
#pragma unroll
  for (int kt = 0; kt < 2; ++kt)
#pragma unroll
    for (int s2 = 0; s2 < 2; ++s2) {
      bf16x8 pk = pack8(st[kt][8 * s2], st[kt][8 * s2 + 1], st[kt][8 * s2 + 2], st[kt][8 * s2 + 3], st[kt][8 * s2 + 4],
                        st[kt][8 * s2 + 5], st[kt][8 * s2 + 6], st[kt][8 * s2 + 7]);
#pragma unroll
      for (int dt = 0; dt < 2; ++dt) {
        const bf16_t* p = sm.v + (dt * 32 + r) * 72 + kt * 32 + 16 * s2 + 4 * h;
        bf16x8 a = cat4(*(const bf16x4*)p, *(const bf16x4*)(p + 8));
        o[dt] = MFMA(a, pk, o[dt]);
      }
    }
}
DI void load_qf(const bf16_t* Qrow, bf16x8 (&qf)[4]) {
  const int h = (tidx() & 63) >> 5;
#pragma unroll
  for (int kk = 0; kk < 4; ++kk) qf[kk] = *(const bf16x8*)(Qrow + kk * 16 + h * 8);
}

template <int MODE>
DI void flash_pass(const bf16_t* Kb, const bf16_t* VTb, const float* cB, float cq, u32x4 selw, int qw, int jlo, int jhi,
                   const bf16x8 (&qf)[4], f32x16 (&o)[2], float& lsum, AttnSmem& sm) {
  const int tid = tidx(), lane = tid & 63, r = lane & 31, h = lane >> 5;
  const int query = qw + r;
  float m_run = -1e30f, l_run = 0.f;
  zero16(o[0]);
  zero16(o[1]);
  u32x4 kr[2], vr[2];
  float cr = 0.f;
  attn_load(Kb, 64, VTb, S_, jlo, kr, vr);
  if (MODE == 0 && tid < 64) cr = cB[jlo * 64 + tid];
  for (int j = jlo; j <= jhi; ++j) {
    __syncthreads();
    attn_store(sm, kr, vr);
    if (MODE == 0 && tid < 64) sm.c[tid] = cr;
    __syncthreads();
    if (j < jhi) {
      attn_load(Kb, 64, VTb, S_, j + 1, kr, vr);
      if (MODE == 0 && tid < 64) cr = cB[(j + 1) * 64 + tid];
    }
    bool active = (j * 64 <= qw + 31);
    bool bit = true;
    if (MODE == 1) active = active && (j * 64 + 63 >= qw - 511);
    if (MODE == 2) {
      const int wi = j >> 5;
      const unsigned w = wi == 0 ? selw.x : (wi == 1 ? selw.y : (wi == 2 ? selw.z : selw.w));
      bit = (w >> (j & 31)) & 1u;
      active = active && (__ballot(bit) != 0ull);
    }
    if (active) {
      f32x16 st[2];
      attn_qk(sm, qf, st);
      const float SC = 0.125f * 1.4426950408889634f;
      const bool interior = (MODE != 0) && (j * 64 + 63 <= qw) && (MODE != 1 || (qw + 31 - j * 64 < 512));
      float mx = -1e30f;
      if (interior) {
#pragma unroll
        for (int kt = 0; kt < 2; ++kt)
#pragma unroll
          for (int i = 0; i < 16; ++i) {
            const float s = st[kt][i] * SC;
            st[kt][i] = s;
            mx = fmaxf(mx, s);
          }
        if (MODE == 2 && !bit) mx = -1e30f;
      } else {
#pragma unroll
        for (int kt = 0; kt < 2; ++kt)
#pragma unroll
          for (int i = 0; i < 16; ++i) {
            const int kl = kt * 32 + crow(i, h);
            const int key = j * 64 + kl;
            float s = st[kt][i] * SC;
            bool ok = key <= query;
            if (MODE == 0) s += (cq - sm.c[kl]) * 1.4426950408889634f;
            if (MODE == 1) ok = ok && (query - key < 512);
            if (MODE == 2) ok = ok && bit;
            s = ok ? s : -1e30f;
            st[kt][i] = s;
            mx = fmaxf(mx, s);
          }
      }
      mx = fmaxf(mx, __shfl_xor(mx, 32));
      const float m_new = fmaxf(m_run, mx);
      const float alpha = __builtin_amdgcn_exp2f(m_run - m_new);
      float ps = 0.f;
      if (interior) {
#pragma unroll
        for (int kt = 0; kt < 2; ++kt)
#pragma unroll
          for (int i = 0; i < 16; ++i) {
            float p = __builtin_amdgcn_exp2f(st[kt][i] - m_new);
            if (MODE == 2) p = bit ? p : 0.f;
            st[kt][i] = p;
            ps += p;
          }
      } else {
#pragma unroll
        for (int kt = 0; kt < 2; ++kt)
#pragma unroll
          for (int i = 0; i < 16; ++i) {
            const float s = st[kt][i];
            const float p = (s > -1e29f) ? __builtin_amdgcn_exp2f(s - m_new) : 0.f;
            st[kt][i] = p;
            ps += p;
          }
      }
      ps += __shfl_xor(ps, 32);
      l_run = l_run * alpha + ps;
      if (__ballot(m_new > m_run) != 0ull) {
#pragma unroll
        for (int dt = 0; dt < 2; ++dt)
#pragma unroll
          for (int i = 0; i < 16; ++i) o[dt][i] *= alpha;
      }
      m_run = m_new;
      attn_pv(sm, st, o);
    }
  }
  lsum = l_run;
}

DI void fox_pass(const bf16_t* Kb, const bf16_t* VTb, const float* cB, float cq, float sbound, int qw, int jhi,
                 const bf16x8 (&qf)[4], f32x16 (&o)[2], float& lsum, AttnSmem& sm) {
  const int tid = tidx(), lane = tid & 63, r = lane & 31, h = lane >> 5;
  const int query = qw + r;
  float m_run = -1e30f, l_run = 0.f;
  zero16(o[0]);
  zero16(o[1]);
  u32x4 kr[2], vr[2];
  float cr = 0.f;
  int done = 0;
  attn_load(Kb, 64, VTb, S_, jhi, kr, vr);
  if (tid < 64) cr = cB[jhi * 64 + tid];
  for (int j = jhi; j >= 0; --j) {
    if (__syncthreads_and(done)) break;
    attn_store(sm, kr, vr);
    if (tid < 64) sm.c[tid] = cr;
    __syncthreads();
    if (j > 0) {
      attn_load(Kb, 64, VTb, S_, j - 1, kr, vr);
      if (tid < 64) cr = cB[(j - 1) * 64 + tid];
    }
    if (j * 64 <= qw + 31) {
      f32x16 st[2];
      attn_qk(sm, qf, st);
      float mx = -1e30f;
#pragma unroll
      for (int kt = 0; kt < 2; ++kt)
#pragma unroll
        for (int i = 0; i < 16; ++i) {
          const int kl = kt * 32 + crow(i, h);
          const int key = j * 64 + kl;
          float s = st[kt][i] * 0.125f + (cq - sm.c[kl]);
          s = (key <= query) ? s : -1e30f;
          st[kt][i] = s;
          mx = fmaxf(mx, s);
        }
      mx = fmaxf(mx, __shfl_xor(mx, 32));
      const float m_new = fmaxf(m_run, mx);
      const float alpha = __expf(m_run - m_new);
      float ps = 0.f;
#pragma unroll
      for (int kt = 0; kt < 2; ++kt)
#pragma unroll
        for (int i = 0; i < 16; ++i) {
          const float s = st[kt][i];
          const float p = (s > -1e29f) ? __expf(s - m_new) : 0.f;
          st[kt][i] = p;
          ps += p;
        }
      ps += __shfl_xor(ps, 32);
      l_run = l_run * alpha + ps;
      m_run = m_new;
#pragma unroll
      for (int dt = 0; dt < 2; ++dt)
#pragma unroll
        for (int i = 0; i < 16; ++i) o[dt][i] *= alpha;
      attn_pv(sm, st, o);
      done = (sbound + cq - sm.c[0] < m_run - 104.f) ? 1 : 0;
    }
  }
  lsum = l_run;
}
DI void fox_scan_phase(const Params& P, char* smem) {
  double* sp = (double*)smem;
  const float* flog = (const float*)(wsp(P) + OFF_FLOG);
  float* c = (float*)(wsp(P) + OFF_C);
  const int tid = tidx();
  for (int seq = bidx(); seq < 64; seq += gridDim.x) {
    const float* src = flog + (size_t)seq * S_ + tid * 32;
    double tot = 0.0;
    for (int i = 0; i < 32; ++i) tot += (double)src[i];
    __syncthreads();
    sp[tid] = tot;
    __syncthreads();
    double pre = 0.0;
    for (int i = 0; i < tid; ++i) pre += sp[i];
    float* dst = c + (size_t)seq * S_ + tid * 32;
    for (int i = 0; i < 32; ++i) {
      pre += (double)src[i];
      dst[i] = (float)pre;
    }
  }
}

DI void fox_attn_phase(const Params& P, char* smem, int rep) {
  AttnSmem& sm = *(AttnSmem*)smem;
  const bf16_t* Q = (const bf16_t*)(wsp(P) + OFF_R);
  const bf16_t* K = Q + (size_t)M_ * D_;
  const bf16_t* VT = K + (size_t)M_ * D_;
  const float* c = (const float*)(wsp(P) + OFF_C);
  bf16_t* obuf = (bf16_t*)(wsp(P) + OFF_OBUF);
  const int lane = tidx() & 63, wave = tidx() >> 6, r = lane & 31, h = lane >> 5;
  float gqm = 0.f, gkm = 0.f;
  for (int d = 0; d < 64; ++d) {
    gqm = fmaxf(gqm, fabsf(inp(P, 10)[d]));
    gkm = fmaxf(gkm, fabsf(inp(P, 11)[d]));
  }
  const float sbound = 8.16f * gqm * gkm;
  for (int it = bidx(); it < 4096; it += gridDim.x) {
    const int qt = 63 - (it >> 6), bh = it & 63;
    const int q0 = qt * 128, qw = q0 + wave * 32, query = qw + r;
    bf16x8 qf[4];
    load_qf(Q + ((size_t)bh * S_ + query) * 64, qf);
    const float cq = c[(size_t)bh * S_ + query];
    f32x16 o[2];
    float l;
    fox_pass(K + (size_t)bh * S_ * 64, VT + (size_t)bh * 64 * S_, c + (size_t)bh * S_, cq, sbound, qw, 2 * qt + 1, qf, o, l, sm);
    const float inv = 1.f / l;
    const int b = bh >> 4, hh = bh & 15;
    bf16_t* dst = obuf + ((size_t)b * S_ + query) * D_ + hh * 64;
#pragma unroll
    for (int dt = 0; dt < 2; ++dt)
#pragma unroll
      for (int a = 0; a < 4; ++a) {
        bf16_t* p = dst + dt * 32 + 8 * a + 4 * h;
        u32x2 g = *(const u32x2*)p;
        if (rep) *(u32x2*)p = g;
        else
        store4bf(p, o[dt][4 * a] * inv * bflo(g.x), o[dt][4 * a + 1] * inv * bfhi(g.x), o[dt][4 * a + 2] * inv * bflo(g.y),
                 o[dt][4 * a + 3] * inv * bfhi(g.y));
      }
  }
}

DI void sb_attn_phase(const Params& P, char* smem) {
  AttnSmem& sm = *(AttnSmem*)smem;
  const bf16_t* Q = (const bf16_t*)(wsp(P) + OFF_R);
  const bf16_t* K = Q + (size_t)M_ * D_;
  const bf16_t* VT = K + (size_t)M_ * D_;
  bf16_t* obuf = (bf16_t*)(wsp(P) + OFF_OBUF);
  const int tid = tidx(), lane = tid & 63, wave = tid >> 6, r = lane & 31, h = lane >> 5;
  bf16x8 tdiag[2], ones;
#pragma unroll
  for (int s2 = 0; s2 < 2; ++s2)
#pragma unroll
    for (int jj = 0; jj < 8; ++jj) {
      const int kj = 16 * s2 + 8 * (jj >> 2) + 4 * h + (jj & 3);
      tdiag[s2][jj] = (kj > r) ? (short)0x3f80 : (short)0;
    }
#pragma unroll
  for (int jj = 0; jj < 8; ++jj) ones[jj] = (short)0x3f80;

  for (int it = bidx(); it < 4096; it += gridDim.x) {
    const int qt = 63 - (it >> 6), bh = it & 63;
    const int q0 = qt * 128, qw = q0 + wave * 32, query = qw + r;
    const bf16_t* Kb = K + (size_t)bh * S_ * 64;
    const bf16_t* VTb = VT + (size_t)bh * 64 * S_;
    bf16x8 qf[4];
    load_qf(Q + ((size_t)bh * S_ + query) * 64, qf);
    f32x16 o[2];
    zero16(o[0]);
    zero16(o[1]);
    float R = 0.f;
    u32x4 kr[2], vr[2];
    const int jhi = 2 * qt + 1;
    attn_load(Kb, 64, VTb, S_, jhi, kr, vr);
    for (int j = jhi; j >= 0; --j) {
      if (__syncthreads_and(R < -110.f)) break;
      attn_store(sm, kr, vr);
      __syncthreads();
      if (j > 0) attn_load(Kb, 64, VTb, S_, j - 1, kr, vr);
      if (j * 64 < qw + 31) {
        f32x16 st[2], Lv[2], lat[2];
        attn_qk(sm, qf, st);
        float tot = 0.f;
#pragma unroll
        for (int kt = 0; kt < 2; ++kt)
#pragma unroll
          for (int i = 0; i < 16; ++i) {
            const int key = j * 64 + kt * 32 + crow(i, h);
            const float z = st[kt][i] * 0.125f;
            const float sp = fmaxf(z, 0.f) + __logf(1.f + __expf(-fabsf(z)));
            const float L = (key < query) ? -sp : 0.f;
            st[kt][i] = z;
            Lv[kt][i] = L;
            tot += L;
          }
        tot += __shfl_xor(tot, 32);
        bf16x8 hi[2][2], lo[2][2];
#pragma unroll
        for (int kt = 0; kt < 2; ++kt)
#pragma unroll
          for (int s2 = 0; s2 < 2; ++s2) {
            float hv[8], lv[8];
#pragma unroll
            for (int q = 0; q < 8; ++q) {
              const float L = Lv[kt][8 * s2 + q];
              hv[q] = bf2f(f2bf(L));
              lv[q] = L - hv[q];
            }
            hi[kt][s2] = pack8(hv[0], hv[1], hv[2], hv[3], hv[4], hv[5], hv[6], hv[7]);
            lo[kt][s2] = pack8(lv[0], lv[1], lv[2], lv[3], lv[4], lv[5], lv[6], lv[7]);
          }
        zero16(lat[0]);
        zero16(lat[1]);
#pragma unroll
        for (int s2 = 0; s2 < 2; ++s2) {
          lat[0] = MFMA(tdiag[s2], hi[0][s2], lat[0]);
          lat[0] = MFMA(tdiag[s2], lo[0][s2], lat[0]);
          lat[0] = MFMA(ones, hi[1][s2], lat[0]);
          lat[0] = MFMA(ones, lo[1][s2], lat[0]);
          lat[1] = MFMA(tdiag[s2], hi[1][s2], lat[1]);
          lat[1] = MFMA(tdiag[s2], lo[1][s2], lat[1]);
        }
#pragma unroll
        for (int kt = 0; kt < 2; ++kt)
#pragma unroll
          for (int i = 0; i < 16; ++i) {
            const int key = j * 64 + kt * 32 + crow(i, h);
            const float e = st[kt][i] + Lv[kt][i] + lat[kt][i] + R;
            st[kt][i] = (key < query) ? __expf(e) : 0.f;
          }
        R += tot;
        attn_pv(sm, st, o);
      }
    }
    const int b = bh >> 4, hh = bh & 15;
    bf16_t* dst = obuf + ((size_t)b * S_ + query) * D_ + hh * 64;
#pragma unroll
    for (int dt = 0; dt < 2; ++dt)
#pragma unroll
      for (int a = 0; a < 4; ++a)
        store4bf(dst + dt * 32 + 8 * a + 4 * h, o[dt][4 * a], o[dt][4 * a + 1], o[dt][4 * a + 2], o[dt][4 * a + 3]);
  }
}

DI void nsa_compress_phase(const Params& P, char* smem) {
  bf16_t* sW = (bf16_t*)smem;
  bf16_t* sX = sW + 128 * 72;
  const bf16_t* KC = (const bf16_t*)(wsp(P) + OFF_R + 64 * MiB);
  const bf16_t* VC = (const bf16_t*)(wsp(P) + OFF_R + 112 * MiB);
  const float* cb = (const float*)(wsp(P) + OFF_CBIAS);
  const int wave = tidx() >> 6, wn = wave >> 1, wm = wave & 1;
  for (int t = bidx(); t < 64; t += gridDim.x) {
    const int isv = t >> 5, kv = (t >> 1) & 15, mt = t & 1;
    const bf16_t* Wt = (const bf16_t*)(wsp(P) + (isv ? OFF_WCV : OFF_WCK));
    const bf16_t* X = (isv ? VC : KC) + ((size_t)kv * S_ + (size_t)mt * 256 * 16) * 64;
    f32x16 acc[2][2][2];
    gemm_tile<2>(Wt, 2048, X, 1024, 2048, sW, sX, acc);
    EpiCmp epi;
    epi.cb = cb + isv * 64;
    epi.gk = inp(P, 19);
    epi.isv = isv;
    epi.dst = isv ? (bf16_t*)(wsp(P) + OFF_VCMPT) + (size_t)kv * 64 * 512 : (bf16_t*)(wsp(P) + OFF_KCMP) + (size_t)kv * 512 * 64;
    epi(acc[0], wn * 64, mt * 256 + wm * 128);
    epi(acc[1], wn * 64, mt * 256 + wm * 128 + 64);
  }
}

struct CmpSmem {
  AttnSmem a;
  float imp[32 * 132];
};

DI void nsa_cmp_phase(const Params& P, char* smem) {
  CmpSmem& sm = *(CmpSmem*)smem;
  const bf16_t* Q = (const bf16_t*)(wsp(P) + OFF_R);
  const bf16_t* KCMP = (const bf16_t*)(wsp(P) + OFF_KCMP);
  const bf16_t* VCMPT = (const bf16_t*)(wsp(P) + OFF_VCMPT);
  const float* gates = (const float*)(wsp(P) + OFF_GATES);
  bf16_t* obuf = (bf16_t*)(wsp(P) + OFF_OBUF);
  u32x4* sel = (u32x4*)(wsp(P) + OFF_SEL);
  const int tid = tidx(), lane = tid & 63, wave = tid >> 6, r = lane & 31, h = lane >> 5;
  for (int it = bidx(); it < 4096; it += gridDim.x) {
    const int tt = 255 - (it >> 4), kv = it & 15, b = kv >> 2, g = kv & 3;
    const int t0 = tt * 32, head = g * 4 + wave, query = t0 + r;
    const bf16_t* Kb = KCMP + (size_t)kv * 512 * 64;
    const bf16_t* VTb = VCMPT + (size_t)kv * 64 * 512;
    bf16x8 qf[4];
    load_qf(Q + ((size_t)(b * 16 + head) * S_ + query) * 64, qf);
    const int ntiles = ((t0 >> 4) >> 6) + 1;
    __syncthreads();
    for (int e = tid; e < 32 * 132; e += 256) sm.imp[e] = 0.f;
    float m_run = -1e30f, l_run = 0.f;
    u32x4 kr[2], vr[2];
    for (int jt = 0; jt < ntiles; ++jt) {
      attn_load(Kb, 64, VTb, 512, jt, kr, vr);
      __syncthreads();
      attn_store(sm.a, kr, vr);
      __syncthreads();
      f32x16 st[2];
      attn_qk(sm.a, qf, st);
      float mx = -1e30f;
#pragma unroll
      for (int kt = 0; kt < 2; ++kt)
#pragma unroll
        for (int i = 0; i < 16; ++i) {
          const int n = jt * 64 + kt * 32 + crow(i, h);
          const float s = (16 * n + 31 <= query) ? st[kt][i] * 0.125f : -1e30f;
          st[kt][i] = s;
          mx = fmaxf(mx, s);
        }
      mx = fmaxf(mx, __shfl_xor(mx, 32));
      const float m_new = fmaxf(m_run, mx);
      float ps = 0.f;
#pragma unroll
      for (int kt = 0; kt < 2; ++kt)
#pragma unroll
        for (int i = 0; i < 16; ++i) ps += (st[kt][i] > -1e29f) ? __expf(st[kt][i] - m_new) : 0.f;
      ps += __shfl_xor(ps, 32);
      l_run = l_run * __expf(m_run - m_new) + ps;
      m_run = m_new;
    }
    const float linv = l_run > 0.f ? 1.f / l_run : 0.f;
    f32x16 o[2];
    zero16(o[0]);
    zero16(o[1]);
    for (int jt = 0; jt < ntiles; ++jt) {
      attn_load(Kb, 64, VTb, 512, jt, kr, vr);
      __syncthreads();
      attn_store(sm.a, kr, vr);
      __syncthreads();
      f32x16 st[2];
      attn_qk(sm.a, qf, st);
#pragma unroll
      for (int kt = 0; kt < 2; ++kt)
#pragma unroll
        for (int i = 0; i < 16; ++i) {
          const int n = jt * 64 + kt * 32 + crow(i, h);
          st[kt][i] = (16 * n + 31 <= query) ? __expf(st[kt][i] * 0.125f - m_run) * linv : 0.f;
        }
      attn_pv(sm.a, st, o);
      for (int w = 0; w < 4; ++w) {
        if (wave == w) {
          float* ip = sm.imp + r * 132 + jt * 16 + h;
#pragma unroll
          for (int kt = 0; kt < 2; ++kt)
#pragma unroll
            for (int a = 0; a < 4; ++a) {
              const float G = st[kt][4 * a] + st[kt][4 * a + 1] + st[kt][4 * a + 2] + st[kt][4 * a + 3];
              const float x = __shfl_xor(st[kt][4 * a + 3], 32);
              ip[kt * 8 + 2 * a] += G + (h ? x : 0.f);
              if (!h) ip[kt * 8 + 2 * a + 2] += x;
            }
        }
        __syncthreads();
      }
    }
    {
      const size_t m = (size_t)b * S_ + query;
      float gc = gates[m * 48 + head * 3 + 0];
#if ABL == 3
      gc = 0.f;
#endif
      bf16_t* dst = obuf + m * D_ + head * 64;
#pragma unroll
      for (int dt = 0; dt < 2; ++dt)
#pragma unroll
        for (int a = 0; a < 4; ++a)
          store4bf(dst + dt * 32 + 8 * a + 4 * h, o[dt][4 * a] * gc, o[dt][4 * a + 1] * gc, o[dt][4 * a + 2] * gc,
                   o[dt][4 * a + 3] * gc);
    }
    for (int tk = 0; tk < 8; ++tk) {
      const int tl = wave * 8 + tk, t = t0 + tl, cur = t >> 6;
      const float* ip = sm.imp + tl * 132;
      const int j0 = lane, j1 = lane + 64;
      const bool f0 = (j0 == 0) || (j0 == cur) || (j0 == cur - 1);
      const bool f1 = (j1 == cur) || (j1 == cur - 1);
      const float v0 = f0 ? 1e9f : (j0 <= cur ? ip[j0] : -1.f);
      const float v1 = f1 ? 1e9f : (j1 <= cur ? ip[j1] : -1.f);
      int r0 = 0, r1 = 0;
      for (int jp = 0; jp <= cur; ++jp) {
        const bool fp = (jp == 0) || (jp == cur) || (jp == cur - 1);
        const float vp = fp ? 1e9f : ip[jp];
        r0 += (vp > v0 || (vp == v0 && jp < j0)) ? 1 : 0;
        r1 += (vp > v1 || (vp == v1 && jp < j1)) ? 1 : 0;
      }
      const unsigned long long m0 = __ballot(j0 <= cur && r0 < 16);
      const unsigned long long m1 = __ballot(j1 <= cur && r1 < 16);
      if (lane == 0) {
        u32x4 w;
        w.x = (unsigned)m0;
        w.y = (unsigned)(m0 >> 32);
        w.z = (unsigned)m1;
        w.w = (unsigned)(m1 >> 32);
        sel[(size_t)kv * S_ + t] = w;
      }
    }
  }
}

DI void nsa_attn_phase(const Params& P, char* smem, int rep) {
  AttnSmem& sm = *(AttnSmem*)smem;
  char* R = wsp(P) + OFF_R;
  const bf16_t* Q = (const bf16_t*)R;
  const bf16_t* KS = (const bf16_t*)(R + 80 * MiB);
  const bf16_t* KW = (const bf16_t*)(R + 96 * MiB);
  const bf16_t* VST = (const bf16_t*)(R + 128 * MiB);
  const bf16_t* VWT = (const bf16_t*)(R + 144 * MiB);
  const float* gates = (const float*)(wsp(P) + OFF_GATES);
  const u32x4* sel = (const u32x4*)(wsp(P) + OFF_SEL);
  bf16_t* obuf = (bf16_t*)(wsp(P) + OFF_OBUF);
  const int lane = tidx() & 63, wave = tidx() >> 6, r = lane & 31, h = lane >> 5;
  for (int it = bidx(); it < 4096; it += gridDim.x) {
    const int qt = 63 - (it >> 6), jx = it & 7, jy = (it >> 3) & 7;
    const int kv = jx * 2 + (jy >> 2), b = kv >> 2, head = (kv & 3) * 4 + (jy & 3), bh = b * 16 + head;
    const int q0 = qt * 128, qw = q0 + wave * 32, query = qw + r;
    bf16x8 qf[4];
    load_qf(Q + ((size_t)bh * S_ + query) * 64, qf);
    const u32x4 selw = sel[(size_t)kv * S_ + query];
    const size_t m = (size_t)b * S_ + query;
    float gs = gates[m * 48 + head * 3 + 1], gw = gates[m * 48 + head * 3 + 2];
    if (rep) { gs = 0.f; gw = 0.f; }
#if ABL == 1
    gs = 0.f;
#elif ABL == 2
    gw = 0.f;
#endif
    f32x16 o[2], ow[2];
    float l;
    const int jlo = (q0 > 511 ? q0 - 511 : 0) >> 6;
    flash_pass<1>(KW + (size_t)kv * S_ * 64, VWT + (size_t)kv * 64 * S_, nullptr, 0.f, selw, qw, jlo, 2 * qt + 1, qf, o, l, sm);
    {
      const float sc = gw / l;
#pragma unroll
      for (int dt = 0; dt < 2; ++dt)
#pragma unroll
        for (int i = 0; i < 16; ++i) ow[dt][i] = o[dt][i] * sc;
    }
    flash_pass<2>(KS + (size_t)kv * S_ * 64, VST + (size_t)kv * 64 * S_, nullptr, 0.f, selw, qw, 0, 2 * qt + 1, qf, o, l, sm);
    const float sc = gs / l;
    bf16_t* dst = obuf + m * D_ + head * 64;
#pragma unroll
    for (int dt = 0; dt < 2; ++dt)
#pragma unroll
      for (int a = 0; a < 4; ++a) {
        bf16_t* p = dst + dt * 32 + 8 * a + 4 * h;
        u32x2 g = *(const u32x2*)p;
        store4bf(p, ow[dt][4 * a] + o[dt][4 * a] * sc + bflo(g.x), ow[dt][4 * a + 1] + o[dt][4 * a + 1] * sc + bfhi(g.x),
                 ow[dt][4 * a + 2] + o[dt][4 * a + 2] * sc + bflo(g.y), ow[dt][4 * a + 3] + o[dt][4 * a + 3] * sc + bfhi(g.y));
      }
  }
}

struct GlaSmem {
  float glow[64 * 16];
  float tot[2 * 128];
  float ssq[2 * 64];
  bf16_t q[64 * 136];
  bf16_t ki[64 * 136];
  bf16_t a[64 * 72];
};

DI void gla_compute_b(const Params& P, GlaSmem& sm, int b, int hg, int t0, float (&bv)[32], float& blast) {
  const int tid = tidx(), d = tid & 127, half = tid >> 7;
  const float* glow = (const float*)(wsp(P) + OFF_GLOW) + ((size_t)b * S_ + t0) * 16;
  __syncthreads();
  for (int e = tid; e < 1024; e += 256) sm.glow[e] = glow[e];
  const int col = hg * 128 + d;
  float w[16];
#pragma unroll
  for (int q = 0; q < 16; ++q) w[q] = inp(P, 22)[q * 512 + col];
  const float bias = inp(P, 23)[col];
  __syncthreads();
  float run = 0.f;
#pragma unroll
  for (int cc = 0; cc < 32; ++cc) {
    const float* gl = sm.glow + (half * 32 + cc) * 16;
    float z = 0.f;
#pragma unroll
    for (int q = 0; q < 16; ++q) z += gl[q] * w[q];
    z += bias;
    run += logsigmoidf_(z) * (1.f / 16.f);
    bv[cc] = run;
    if ((cc & 3) == 3) __builtin_amdgcn_sched_barrier(0);
  }
  sm.tot[half * 128 + d] = run;
  __syncthreads();
  const float t0v = sm.tot[d], t1v = sm.tot[128 + d];
  if (half) {
#pragma unroll
    for (int cc = 0; cc < 32; ++cc) bv[cc] += t0v;
  }
  blast = t0v + t1v;
}

DI void gla_u_phase(const Params& P, char* smem) {
  GlaSmem& sm = *(GlaSmem*)smem;
  char* R = wsp(P) + OFF_R;
  const bf16_t* KG = (const bf16_t*)(R + 32 * MiB);
  const bf16_t* VTG = (const bf16_t*)(R + 64 * MiB);
  bf16_t* UT = (bf16_t*)(R + 128 * MiB);
  float* decay = (float*)(wsp(P) + OFF_DECAY);
  bf16_t* sKT = sm.q;
  const int tid = tidx(), lane = tid & 63, wave = tid >> 6, r = lane & 31, h = lane >> 5;
  const int d = tid & 127, half = tid >> 7;
  for (int it = bidx(); it < 2048; it += gridDim.x) {
    const int n = it & 127, bhg = it >> 7, b = bhg >> 2, hg = bhg & 3, t0 = n * 64;
    float bv[32], blast;
    gla_compute_b(P, sm, b, hg, t0, bv, blast);
#pragma unroll
    for (int cc = 0; cc < 32; ++cc) {
      const int c = half * 32 + cc;
      const float k = bf2f(KG[((size_t)b * S_ + t0 + c) * 512 + hg * 128 + d]);
      sKT[d * 72 + c] = f2bf(k * __expf(blast - bv[cc]));
      if ((cc & 7) == 7) __builtin_amdgcn_sched_barrier(0);
    }
    if (half == 0) decay[(size_t)it * 128 + d] = __expf(blast);
    __syncthreads();
#pragma unroll 1
    for (int m2 = 0; m2 < 2; ++m2) {
      const int e0 = (2 * wave + m2) * 32;
      f32x16 acc[4];
#pragma unroll
      for (int q = 0; q < 4; ++q) zero16(acc[q]);
      const bf16_t* vrow = VTG + ((size_t)b * 1024 + hg * 256 + e0 + r) * S_ + t0;
#pragma unroll
      for (int kk = 0; kk < 4; ++kk) {
        bf16x8 a = *(const bf16x8*)(vrow + kk * 16 + h * 8);
#pragma unroll
        for (int nt = 0; nt < 4; ++nt) {
          bf16x8 bb = *(const bf16x8*)(sKT + (nt * 32 + r) * 72 + kk * 16 + h * 8);
          acc[nt] = MFMA(a, bb, acc[nt]);
        }
        __builtin_amdgcn_sched_barrier(0);
      }
      bf16_t* ub = UT + ((size_t)it * 256 + e0 + 4 * h) * 128 + r;
#pragma unroll
      for (int nt = 0; nt < 4; ++nt) {
#pragma unroll
        for (int i = 0; i < 16; ++i) ub[((i & 3) + 8 * (i >> 2)) * 128 + nt * 32] = f2bf(acc[nt][i]);
        __builtin_amdgcn_sched_barrier(0);
      }
    }
  }
}

DI void gla_scan_phase(const Params& P, int rep) {
  bf16_t* UT = (bf16_t*)(wsp(P) + OFF_R + 128 * MiB);
  const float* decay = (const float*)(wsp(P) + OFF_DECAY);
  for (int gid = bidx() * 256 + tidx(); gid < 16 * 256 * 128; gid += gridDim.x * 256) {
    const int bhg = gid >> 15, e = (gid >> 7) & 255, d = gid & 127;
    float state = 0.f;
    for (int n0 = 0; n0 < 128; n0 += 8) {
      float u[8], dc[8];
#pragma unroll
      for (int q = 0; q < 8; ++q) {
        const size_t it = (size_t)bhg * 128 + n0 + q;
        u[q] = bf2f(UT[(it * 256 + e) * 128 + d]);
        dc[q] = decay[it * 128 + d];
      }
#pragma unroll
      for (int q = 0; q < 8; ++q) {
        const size_t it = (size_t)bhg * 128 + n0 + q;
        UT[(it * 256 + e) * 128 + d] = rep ? f2bf(u[q]) : f2bf(state);
        state = dc[q] * state + u[q];
      }
    }
  }
}

DI void gla_out_phase(const Params& P, char* smem, int rep) {
  GlaSmem& sm = *(GlaSmem*)smem;
  char* R = wsp(P) + OFF_R;
  const bf16_t* QG = (const bf16_t*)R;
  const bf16_t* KG = (const bf16_t*)(R + 32 * MiB);
  const bf16_t* VTG = (const bf16_t*)(R + 64 * MiB);
  const bf16_t* UT = (const bf16_t*)(R + 128 * MiB);
  bf16_t* obuf = (bf16_t*)(wsp(P) + OFF_OBUF);
  const float* gout = inp(P, 24);
  const int tid = tidx(), lane = tid & 63, wave = tid >> 6, r = lane & 31, h = lane >> 5;
  const int d = tid & 127, half = tid >> 7;
  for (int it = bidx(); it < 2048; it += gridDim.x) {
    const int n = it & 127, bhg = it >> 7, b = bhg >> 2, hg = bhg & 3, t0 = n * 64;
    float bv[32], blast;
    gla_compute_b(P, sm, b, hg, t0, bv, blast);
#pragma unroll
    for (int cc = 0; cc < 32; ++cc) {
      const int c = half * 32 + cc;
      const size_t off = ((size_t)b * S_ + t0 + c) * 512 + hg * 128 + d;
      const float q = bf2f(QG[off]), k = bf2f(KG[off]);
      sm.q[c * 136 + d] = f2bf(q * 0.08838834764831845f * __expf(bv[cc]));
      sm.ki[c * 136 + d] = f2bf(k * __expf(-bv[cc]));
      if ((cc & 3) == 3) __builtin_amdgcn_sched_barrier(0);
    }
    __syncthreads();
    {
      const int ct = wave >> 1, stt = wave & 1;
      f32x16 acc;
      zero16(acc);
      if (stt <= ct) {
#pragma unroll
        for (int kk = 0; kk < 8; ++kk) {
          bf16x8 a = *(const bf16x8*)(sm.q + (ct * 32 + r) * 136 + kk * 16 + h * 8);
          bf16x8 bb = *(const bf16x8*)(sm.ki + (stt * 32 + r) * 136 + kk * 16 + h * 8);
          acc = MFMA(a, bb, acc);
        }
      }
#pragma unroll
      for (int i = 0; i < 16; ++i) {
        const int c = ct * 32 + crow(i, h), s = stt * 32 + r;
        sm.a[c * 72 + s] = f2bf(s <= c ? acc[i] : 0.f);
      }
    }
    __syncthreads();
    const int ctok = wave & 1, eh = wave >> 1;
    f32x16 acc[4];
#pragma unroll
    for (int q = 0; q < 4; ++q) zero16(acc[q]);
#pragma unroll
    for (int kk = 0; kk < 4; ++kk) {
      bf16x8 bb = *(const bf16x8*)(sm.a + (ctok * 32 + r) * 72 + kk * 16 + h * 8);
#pragma unroll
      for (int mt = 0; mt < 4; ++mt) {
        bf16x8 a = *(const bf16x8*)(VTG + ((size_t)b * 1024 + hg * 256 + eh * 128 + mt * 32 + r) * S_ + t0 + kk * 16 + h * 8);
        acc[mt] = MFMA(a, bb, acc[mt]);
      }
      if (kk & 1) __builtin_amdgcn_sched_barrier(0);
    }
#pragma unroll
    for (int kk = 0; kk < 8; ++kk) {
      bf16x8 bb = *(const bf16x8*)(sm.q + (ctok * 32 + r) * 136 + kk * 16 + h * 8);
#pragma unroll
      for (int mt = 0; mt < 4; ++mt) {
        bf16x8 a = *(const bf16x8*)(UT + ((size_t)it * 256 + eh * 128 + mt * 32 + r) * 128 + kk * 16 + h * 8);
        acc[mt] = MFMA(a, bb, acc[mt]);
      }
      if (kk & 1) __builtin_amdgcn_sched_barrier(0);
    }
    float ss = 0.f;
#pragma unroll
    for (int mt = 0; mt < 4; ++mt)
#pragma unroll
      for (int i = 0; i < 16; ++i) ss += acc[mt][i] * acc[mt][i];
    ss += __shfl_xor(ss, 32);
    if (h == 0) sm.ssq[eh * 64 + ctok * 32 + r] = ss;
    __syncthreads();
    const float tot = sm.ssq[ctok * 32 + r] + sm.ssq[64 + ctok * 32 + r];
    const float rinv = rsqrtf(tot * (1.f / 256.f) + 1e-6f);
    bf16_t* dst = obuf + ((size_t)b * S_ + t0 + ctok * 32 + r) * D_ + hg * 256 + eh * 128;
#pragma unroll
    for (int mt = 0; mt < 4; ++mt)
#pragma unroll
      for (int a = 0; a < 4; ++a) {
        const int el = mt * 32 + 8 * a + 4 * h;
        const float* gp = gout + eh * 128 + el;
        bf16_t* p = dst + el;
        u32x2 g = *(const u32x2*)p;
        if (rep) *(u32x2*)p = g;
        else
        store4bf(p, acc[mt][4 * a] * rinv * gp[0] * bflo(g.x), acc[mt][4 * a + 1] * rinv * gp[1] * bfhi(g.x),
                 acc[mt][4 * a + 2] * rinv * gp[2] * bflo(g.y), acc[mt][4 * a + 3] * rinv * gp[3] * bfhi(g.y));
      }
  }
}

#define XB_TMO 128
#define XB_XCNT(j) (256 + 64 * (j))
#define XB_XSUB(j) (1280 + 64 * (j))
#define XB_XGEN(j) (2304 + 64 * (j))
#define XB_TOP 3328
#define XB_TOPGEN 3392
#define XCD_BAR_WORDS 3456
#define XB_SPIN_CAP (1u << 21)
#define LAS __attribute__((address_space(3)))
DI unsigned xb_ld(unsigned* p) { return __hip_atomic_load(p, __ATOMIC_RELAXED, __HIP_MEMORY_SCOPE_AGENT); }
DI unsigned xb_add(unsigned* p, unsigned v) { return __hip_atomic_fetch_add(p, v, __ATOMIC_RELAXED, __HIP_MEMORY_SCOPE_AGENT); }
DI unsigned xb_xcc_id() { return (unsigned)__builtin_amdgcn_s_getreg((3 << 11) | 20) & 0xFu; }
#define XB_SPIN(cond, bar)                                           \
  do {                                                               \
    unsigned _sp = 0;                                                \
    while (cond) {                                                   \
      __builtin_amdgcn_s_sleep(1);                                   \
      if ((++_sp & 255u) == 0u) {                                    \
        if (xb_ld(&(bar)[XB_TMO])) break;                            \
        if (_sp > XB_SPIN_CAP) {                                     \
          atomicAdd(&(bar)[XB_TMO], 1u);                             \
          break;                                                     \
        }                                                            \
      }                                                              \
    }                                                                \
  } while (0)
struct XcdBarrier {
  unsigned* bar;
  unsigned x;
  volatile LAS unsigned* st;
};
DI XcdBarrier xcd_barrier_post(unsigned* bar, volatile LAS unsigned* st) {
  XcdBarrier b;
  b.bar = bar;
  b.x = xb_xcc_id();
  b.st = st;
  if (threadIdx.x == 0) (void)xb_add(&bar[XB_XCNT(b.x)], 1u);
  return b;
}
DI void xcd_barrier_complete(unsigned* bar, unsigned x, unsigned& nloc, unsigned& nx) {
  const unsigned G = gridDim.x * gridDim.y * gridDim.z;
  unsigned sum, cnt, mine, sp = 0u;
  for (;;) {
    sum = 0u;
    cnt = 0u;
    mine = 0u;
#pragma unroll
    for (unsigned j = 0; j < 16; ++j) {
      const unsigned c = xb_ld(&bar[XB_XCNT(j)]);
      sum += c;
      cnt += (c > 0u) ? 1u : 0u;
      mine = (j == x) ? c : mine;
    }
    if (sum == G) break;
    __builtin_amdgcn_s_sleep(1);
    if ((++sp & 255u) == 0u) {
      if (xb_ld(&bar[XB_TMO])) break;
      if (sp > XB_SPIN_CAP) {
        atomicAdd(&bar[XB_TMO], 1u);
        break;
      }
    }
  }
  nloc = mine > 0u ? mine : 1u;
  nx = cnt > 0u ? cnt : 1u;
}
DI void xcd_barrier(const XcdBarrier& b) {
  asm volatile("s_waitcnt vmcnt(0)" ::: "memory");
  __syncthreads();
  if (threadIdx.x == 0) {
    unsigned* bar = b.bar;
    __builtin_amdgcn_s_waitcnt(0);
    unsigned nloc = b.st[0], nx = b.st[1];
    if (nloc == 0u) {
      xcd_barrier_complete(bar, b.x, nloc, nx);
      b.st[0] = nloc;
      b.st[1] = nx;
    }
    const unsigned old = xb_add(&bar[XB_XSUB(b.x)], 1u);
    const unsigned gen = old / nloc;
    if (old + 1u == (gen + 1u) * nloc) {
      __builtin_amdgcn_fence(__ATOMIC_RELEASE, "agent");
      asm volatile("s_waitcnt vmcnt(0)" ::: "memory");
      const unsigned og = xb_add(&bar[XB_TOP], 1u);
      const unsigned tg = og / nx;
      if (og + 1u == (tg + 1u) * nx) xb_add(&bar[XB_TOPGEN], 1u);
      else XB_SPIN(xb_ld(&bar[XB_TOPGEN]) == tg, bar);
      __builtin_amdgcn_fence(__ATOMIC_ACQUIRE, "agent");
      xb_add(&bar[XB_XGEN(b.x)], 1u);
      asm volatile("s_waitcnt vmcnt(0)" ::: "memory");
    } else {
      XB_SPIN(xb_ld(&bar[XB_XGEN(b.x)]) == gen, bar);
      __builtin_amdgcn_fence(__ATOMIC_ACQUIRE, "agent");
      asm volatile("s_waitcnt vmcnt(0)" ::: "memory");
    }
  }
  __syncthreads();
}

DI void run_phase(const Params& P, int ph, char* smem, int rep) {
  char* ws = wsp(P);
  float* ssq = (float*)(ws + OFF_SSQ);
  bf16_t* xb = (bf16_t*)(ws + OFF_XB);
  bf16_t* obuf = (bf16_t*)(ws + OFF_OBUF);
  bf16_t* act = (bf16_t*)(ws + OFF_R);
  if (ph == 0) {
    init_phase(P);
    prep_layer(P, 0, smem);
    return;
  }
  int L, lp;
  if (ph <= 8) { L = 0; lp = ph - 1; }
  else if (ph <= 18) { L = 1; lp = ph - 10; }
  else if (ph <= 28) { L = 2; lp = ph - 20; }
  else { L = 3; lp = ph - 30; }
  if (lp < 0) {
    prep_layer(P, L, smem);
    return;
  }
  const int nmix = (L == 0) ? 2 : (L == 1 ? 3 : (L == 2 ? 3 : 1));
  const float* s0 = ssq + (size_t)(3 * L) * M_ * 16;
  const float* s1 = s0 + (size_t)M_ * 16;
  const float* s2 = s1 + (size_t)M_ * 16;
  if (lp == 0 || lp == 4 + nmix) {
    const bool f2 = lp != 0;
    EpiFfn1 e;
    e.ssq = f2 ? s2 : s0;
    e.act = act;
    gemm_phase<2>((const bf16_t*)(ws + (f2 ? OFF_W2 : OFF_W1)), 2 * F_, xb, D_, D_, smem, e);
  } else if (lp == 1 || lp == 5 + nmix) {
    const bool f2 = lp != 1;
    EpiResid e;
    e.xin = (L == 0 && !f2 && !rep) ? inp(P, 0) : outp(P);
    e.xout = outp(P);
    e.xb = xb;
    e.ssqn = ssq + (size_t)(3 * L + (f2 ? 3 : 1)) * M_ * 16;
    e.scale = rep ? 0.f : 0.5f;
    gemm_phase<2>((const bf16_t*)(ws + (f2 ? OFF_W2D : OFF_W1D)), D_, act, F_, F_, smem, e);
  } else if (lp == 3 + nmix) {
    EpiResid e;
    e.xin = outp(P);
    e.xout = outp(P);
    e.xb = xb;
    e.ssqn = ssq + (size_t)(3 * L + 2) * M_ * 16;
    e.scale = rep ? 0.f : 1.f;
    gemm_phase<2>((const bf16_t*)(ws + OFF_WMO), D_, obuf, D_, D_, smem, e);
  } else if (lp == 2) {
    const bf16_t* wmi = (const bf16_t*)(ws + OFF_WMI);
    char* R = ws + OFF_R;
    if (L == 0 || L == 3) {
      EpiQKV e;
      e.ssq = s1;
      e.gq = inp(P, 10);
      e.gk = inp(P, 11);
      e.bfv = inp(P, 9);
      e.Q = (bf16_t*)R;
      e.K = (bf16_t*)(R + 64 * MiB);
      e.VT = (bf16_t*)(R + 128 * MiB);
      e.obuf = obuf;
      e.flog = (float*)(ws + OFF_FLOG);
      e.fox = (L == 0);
      gemm_phase<2>(wmi, L == 0 ? 4224 : 3072, xb, D_, D_, smem, e);
    } else if (L == 1) {
      EpiNSA e;
      e.ssq = s1;
      e.gq = inp(P, 18);
      e.gk = inp(P, 19);
      e.Q = (bf16_t*)R;
      e.KC = (bf16_t*)(R + 64 * MiB);
      e.KS = (bf16_t*)(R + 80 * MiB);
      e.KW = (bf16_t*)(R + 96 * MiB);
      e.VC = (bf16_t*)(R + 112 * MiB);
      e.VST = (bf16_t*)(R + 128 * MiB);
      e.VWT = (bf16_t*)(R + 144 * MiB);
      e.gates = (float*)(ws + OFF_GATES);
      gemm_phase<1>(wmi, 2688, xb, D_, D_, smem, e);
    } else {
      EpiGLA e;
      e.ssq = s1;
      e.QG = (bf16_t*)R;
      e.KG = (bf16_t*)(R + 32 * MiB);
      e.VTG = (bf16_t*)(R + 64 * MiB);
      e.obuf = obuf;
      e.glow = (float*)(ws + OFF_GLOW);
      gemm_phase<2>(wmi, 3200, xb, D_, D_, smem, e);
    }
  } else {
    const int mp = lp - 3;
    if (L == 0) {
      if (mp == 0) {
        fox_scan_phase(P, smem);
      }
      else {
        fox_attn_phase(P, smem, rep);
      }
    } else if (L == 1) {
      if (mp == 0) nsa_compress_phase(P, smem);
      else if (mp == 1) nsa_cmp_phase(P, smem);
      else {
        nsa_attn_phase(P, smem, rep);
      }
    } else if (L == 2) {
      if (mp == 0) gla_u_phase(P, smem);
      else if (mp == 1) gla_scan_phase(P, rep);
      else gla_out_phase(P, smem, rep);
    } else {
      sb_attn_phase(P, smem);
    }
  }
}

__global__ void __launch_bounds__(256, 2) mega_kernel(Params P, int ph_lo, int ph_hi) {
  __shared__ __attribute__((aligned(16))) char smem[57344];
  __shared__ __attribute__((aligned(16))) unsigned xbw[4];
  if (threadIdx.x == 0) { xbw[0] = 0u; xbw[1] = 0u; xbw[2] = 0u; xbw[3] = 0u; }
  __syncthreads();
  XcdBarrier xb = xcd_barrier_post((unsigned*)(P.ws + OFF_XBAR), (volatile LAS unsigned*)xbw);
  for (int ph = ph_lo; ph < ph_hi; ++ph) {
    run_phase(P, ph, smem, 0);
    if (ph + 1 < ph_hi) {
      if (ph == ph_lo) {
        asm volatile("s_waitcnt vmcnt(0)" ::: "memory");
        cg::this_grid().sync();
        __builtin_amdgcn_fence(__ATOMIC_ACQUIRE, "agent");
        asm volatile("s_waitcnt vmcnt(0)" ::: "memory");
        __syncthreads();
      } else {
        xcd_barrier(xb);
      }
    }
  }
}

extern "C" void kernel_launch(void* const* d_in, const int* in_sizes, int n_in, void* d_out, int out_size, void* d_ws,
                              size_t ws_size, hipStream_t stream) {
  static int grid_blocks = 0;
  if (!grid_blocks) {
    int dev = 0, cus = 0, per_cu = 0;
    hipGetDevice(&dev);
    hipDeviceGetAttribute(&cus, hipDeviceAttributeMultiprocessorCount, dev);
    hipOccupancyMaxActiveBlocksPerMultiprocessor(&per_cu, mega_kernel, 256, 0);
    if (per_cu > 2) per_cu = 2;
    if (per_cu < 1) per_cu = 1;
    grid_blocks = cus * per_cu;
  }
  Params p{};
  for (int i = 0; i < 28; ++i) p.in[i] = (const float*)d_in[i];
  p.out = (float*)d_out;
  p.ws = (char*)d_ws;
  hipMemsetAsync((char*)d_ws + OFF_XBAR, 0, XCD_BAR_WORDS * sizeof(unsigned), stream);
#if ONE_LAUNCH
  int lo = 0, hi = NPH_RUN;
  void* args[] = {&p, &lo, &hi};
  hipError_t e = hipLaunchCooperativeKernel((void*)mega_kernel, dim3(grid_blocks), dim3(256), args, 0, stream);
  if (e != hipSuccess) fprintf(stderr, "cooperative launch failed: %s (grid %d)\n", hipGetErrorString(e), grid_blocks);
#else
  for (int ph = 0; ph < NPH_RUN; ++ph) mega_kernel<<<grid_blocks, 256, 0, stream>>>(p, ph, ph + 1);
#endif
}
```

```cpp
#include <hip/hip_runtime.h>
#include <hip/hip_cooperative_groups.h>
#include <cstdio>
namespace cg = cooperative_groups;

#ifndef ONE_LAUNCH
#define ONE_LAUNCH 1
#endif

#define ABL 0
#ifndef NPH_RUN
#define NPH_RUN 37
#endif
#define DI __device__ __forceinline__
typedef unsigned short bf16_t;
typedef __attribute__((ext_vector_type(8))) short bf16x8;
typedef __attribute__((ext_vector_type(4))) short bf16x4;
typedef __attribute__((ext_vector_type(16))) float f32x16;
typedef __attribute__((ext_vector_type(2))) __bf16 bf2_t;
typedef __attribute__((ext_vector_type(4))) unsigned u32x4;
typedef __attribute__((ext_vector_type(2))) unsigned u32x2;
typedef __attribute__((ext_vector_type(4))) float f32x4;
DI int tidx() { int t = threadIdx.x; asm volatile("" : "+v"(t)); return t; }
DI int bidx() { int t = blockIdx.x; asm volatile("" : "+s"(t)); return t; }

#define MFMA(a, b, c) __builtin_amdgcn_mfma_f32_32x32x16_bf16((a), (b), (c), 0, 0, 0)

constexpr int S_ = 8192;
constexpr int M_ = 32768;
constexpr int D_ = 1024;
constexpr int F_ = 2816;
constexpr int NPH = 37;
constexpr size_t MiB = 1048576;
constexpr size_t OFF_W1 = 0, OFF_W1D = 11 * MiB, OFF_W2 = 17 * MiB, OFF_W2D = 28 * MiB, OFF_WMI = 34 * MiB,
                 OFF_WMO = 43 * MiB, OFF_WCK = 45 * MiB, OFF_WCV = 46 * MiB;
constexpr size_t OFF_XB = 48 * MiB, OFF_OBUF = 112 * MiB, OFF_SSQ = 460 * MiB, OFF_FLOG = 178 * MiB, OFF_C = 180 * MiB,
                 OFF_GATES = 182 * MiB, OFF_SEL = 188 * MiB, OFF_GLOW = 190 * MiB, OFF_DECAY = 192 * MiB,
                 OFF_KCMP = 193 * MiB, OFF_VCMPT = 194 * MiB, OFF_CBIAS = 195 * MiB, OFF_XBAR = 196 * MiB, OFF_R = 200 * MiB;

struct Params {
  const float* in[28];
  float* out;
  char* ws;
};

#define GAS __attribute__((address_space(1)))
DI const float* inp(const Params& P, int k) {
  asm volatile("" : "+s"(k));
  GAS const float* p = (GAS const float*)P.in[k];
  asm volatile("" : "+s"(p));
  return (const float*)p;
}
DI char* wsp(const Params& P) {
  GAS char* w = (GAS char*)P.ws;
  asm volatile("" : "+s"(w));
  return (char*)w;
}
DI float* outp(const Params& P) {
  GAS float* w = (GAS float*)P.out;
  asm volatile("" : "+s"(w));
  return (float*)w;
}
DI unsigned pack2(float a, float b) {
  bf2_t v;
  v[0] = (__bf16)a;
  v[1] = (__bf16)b;
  return __builtin_bit_cast(unsigned, v);
}
DI bf16_t f2bf(float a) { return (bf16_t)(pack2(a, 0.f) & 0xffffu); }
DI float bf2f(bf16_t v) { return __uint_as_float(((unsigned)v) << 16); }
DI float bflo(unsigned u) { return __uint_as_float(u << 16); }
DI float bfhi(unsigned u) { return __uint_as_float(u & 0xffff0000u); }
DI int crow(int i, int h) { return (i & 3) + 8 * (i >> 2) + 4 * h; }
DI float sigmoidf_(float x) { return __builtin_amdgcn_rcpf(1.f + __expf(-x)); }
DI float logsigmoidf_(float z) { return fminf(z, 0.f) - log1pf(__expf(-fabsf(z))); }
DI float row_rstd(const float* ssq, int m) {
  const f32x4* p = (const f32x4*)(ssq + (size_t)m * 16);
  f32x4 a = p[0], b = p[1], c = p[2], d = p[3];
  float s = a.x;
  s += a.y; s += a.z; s += a.w;
  s += b.x; s += b.y; s += b.z; s += b.w;
  s += c.x; s += c.y; s += c.z; s += c.w;
  s += d.x; s += d.y; s += d.z; s += d.w;
  return rsqrtf(s * (1.f / 1024.f) + 1e-6f);
}
DI void store4bf(bf16_t* p, float a, float b, float c, float d) {
  u32x2 u;
  u.x = pack2(a, b);
  u.y = pack2(c, d);
  *(u32x2*)p = u;
}
DI bf16x8 pack8(float a0, float a1, float a2, float a3, float a4, float a5, float a6, float a7) {
  u32x4 u;
  u.x = pack2(a0, a1);
  u.y = pack2(a2, a3);
  u.z = pack2(a4, a5);
  u.w = pack2(a6, a7);
  return __builtin_bit_cast(bf16x8, u);
}
DI bf16x8 cat4(bf16x4 lo, bf16x4 hi) { return __builtin_shufflevector(lo, hi, 0, 1, 2, 3, 4, 5, 6, 7); }
DI void zero16(f32x16& v) {
#pragma unroll
  for (int i = 0; i < 16; ++i) v[i] = 0.f;
}

template <int MH>
DI void gemm_tile(const bf16_t* Wg, int ldw, const bf16_t* Xg, int ldx, int K, bf16_t* sW, bf16_t* sX,
                  f32x16 (&acc)[MH][2][2]) {
  const int tid = tidx(), lane = tid & 63, wave = tid >> 6, wn = wave >> 1, wm = wave & 1, r = lane & 31,
            h = lane >> 5;
#pragma unroll
  for (int a = 0; a < MH; ++a)
#pragma unroll
    for (int b = 0; b < 2; ++b)
#pragma unroll
      for (int c = 0; c < 2; ++c) zero16(acc[a][b][c]);
  u32x4 rw[4], rx[4 * MH];
  const int nk = K >> 6;
  const int row0 = tid >> 3, cc = tid & 7;
  const bf16_t* wp = Wg + (size_t)row0 * ldw + cc * 8;
  const bf16_t* xp = Xg + (size_t)row0 * ldx + cc * 8;
#pragma unroll
  for (int i = 0; i < 4; ++i) rw[i] = *(const u32x4*)(wp + (size_t)(32 * i) * ldw);
#pragma unroll
  for (int i = 0; i < 4 * MH; ++i) rx[i] = *(const u32x4*)(xp + (size_t)(32 * i) * ldx);
  for (int kt = 0; kt < nk; ++kt) {
    __syncthreads();
#pragma unroll
    for (int i = 0; i < 4; ++i) *(u32x4*)(sW + (row0 + 32 * i) * 72 + cc * 8) = rw[i];
#pragma unroll
    for (int i = 0; i < 4 * MH; ++i) *(u32x4*)(sX + (row0 + 32 * i) * 72 + cc * 8) = rx[i];
    __syncthreads();
    if (kt + 1 < nk) {
      const int k0 = (kt + 1) * 64;
#pragma unroll
      for (int i = 0; i < 4; ++i) rw[i] = *(const u32x4*)(wp + (size_t)(32 * i) * ldw + k0);
#pragma unroll
      for (int i = 0; i < 4 * MH; ++i) rx[i] = *(const u32x4*)(xp + (size_t)(32 * i) * ldx + k0);
    }
    __builtin_amdgcn_sched_barrier(0);
#pragma unroll
    for (int kk = 0; kk < 4; ++kk) {
      bf16x8 a0 = *(const bf16x8*)(sW + (wn * 64 + r) * 72 + kk * 16 + h * 8);
      bf16x8 a1 = *(const bf16x8*)(sW + (wn * 64 + 32 + r) * 72 + kk * 16 + h * 8);
#pragma unroll
      for (int mq = 0; mq < 2 * MH; ++mq) {
        bf16x8 b = *(const bf16x8*)(sX + (wm * 64 * MH + mq * 32 + r) * 72 + kk * 16 + h * 8);
        acc[mq >> 1][0][mq & 1] = MFMA(a0, b, acc[mq >> 1][0][mq & 1]);
        acc[mq >> 1][1][mq & 1] = MFMA(a1, b, acc[mq >> 1][1][mq & 1]);
      }
    }
  }
}

template <int MH, class Epi>
DI void gemm_phase(const bf16_t* Wt, int Npad, const bf16_t* X, int ldx, int K, char* smem, const Epi& epi) {
  bf16_t* sW = (bf16_t*)smem;
  bf16_t* sX = sW + 128 * 72;
  const int NT = Npad >> 7, MT = M_ / (128 * MH);
  const int wave = tidx() >> 6, wn = wave >> 1, wm = wave & 1;
  const int nblk = gridDim.x;
  const int lb = ((nblk & 7) == 0) ? ((bidx() & 7) * (nblk >> 3) + (bidx() >> 3)) : bidx();
  const bool part2d = ((nblk & 7) == 0) && (NT >= 16) && ((MT & 1) == 0);
  const int xg = bidx() & 7, nper = NT >> 2, mper = MT >> 1;
  const int lenA = nper * mper, nleft = (NT - 4 * nper) * MT;
  const int lenB = (nleft > xg) ? ((nleft - xg + 7) >> 3) : 0;
  const int q0 = part2d ? (bidx() >> 3) : lb, qstep = part2d ? (nblk >> 3) : nblk, qend = part2d ? lenA + lenB : NT * MT;
  for (int t = q0; t < qend; t += qstep) {
    int nt, mt;
    if (part2d) {
      if (t < lenA) {
        nt = (xg >> 1) * nper + t % nper;
        mt = (xg & 1) * mper + t / nper;
      } else {
        const int u = (t - lenA) * 8 + xg;
        nt = 4 * nper + u / MT;
        mt = u % MT;
      }
    } else {
      nt = t % NT;
      mt = t / NT;
    }
    f32x16 acc[MH][2][2];
    gemm_tile<MH>(Wt + (size_t)nt * 128 * K, K, X + (size_t)mt * 128 * MH * ldx, ldx, K, sW, sX, acc);
#pragma unroll
    for (int mh = 0; mh < MH; ++mh) epi(acc[mh], nt * 128 + wn * 64, mt * 128 * MH + wm * 64 * MH + mh * 64);
  }
}

struct EpiFfn1 {
  const float* ssq;
  bf16_t* act;
  DI void operator()(f32x16 (&acc)[2][2], int nb, int mb) const {
    const int lane = tidx() & 63, r = lane & 31, h = lane >> 5;
    const int jb = (nb >> 6) * 32;
#pragma unroll
    for (int mi = 0; mi < 2; ++mi) {
      const int m = mb + mi * 32 + r;
      const float rstd = row_rstd(ssq, m);
#pragma unroll
      for (int a = 0; a < 4; ++a) {
        float v[4];
#pragma unroll
        for (int q = 0; q < 4; ++q) {
          float g = acc[0][mi][4 * a + q] * rstd, u = acc[1][mi][4 * a + q] * rstd;
          v[q] = g * sigmoidf_(g) * u;
        }
        store4bf(act + (size_t)m * F_ + jb + 8 * a + 4 * h, v[0], v[1], v[2], v[3]);
      }
    }
  }
};

struct EpiResid {
  const float* xin;
  float* xout;
  bf16_t* xb;
  float* ssqn;
  float scale;
  DI void operator()(f32x16 (&acc)[2][2], int nb, int mb) const {
    const int lane = tidx() & 63, r = lane & 31, h = lane >> 5;
#pragma unroll
    for (int mi = 0; mi < 2; ++mi) {
      const int m = mb + mi * 32 + r;
      float part = 0.f;
#pragma unroll
      for (int ni = 0; ni < 2; ++ni)
#pragma unroll
        for (int a = 0; a < 4; ++a) {
          const int n = nb + ni * 32 + 8 * a + 4 * h;
          f32x4 xi = *(const f32x4*)(xin + (size_t)m * D_ + n);
          f32x4 xo;
          xo.x = xi.x + scale * acc[ni][mi][4 * a + 0];
          xo.y = xi.y + scale * acc[ni][mi][4 * a + 1];
          xo.z = xi.z + scale * acc[ni][mi][4 * a + 2];
          xo.w = xi.w + scale * acc[ni][mi][4 * a + 3];
          *(f32x4*)(xout + (size_t)m * D_ + n) = xo;
          store4bf(xb + (size_t)m * D_ + n, xo.x, xo.y, xo.z, xo.w);
          part += xo.x * xo.x + xo.y * xo.y + xo.z * xo.z + xo.w * xo.w;
        }
      part += __shfl_xor(part, 32);
      if (h == 0) ssqn[(size_t)m * 16 + (nb >> 6)] = part;
    }
  }
};

struct EpiQKV {
  const float* ssq;
  const float* gq;
  const float* gk;
  const float* bfv;
  bf16_t* Q;
  bf16_t* K;
  bf16_t* VT;
  bf16_t* obuf;
  float* flog;
  int fox;
  DI void operator()(f32x16 (&acc)[2][2], int nb, int mb) const {
    const int lane = tidx() & 63, r = lane & 31, h = lane >> 5;
#pragma unroll
    for (int mi = 0; mi < 2; ++mi) {
      const int m = mb + mi * 32 + r, b = m >> 13, t = m & 8191;
      const float rstd = row_rstd(ssq, m);
      if (nb < 2048) {
        const int isk = nb >= 1024, hh = (nb & 1023) >> 6;
        float v[2][16];
        float ss = 0.f;
#pragma unroll
        for (int ni = 0; ni < 2; ++ni)
#pragma unroll
          for (int i = 0; i < 16; ++i) {
            v[ni][i] = acc[ni][mi][i] * rstd;
            ss += v[ni][i] * v[ni][i];
          }
        if (fox) {
          ss += __shfl_xor(ss, 32);
          const float rinv = rsqrtf(ss * (1.f / 64.f) + 1e-6f);
          const float* g = isk ? gk : gq;
#pragma unroll
          for (int ni = 0; ni < 2; ++ni)
#pragma unroll
            for (int i = 0; i < 16; ++i) v[ni][i] *= rinv * g[ni * 32 + crow(i, h)];
        }
        bf16_t* dst = (isk ? K : Q) + ((size_t)(b * 16 + hh) * S_ + t) * 64;
#pragma unroll
        for (int ni = 0; ni < 2; ++ni)
#pragma unroll
          for (int a = 0; a < 4; ++a)
            store4bf(dst + ni * 32 + 8 * a + 4 * h, v[ni][4 * a], v[ni][4 * a + 1], v[ni][4 * a + 2], v[ni][4 * a + 3]);
      } else if (nb < 3072) {
        const int hh = (nb - 2048) >> 6;
#pragma unroll
        for (int ni = 0; ni < 2; ++ni)
#pragma unroll
          for (int i = 0; i < 16; ++i) {
            const int d = ni * 32 + crow(i, h);
            VT[((size_t)(b * 16 + hh) * 64 + d) * S_ + t] = f2bf(acc[ni][mi][i] * rstd);
          }
      } else if (fox && nb < 4096) {
        const int hh = (nb - 3072) >> 6;
#pragma unroll
        for (int ni = 0; ni < 2; ++ni)
#pragma unroll
          for (int a = 0; a < 4; ++a)
            store4bf(obuf + (size_t)m * D_ + hh * 64 + ni * 32 + 8 * a + 4 * h, sigmoidf_(acc[ni][mi][4 * a] * rstd),
                     sigmoidf_(acc[ni][mi][4 * a + 1] * rstd), sigmoidf_(acc[ni][mi][4 * a + 2] * rstd),
                     sigmoidf_(acc[ni][mi][4 * a + 3] * rstd));
      } else if (fox && nb == 4096) {
#pragma unroll
        for (int i = 0; i < 8; ++i) {
          const int hh = crow(i, h);
          flog[(size_t)(b * 16 + hh) * S_ + t] = logsigmoidf_(acc[0][mi][i] * rstd + bfv[hh]);
        }
      }
    }
  }
};

struct EpiNSA {
  const float* ssq;
  const float* gq;
  const float* gk;
  bf16_t* Q;
  bf16_t* KC;
  bf16_t* KS;
  bf16_t* KW;
  bf16_t* VC;
  bf16_t* VST;
  bf16_t* VWT;
  float* gates;
  DI void operator()(f32x16 (&acc)[2][2], int nb, int mb) const {
    const int lane = tidx() & 63, r = lane & 31, h = lane >> 5;
    if (nb > 2560) return;
#pragma unroll
    for (int mi = 0; mi < 2; ++mi) {
      const int m = mb + mi * 32 + r, b = m >> 13, t = m & 8191;
      const float rstd = row_rstd(ssq, m);
      if (nb == 2560) {
#pragma unroll
        for (int ni = 0; ni < 2; ++ni)
#pragma unroll
          for (int i = 0; i < 16; ++i) {
            const int nl = ni * 32 + crow(i, h);
            if (nl < 48) gates[(size_t)m * 48 + nl] = sigmoidf_(acc[ni][mi][i] * rstd);
          }
        continue;
      }
      int seg = -1, hh;
      if (nb < 1024) {
        hh = nb >> 6;
      } else {
        seg = (nb - 1024) >> 8;
        hh = ((nb - 1024) & 255) >> 6;
      }
      const int kv = b * 4 + hh;
      if (seg == 1) {
        bf16_t* dst = VC + ((size_t)kv * S_ + t) * 64;
#pragma unroll
        for (int ni = 0; ni < 2; ++ni)
#pragma unroll
          for (int a = 0; a < 4; ++a)
            store4bf(dst + ni * 32 + 8 * a + 4 * h, acc[ni][mi][4 * a] * rstd, acc[ni][mi][4 * a + 1] * rstd,
                     acc[ni][mi][4 * a + 2] * rstd, acc[ni][mi][4 * a + 3] * rstd);
      } else if (seg == 3 || seg == 5) {
        bf16_t* dst = (seg == 3 ? VST : VWT);
#pragma unroll
        for (int ni = 0; ni < 2; ++ni)
#pragma unroll
          for (int i = 0; i < 16; ++i) {
            const int d = ni * 32 + crow(i, h);
            dst[((size_t)kv * 64 + d) * S_ + t] = f2bf(acc[ni][mi][i] * rstd);
          }
      } else {
        float v[2][16];
        float ss = 0.f;
#pragma unroll
        for (int ni = 0; ni < 2; ++ni)
#pragma unroll
          for (int i = 0; i < 16; ++i) {
            v[ni][i] = acc[ni][mi][i] * rstd;
            ss += v[ni][i] * v[ni][i];
          }
        ss += __shfl_xor(ss, 32);
        const float rinv = rsqrtf(ss * (1.f / 64.f) + 1e-6f);
        const float* g = (seg < 0) ? gq : gk;
        const float tf = (float)t;
#pragma unroll
        for (int i = 0; i < 16; ++i) {
          const int fi = crow(i, h);
          const float x1 = v[0][i] * rinv * g[fi], x2 = v[1][i] * rinv * g[32 + fi];
          const float inv = exp2f(-(float)fi * 0.41524101186092034f);
          const float ang = tf * inv;
          const float Chi = 0.15915494f, Clo = 6.4206383e-9f;
          const float p = ang * Chi;
          const float e = __builtin_fmaf(ang, Chi, -p);
          const float fr = (p - floorf(p)) + (e + ang * Clo);
          const float sn = __builtin_amdgcn_sinf(fr), cs = __builtin_amdgcn_cosf(fr);
          v[0][i] = x1 * cs - x2 * sn;
          v[1][i] = x2 * cs + x1 * sn;
          if ((i & 1) == 1) __builtin_amdgcn_sched_barrier(0);
        }
        bf16_t* dst;
        if (seg < 0)
          dst = Q + ((size_t)(b * 16 + hh) * S_ + t) * 64;
        else
          dst = (seg == 0 ? KC : (seg == 2 ? KS : KW)) + ((size_t)kv * S_ + t) * 64;
#pragma unroll
        for (int ni = 0; ni < 2; ++ni)
#pragma unroll
          for (int a = 0; a < 4; ++a)
            store4bf(dst + ni * 32 + 8 * a + 4 * h, v[ni][4 * a], v[ni][4 * a + 1], v[ni][4 * a + 2], v[ni][4 * a + 3]);
      }
    }
  }
};

struct EpiGLA {
  const float* ssq;
  bf16_t* QG;
  bf16_t* KG;
  bf16_t* VTG;
  bf16_t* obuf;
  float* glow;
  DI void operator()(f32x16 (&acc)[2][2], int nb, int mb) const {
    const int lane = tidx() & 63, r = lane & 31, h = lane >> 5;
    if (nb > 3072) return;
#pragma unroll
    for (int mi = 0; mi < 2; ++mi) {
      const int m = mb + mi * 32 + r, b = m >> 13, t = m & 8191;
      const float rstd = row_rstd(ssq, m);
      if (nb < 1024) {
        bf16_t* dst = (nb < 512 ? QG + (size_t)m * 512 + nb : KG + (size_t)m * 512 + (nb - 512));
#pragma unroll
        for (int ni = 0; ni < 2; ++ni)
#pragma unroll
          for (int a = 0; a < 4; ++a)
            store4bf(dst + ni * 32 + 8 * a + 4 * h, acc[ni][mi][4 * a] * rstd, acc[ni][mi][4 * a + 1] * rstd,
                     acc[ni][mi][4 * a + 2] * rstd, acc[ni][mi][4 * a + 3] * rstd);
      } else if (nb < 2048) {
#pragma unroll
        for (int ni = 0; ni < 2; ++ni)
#pragma unroll
          for (int i = 0; i < 16; ++i) {
            const int e = nb - 1024 + ni * 32 + crow(i, h);
            VTG[((size_t)b * 1024 + e) * S_ + t] = f2bf(acc[ni][mi][i] * rstd);
          }
      } else if (nb < 3072) {
#pragma unroll
        for (int ni = 0; ni < 2; ++ni)
#pragma unroll
          for (int a = 0; a < 4; ++a) {
            float v[4];
#pragma unroll
            for (int q = 0; q < 4; ++q) {
              float z = acc[ni][mi][4 * a + q] * rstd;
              v[q] = z * sigmoidf_(z);
            }
            store4bf(obuf + (size_t)m * D_ + (nb - 2048) + ni * 32 + 8 * a + 4 * h, v[0], v[1], v[2], v[3]);
          }
      } else {
#pragma unroll
        for (int i = 0; i < 8; ++i) glow[(size_t)m * 16 + crow(i, h)] = acc[0][mi][i] * rstd;
      }
    }
  }
};

struct EpiCmp {
  const float* cb;
  const float* gk;
  bf16_t* dst;
  int isv;
  DI void operator()(f32x16 (&acc)[2][2], int nb, int mb) const {
    const int lane = tidx() & 63, r = lane & 31, h = lane >> 5;
    if (nb != 0) return;
#pragma unroll
    for (int mi = 0; mi < 2; ++mi) {
      const int n = mb + mi * 32 + r;
      const bool ok = n < 511;
      float v[2][16];
      float ss = 0.f;
#pragma unroll
      for (int ni = 0; ni < 2; ++ni)
#pragma unroll
        for (int i = 0; i < 16; ++i) {
          v[ni][i] = ok ? acc[ni][mi][i] + cb[ni * 32 + crow(i, h)] : 0.f;
          ss += v[ni][i] * v[ni][i];
        }
      if (!isv) {
        ss += __shfl_xor(ss, 32);
        const float rinv = rsqrtf(ss * (1.f / 64.f) + 1e-6f);
#pragma unroll
        for (int ni = 0; ni < 2; ++ni)
#pragma unroll
          for (int a = 0; a < 4; ++a) {
            const int e = ni * 32 + 8 * a + 4 * h;
            store4bf(dst + (size_t)n * 64 + e, v[ni][4 * a] * rinv * gk[e], v[ni][4 * a + 1] * rinv * gk[e + 1],
                     v[ni][4 * a + 2] * rinv * gk[e + 2], v[ni][4 * a + 3] * rinv * gk[e + 3]);
          }
      } else {
#pragma unroll
        for (int ni = 0; ni < 2; ++ni)
#pragma unroll
          for (int i = 0; i < 16; ++i) dst[(size_t)(ni * 32 + crow(i, h)) * 512 + n] = f2bf(v[ni][i]);
      }
    }
  }
};

template <class Src>
DI void prep_job(bf16_t* dst, int Npad, int K, float* sT, Src src) {
  const int tid = tidx();
  const int NT = Npad >> 6, KT = K >> 6;
  for (int t = bidx(); t < NT * KT; t += gridDim.x) {
    const int nt = t % NT, kt = t / NT;
    __syncthreads();
#pragma unroll 4
    for (int i = 0; i < 16; ++i) {
      const int e = tid + 256 * i, kk = e >> 6, nn = e & 63;
      sT[kk * 65 + nn] = src(kt * 64 + kk, nt * 64 + nn);
    }
    __syncthreads();
#pragma unroll 4
    for (int i = 0; i < 8; ++i) {
      const int e = tid + 256 * i, nn = e >> 5, kp = e & 31;
      *(unsigned*)(dst + (size_t)(nt * 64 + nn) * K + kt * 64 + 2 * kp) = pack2(sT[(2 * kp) * 65 + nn], sT[(2 * kp + 1) * 65 + nn]);
    }
  }
}

DI void prep_layer(const Params& P, int L, char* smem) {
  float* sT = (float*)smem;
  char* ws = wsp(P);
  const float* ng = inp(P, 1) + (size_t)L * 3 * D_;
  for (int f = 0; f < 2; ++f) {
    const float* wg = inp(P, f ? 5 : 2) + (size_t)L * D_ * F_;
    const float* wu = inp(P, f ? 6 : 3) + (size_t)L * D_ * F_;
    const float* wd = inp(P, f ? 7 : 4) + (size_t)L * D_ * F_;
    const float* g = ng + (f ? 2 * D_ : 0);
    prep_job((bf16_t*)(ws + (f ? OFF_W2 : OFF_W1)), 2 * F_, D_, sT, [=](int k, int n) {
      const int grp = n >> 6, rr = n & 63;
      const float* s = rr < 32 ? wg : wu;
      return s[(size_t)k * F_ + grp * 32 + (rr & 31)] * g[k];
    });
    prep_job((bf16_t*)(ws + (f ? OFF_W2D : OFF_W1D)), D_, F_, sT, [=](int k, int n) { return wd[(size_t)k * D_ + n]; });
  }
  const float* g1 = ng + D_;
  bf16_t* wmi = (bf16_t*)(ws + OFF_WMI);
  bf16_t* wmo = (bf16_t*)(ws + OFF_WMO);
  if (L == 0) {
    const float* w = inp(P, 8);
    prep_job(wmi, 4224, D_, sT, [=](int k, int n) {
      int c = n < 3072 ? n : (n < 4096 ? n + 16 : (n < 4112 ? n - 1024 : -1));
      return c < 0 ? 0.f : w[(size_t)k * 4112 + c] * g1[k];
    });
    const float* wo = inp(P, 12);
    prep_job(wmo, D_, D_, sT, [=](int k, int n) { return wo[(size_t)k * D_ + n]; });
  } else if (L == 1) {
    const float* w = inp(P, 13);
    prep_job(wmi, 2688, D_, sT, [=](int k, int n) { return n < 2608 ? w[(size_t)k * 2608 + n] * g1[k] : 0.f; });
    const float* wo = inp(P, 20);
    prep_job(wmo, D_, D_, sT, [=](int k, int n) { return wo[(size_t)k * D_ + n]; });
    const float* wck = inp(P, 16);
    const float* wcv = inp(P, 17);
    prep_job((bf16_t*)(ws + OFF_WCK), 128, 2048, sT, [=](int k, int n) { return n < 64 ? wck[(size_t)k * 64 + n] : 0.f; });
    prep_job((bf16_t*)(ws + OFF_WCV), 128, 2048, sT, [=](int k, int n) { return n < 64 ? wcv[(size_t)k * 64 + n] : 0.f; });
    if (bidx() == 0 && tidx() < 128) {
      const int e = tidx() & 63, which = tidx() >> 6;
      const float* pos = which ? inp(P, 15) : inp(P, 14);
      const float* wc = which ? inp(P, 17) : inp(P, 16);
      float s = 0.f;
      for (int kd = 0; kd < 2048; ++kd) s += pos[kd] * wc[(size_t)kd * 64 + e];
      ((float*)(ws + OFF_CBIAS))[which * 64 + e] = s;
    }
  } else if (L == 2) {
    const float* w = inp(P, 21);
    prep_job(wmi, 3200, D_, sT, [=](int k, int n) {
      int c = n < 2048 ? n : (n < 3072 ? n + 16 : (n < 3088 ? n - 1024 : -1));
      return c < 0 ? 0.f : w[(size_t)k * 3088 + c] * g1[k];
    });
    const float* wo = inp(P, 25);
    prep_job(wmo, D_, D_, sT, [=](int k, int n) { return wo[(size_t)k * D_ + n]; });
  } else {
    const float* w = inp(P, 26);
    prep_job(wmi, 3072, D_, sT, [=](int k, int n) { return w[(size_t)k * 3072 + n] * g1[k]; });
    const float* wo = inp(P, 27);
    prep_job(wmo, D_, D_, sT, [=](int k, int n) { return wo[(size_t)k * D_ + n]; });
  }
}

DI void init_phase(const Params& P) {
  const int tid = tidx(), lane = tid & 63, wave = tid >> 6;
  float* ssq = (float*)(wsp(P) + OFF_SSQ);
  bf16_t* xb = (bf16_t*)(wsp(P) + OFF_XB);
  const float* x = inp(P, 0);
  for (int row = bidx() * 4 + wave; row < M_; row += gridDim.x * 4) {
    float s = 0.f;
#pragma unroll
    for (int i = 0; i < 4; ++i) {
      const int c = (i * 64 + lane) * 4;
      f32x4 v = *(const f32x4*)(x + (size_t)row * D_ + c);
      s += v.x * v.x + v.y * v.y + v.z * v.z + v.w * v.w;
      store4bf(xb + (size_t)row * D_ + c, v.x, v.y, v.z, v.w);
    }
#pragma unroll
    for (int o = 32; o >= 1; o >>= 1) s += __shfl_xor(s, o);
    if (lane < 16) ssq[(size_t)row * 16 + lane] = (lane == 0) ? s : 0.f;
  }
}

struct AttnSmem {
  bf16_t k[64 * 72];
  bf16_t v[64 * 72];
  float c[64];
};

DI void attn_load(const bf16_t* Kb, int ldk, const bf16_t* VTb, int ldv, int j, u32x4 (&kr)[2], u32x4 (&vr)[2]) {
  const int tid = tidx();
#pragma unroll
  for (int i = 0; i < 2; ++i) {
    const int c = tid + 256 * i, row = c >> 3, cc = c & 7;
    kr[i] = *(const u32x4*)(Kb + (size_t)(j * 64 + row) * ldk + cc * 8);
    vr[i] = *(const u32x4*)(VTb + (size_t)row * ldv + j * 64 + cc * 8);
  }
}
DI void attn_store(AttnSmem& sm, const u32x4 (&kr)[2], const u32x4 (&vr)[2]) {
  const int tid = tidx();
#pragma unroll
  for (int i = 0; i < 2; ++i) {
    const int c = tid + 256 * i, row = c >> 3, cc = c & 7;
    *(u32x4*)(sm.k + row * 72 + cc * 8) = kr[i];
    *(u32x4*)(sm.v + row * 72 + cc * 8) = vr[i];
  }
}
DI void attn_qk(const AttnSmem& sm, const bf16x8 (&qf)[4], f32x16 (&st)[2]) {
  const int lane = tidx() & 63, r = lane & 31, h = lane >> 5;
#pragma unroll
  for (int kt = 0; kt < 2; ++kt) {
    zero16(st[kt]);
#pragma unroll
    for (int kk = 0; kk < 4; ++kk) {
      bf16x8 a = *(const bf16x8*)(sm.k + (kt * 32 + r) * 72 + kk * 16 + h * 8);
      st[kt] = MFMA(a, qf[kk], st[kt]);
    }
  }
}
DI void attn_pv(const AttnSmem& sm, const f32x16 (&st)[2], f32x16 (&o)[2]) {
  const int lane = tidx() & 63, r = lane & 31, h = lane >> 5;
#pragma unroll
  for (int kt = 0; kt < 2; ++kt)
#pragma unroll
    for (int s2 = 0; s2 < 2; ++s2) {
      bf16x8 pk = pack8(st[kt][8 * s2], st[kt][8 * s2 + 1], st[kt][8 * s2 + 2], st[kt][8 * s2 + 3], st[kt][8 * s2 + 4],
                        st[kt][8 * s2 + 5], st[kt][8 * s2 + 6], st[kt][8 * s2 + 7]);
#pragma unroll
      for (int dt = 0; dt < 2; ++dt) {
        const bf16_t* p = sm.v + (dt * 32 + r) * 72 + kt * 32 + 16 * s2 + 4 * h;
        bf16x8 a = cat4(*(const bf16x4*)p, *(const bf16x4*)(p + 8));
        o[dt] = MFMA(a, pk, o[dt]);
      }
    }
}
DI void load_qf(const bf16_t* Qrow, bf16x8 (&qf)[4]) {
  const int h = (tidx() & 63) >> 5;
#pragma unroll
  for (int kk = 0; kk < 4; ++kk) qf[kk] = *(const bf16x8*)(Qrow + kk * 16 + h * 8);
}

template <int MODE>
DI void flash_pass(const bf16_t* Kb, const bf16_t* VTb, const float* cB, float cq, u32x4 selw, int qw, int jlo, int jhi,
                   const bf16x8 (&qf)[4], f32x16 (&o)[2], float& lsum, AttnSmem& sm) {
  const int tid = tidx(), lane = tid & 63, r = lane & 31, h = lane >> 5;
  const int query = qw + r;
  float m_run = -1e30f, l_run = 0.f;
  zero16(o[0]);
  zero16(o[1]);
  u32x4 kr[2], vr[2];
  float cr = 0.f;
  attn_load(Kb, 64, VTb, S_, jlo, kr, vr);
  if (MODE == 0 && tid < 64) cr = cB[jlo * 64 + tid];
  for (int j = jlo; j <= jhi; ++j) {
    __syncthreads();
    attn_store(sm, kr, vr);
    if (MODE == 0 && tid < 64) sm.c[tid] = cr;
    __syncthreads();
    if (j < jhi) {
      attn_load(Kb, 64, VTb, S_, j + 1, kr, vr);
      if (MODE == 0 && tid < 64) cr = cB[(j + 1) * 64 + tid];
    }
    bool active = (j * 64 <= qw + 31);
    bool bit = true;
    if (MODE == 1) active = active && (j * 64 + 63 >= qw - 511);
    if (MODE == 2) {
      const int wi = j >> 5;
      const unsigned w = wi == 0 ? selw.x : (wi == 1 ? selw.y : (wi == 2 ? selw.z : selw.w));
      bit = (w >> (j & 31)) & 1u;
      active = active && (__ballot(bit) != 0ull);
    }
    if (active) {
      f32x16 st[2];
      attn_qk(sm, qf, st);
      const float SC = 0.125f * 1.4426950408889634f;
      const bool interior = (MODE != 0) && (j * 64 + 63 <= qw) && (MODE != 1 || (qw + 31 - j * 64 < 512));
      float mx = -1e30f;
      if (interior) {
#pragma unroll
        for (int kt = 0; kt < 2; ++kt)
#pragma unroll
          for (int i = 0; i < 16; ++i) {
            const float s = st[kt][i] * SC;
            st[kt][i] = s;
            mx = fmaxf(mx, s);
          }
        if (MODE == 2 && !bit) mx = -1e30f;
      } else {
#pragma unroll
        for (int kt = 0; kt < 2; ++kt)
#pragma unroll
          for (int i = 0; i < 16; ++i) {
            const int kl = kt * 32 + crow(i, h);
            const int key = j * 64 + kl;
            float s = st[kt][i] * SC;
            bool ok = key <= query;
            if (MODE == 0) s += (cq - sm.c[kl]) * 1.4426950408889634f;
            if (MODE == 1) ok = ok && (query - key < 512);
            if (MODE == 2) ok = ok && bit;
            s = ok ? s : -1e30f;
            st[kt][i] = s;
            mx = fmaxf(mx, s);
          }
      }
      mx = fmaxf(mx, __shfl_xor(mx, 32));
      const float m_new = fmaxf(m_run, mx);
      const float alpha = __builtin_amdgcn_exp2f(m_run - m_new);
      float ps = 0.f;
      if (interior) {
#pragma unroll
        for (int kt = 0; kt < 2; ++kt)
#pragma unroll
          for (int i = 0; i < 16; ++i) {
            float p = __builtin_amdgcn_exp2f(st[kt][i] - m_new);
            if (MODE == 2) p = bit ? p : 0.f;
            st[kt][i] = p;
            ps += p;
          }
      } else {
#pragma unroll
        for (int kt = 0; kt < 2; ++kt)
#pragma unroll
          for (int i = 0; i < 16; ++i) {
            const float s = st[kt][i];
            const float p = (s > -1e29f) ? __builtin_amdgcn_exp2f(s - m_new) : 0.f;
            st[kt][i] = p;
            ps += p;
          }
      }
      ps += __shfl_xor(ps, 32);
      l_run = l_run * alpha + ps;
      if (__ballot(m_new > m_run) != 0ull) {
#pragma unroll
        for (int dt = 0; dt < 2; ++dt)
#pragma unroll
          for (int i = 0; i < 16; ++i) o[dt][i] *= alpha;
      }
      m_run = m_new;
      attn_pv(sm, st, o);
    }
  }
  lsum = l_run;
}

DI void fox_pass(const bf16_t* Kb, const bf16_t* VTb, const float* cB, float cq, float sbound, int qw, int jhi,
                 const bf16x8 (&qf)[4], f32x16 (&o)[2], float& lsum, AttnSmem& sm) {
  const int tid = tidx(), lane = tid & 63, r = lane & 31, h = lane >> 5;
  const int query = qw + r;
  float m_run = -1e30f, l_run = 0.f;
  zero16(o[0]);
  zero16(o[1]);
  u32x4 kr[2], vr[2];
  float cr = 0.f;
  int done = 0;
  attn_load(Kb, 64, VTb, S_, jhi, kr, vr);
  if (tid < 64) cr = cB[jhi * 64 + tid];
  for (int j = jhi; j >= 0; --j) {
    if (__syncthreads_and(done)) break;
    attn_store(sm, kr, vr);
    if (tid < 64) sm.c[tid] = cr;
    __syncthreads();
    if (j > 0) {
      attn_load(Kb, 64, VTb, S_, j - 1, kr, vr);
      if (tid < 64) cr = cB[(j - 1) * 64 + tid];
    }
    if (j * 64 <= qw + 31) {
      f32x16 st[2];
      attn_qk(sm, qf, st);
      float mx = -1e30f;
#pragma unroll
      for (int kt = 0; kt < 2; ++kt)
#pragma unroll
        for (int i = 0; i < 16; ++i) {
          const int kl = kt * 32 + crow(i, h);
          const int key = j * 64 + kl;
          float s = st[kt][i] * 0.125f + (cq - sm.c[kl]);
          s = (key <= query) ? s : -1e30f;
          st[kt][i] = s;
          mx = fmaxf(mx, s);
        }
      mx = fmaxf(mx, __shfl_xor(mx, 32));
      const float m_new = fmaxf(m_run, mx);
      const float alpha = __expf(m_run - m_new);
      float ps = 0.f;
#pragma unroll
      for (int kt = 0; kt < 2; ++kt)
#pragma unroll
        for (int i = 0; i < 16; ++i) {
          const float s = st[kt][i];
          const float p = (s > -1e29f) ? __expf(s - m_new) : 0.f;
          st[kt][i] = p;
          ps += p;
        }
      ps += __shfl_xor(ps, 32);
      l_run = l_run * alpha + ps;
      m_run = m_new;
#pragma unroll
      for (int dt = 0; dt < 2; ++dt)
#pragma unroll
        for (int i = 0; i < 16; ++i) o[dt][i] *= alpha;
      attn_pv(sm, st, o);
      done = (sbound + cq - sm.c[0] < m_run - 104.f) ? 1 : 0;
    }
  }
  lsum = l_run;
}
DI void fox_scan_phase(const Params& P, char* smem) {
  double* sp = (double*)smem;
  const float* flog = (const float*)(wsp(P) + OFF_FLOG);
  float* c = (float*)(wsp(P) + OFF_C);
  const int tid = tidx();
  for (int seq = bidx(); seq < 64; seq += gridDim.x) {
    const float* src = flog + (size_t)seq * S_ + tid * 32;
    double tot = 0.0;
    for (int i = 0; i < 32; ++i) tot += (double)src[i];
    __syncthreads();
    sp[tid] = tot;
    __syncthreads();
    double pre = 0.0;
    for (int i = 0; i < tid; ++i) pre += sp[i];
    float* dst = c + (size_t)seq * S_ + tid * 32;
    for (int i = 0; i < 32; ++i) {
      pre += (double)src[i];
      dst[i] = (float)pre;
    }
  }
}

DI void fox_attn_phase(const Params& P, char* smem, int rep) {
  AttnSmem& sm = *(AttnSmem*)smem;
  const bf16_t* Q = (const bf16_t*)(wsp(P) + OFF_R);
  const bf16_t* K = Q + (size_t)M_ * D_;
  const bf16_t* VT = K + (size_t)M_ * D_;
  const float* c = (const float*)(wsp(P) + OFF_C);
  bf16_t* obuf = (bf16_t*)(wsp(P) + OFF_OBUF);
  const int lane = tidx() & 63, wave = tidx() >> 6, r = lane & 31, h = lane >> 5;
  float gqm = 0.f, gkm = 0.f;
  for (int d = 0; d < 64; ++d) {
    gqm = fmaxf(gqm, fabsf(inp(P, 10)[d]));
    gkm = fmaxf(gkm, fabsf(inp(P, 11)[d]));
  }
  const float sbound = 8.16f * gqm * gkm;
  for (int it = bidx(); it < 4096; it += gridDim.x) {
    const int qt = 63 - (it >> 6), bh = it & 63;
    const int q0 = qt * 128, qw = q0 + wave * 32, query = qw + r;
    bf16x8 qf[4];
    load_qf(Q + ((size_t)bh * S_ + query) * 64, qf);
    const float cq = c[(size_t)bh * S_ + query];
    f32x16 o[2];
    float l;
    fox_pass(K + (size_t)bh * S_ * 64, VT + (size_t)bh * 64 * S_, c + (size_t)bh * S_, cq, sbound, qw, 2 * qt + 1, qf, o, l, sm);
    const float inv = 1.f / l;
    const int b = bh >> 4, hh = bh & 15;
    bf16_t* dst = obuf + ((size_t)b * S_ + query) * D_ + hh * 64;
#pragma unroll
    for (int dt = 0; dt < 2; ++dt)
#pragma unroll
      for (int a = 0; a < 4; ++a) {
        bf16_t* p = dst + dt * 32 + 8 * a + 4 * h;
        u32x2 g = *(const u32x2*)p;
        if (rep) *(u32x2*)p = g;
        else
        store4bf(p, o[dt][4 * a] * inv * bflo(g.x), o[dt][4 * a + 1] * inv * bfhi(g.x), o[dt][4 * a + 2] * inv * bflo(g.y),
                 o[dt][4 * a + 3] * inv * bfhi(g.y));
      }
  }
}

DI void sb_attn_phase(const Params& P, char* smem) {
  AttnSmem& sm = *(AttnSmem*)smem;
  const bf16_t* Q = (const bf16_t*)(wsp(P) + OFF_R);
  const bf16_t* K = Q + (size_t)M_ * D_;
  const bf16_t* VT = K + (size_t)M_ * D_;
  bf16_t* obuf = (bf16_t*)(wsp(P) + OFF_OBUF);
  const int tid = tidx(), lane = tid & 63, wave = tid >> 6, r = lane & 31, h = lane >> 5;
  bf16x8 tdiag[2], ones;
#pragma unroll
  for (int s2 = 0; s2 < 2; ++s2)
#pragma unroll
    for (int jj = 0; jj < 8; ++jj) {
      const int kj = 16 * s2 + 8 * (jj >> 2) + 4 * h + (jj & 3);
      tdiag[s2][jj] = (kj > r) ? (short)0x3f80 : (short)0;
    }
#pragma unroll
  for (int jj = 0; jj < 8; ++jj) ones[jj] = (short)0x3f80;

  for (int it = bidx(); it < 4096; it += gridDim.x) {
    const int qt = 63 - (it >> 6), bh = it & 63;
    const int q0 = qt * 128, qw = q0 + wave * 32, query = qw + r;
    const bf16_t* Kb = K + (size_t)bh * S_ * 64;
    const bf16_t* VTb = VT + (size_t)bh * 64 * S_;
    bf16x8 qf[4];
    load_qf(Q + ((size_t)bh * S_ + query) * 64, qf);
    f32x16 o[2];
    zero16(o[0]);
    zero16(o[1]);
    float R = 0.f;
    u32x4 kr[2], vr[2];
    const int jhi = 2 * qt + 1;
    attn_load(Kb, 64, VTb, S_, jhi, kr, vr);
    for (int j = jhi; j >= 0; --j) {
      if (__syncthreads_and(R < -110.f)) break;
      attn_store(sm, kr, vr);
      __syncthreads();
      if (j > 0) attn_load(Kb, 64, VTb, S_, j - 1, kr, vr);
      if (j * 64 < qw + 31) {
        f32x16 st[2], Lv[2], lat[2];
        attn_qk(sm, qf, st);
        float tot = 0.f;
#pragma unroll
        for (int kt = 0; kt < 2; ++kt)
#pragma unroll
          for (int i = 0; i < 16; ++i) {
            const int key = j * 64 + kt * 32 + crow(i, h);
            const float z = st[kt][i] * 0.125f;
            const float sp = fmaxf(z, 0.f) + __logf(1.f + __expf(-fabsf(z)));
            const float L = (key < query) ? -sp : 0.f;
            st[kt][i] = z;
            Lv[kt][i] = L;
            tot += L;
          }
        tot += __shfl_xor(tot, 32);
        bf16x8 hi[2][2], lo[2][2];
#pragma unroll
        for (int kt = 0; kt < 2; ++kt)
#pragma unroll
          for (int s2 = 0; s2 < 2; ++s2) {
            float hv[8], lv[8];
#pragma unroll
            for (int q = 0; q < 8; ++q) {
              const float L = Lv[kt][8 * s2 + q];
              hv[q] = bf2f(f2bf(L));
              lv[q] = L - hv[q];
            }
            hi[kt][s2] = pack8(hv[0], hv[1], hv[2], hv[3], hv[4], hv[5], hv[6], hv[7]);
            lo[kt][s2] = pack8(lv[0], lv[1], lv[2], lv[3], lv[4], lv[5], lv[6], lv[7]);
          }
        zero16(lat[0]);
        zero16(lat[1]);
#pragma unroll
        for (int s2 = 0; s2 < 2; ++s2) {
          lat[0] = MFMA(tdiag[s2], hi[0][s2], lat[0]);
          lat[0] = MFMA(tdiag[s2], lo[0][s2], lat[0]);
          lat[0] = MFMA(ones, hi[1][s2], lat[0]);
          lat[0] = MFMA(ones, lo[1][s2], lat[0]);
          lat[1] = MFMA(tdiag[s2], hi[1][s2], lat[1]);
          lat[1] = MFMA(tdiag[s2], lo[1][s2], lat[1]);
        }
#pragma unroll
        for (int kt = 0; kt < 2; ++kt)
#pragma unroll
          for (int i = 0; i < 16; ++i) {
            const int key = j * 64 + kt * 32 + crow(i, h);
            const float e = st[kt][i] + Lv[kt][i] + lat[kt][i] + R;
            st[kt][i] = (key < query) ? __expf(e) : 0.f;
          }
        R += tot;
        attn_pv(sm, st, o);
      }
    }
    const int b = bh >> 4, hh = bh & 15;
    bf16_t* dst = obuf + ((size_t)b * S_ + query) * D_ + hh * 64;
#pragma unroll
    for (int dt = 0; dt < 2; ++dt)
#pragma unroll
      for (int a = 0; a < 4; ++a)
        store4bf(dst + dt * 32 + 8 * a + 4 * h, o[dt][4 * a], o[dt][4 * a + 1], o[dt][4 * a + 2], o[dt][4 * a + 3]);
  }
}

DI void nsa_compress_phase(const Params& P, char* smem) {
  bf16_t* sW = (bf16_t*)smem;
  bf16_t* sX = sW + 128 * 72;
  const bf16_t* KC = (const bf16_t*)(wsp(P) + OFF_R + 64 * MiB);
  const bf16_t* VC = (const bf16_t*)(wsp(P) + OFF_R + 112 * MiB);
  const float* cb = (const float*)(wsp(P) + OFF_CBIAS);
  const int wave = tidx() >> 6, wn = wave >> 1, wm = wave & 1;
  for (int t = bidx(); t < 64; t += gridDim.x) {
    const int isv = t >> 5, kv = (t >> 1) & 15, mt = t & 1;
    const bf16_t* Wt = (const bf16_t*)(wsp(P) + (isv ? OFF_WCV : OFF_WCK));
    const bf16_t* X = (isv ? VC : KC) + ((size_t)kv * S_ + (size_t)mt * 256 * 16) * 64;
    f32x16 acc[2][2][2];
    gemm_tile<2>(Wt, 2048, X, 1024, 2048, sW, sX, acc);
    EpiCmp epi;
    epi.cb = cb + isv * 64;
    epi.gk = inp(P, 19);
    epi.isv = isv;
    epi.dst = isv ? (bf16_t*)(wsp(P) + OFF_VCMPT) + (size_t)kv * 64 * 512 : (bf16_t*)(wsp(P) + OFF_KCMP) + (size_t)kv * 512 * 64;
    epi(acc[0], wn * 64, mt * 256 + wm * 128);
    epi(acc[1], wn * 64, mt * 256 + wm * 128 + 64);
  }
}

struct CmpSmem {
  AttnSmem a;
  float imp[32 * 132];
};

DI void nsa_cmp_phase(const Params& P, char* smem) {
  CmpSmem& sm = *(CmpSmem*)smem;
  const bf16_t* Q = (const bf16_t*)(wsp(P) + OFF_R);
  const bf16_t* KCMP = (const bf16_t*)(wsp(P) + OFF_KCMP);
  const bf16_t* VCMPT = (const bf16_t*)(wsp(P) + OFF_VCMPT);
  const float* gates = (const float*)(wsp(P) + OFF_GATES);
  bf16_t* obuf = (bf16_t*)(wsp(P) + OFF_OBUF);
  u32x4* sel = (u32x4*)(wsp(P) + OFF_SEL);
  const int tid = tidx(), lane = tid & 63, wave = tid >> 6, r = lane & 31, h = lane >> 5;
  for (int it = bidx(); it < 4096; it += gridDim.x) {
    const int tt = 255 - (it >> 4), kv = it & 15, b = kv >> 2, g = kv & 3;
    const int t0 = tt * 32, head = g * 4 + wave, query = t0 + r;
    const bf16_t* Kb = KCMP + (size_t)kv * 512 * 64;
    const bf16_t* VTb = VCMPT + (size_t)kv * 64 * 512;
    bf16x8 qf[4];
    load_qf(Q + ((size_t)(b * 16 + head) * S_ + query) * 64, qf);
    const int ntiles = ((t0 >> 4) >> 6) + 1;
    __syncthreads();
    for (int e = tid; e < 32 * 132; e += 256) sm.imp[e] = 0.f;
    float m_run = -1e30f, l_run = 0.f;
    u32x4 kr[2], vr[2];
    for (int jt = 0; jt < ntiles; ++jt) {
      attn_load(Kb, 64, VTb, 512, jt, kr, vr);
      __syncthreads();
      attn_store(sm.a, kr, vr);
      __syncthreads();
      f32x16 st[2];
      attn_qk(sm.a, qf, st);
      float mx = -1e30f;
#pragma unroll
      for (int kt = 0; kt < 2; ++kt)
#pragma unroll
        for (int i = 0; i < 16; ++i) {
          const int n = jt * 64 + kt * 32 + crow(i, h);
          const float s = (16 * n + 31 <= query) ? st[kt][i] * 0.125f : -1e30f;
          st[kt][i] = s;
          mx = fmaxf(mx, s);
        }
      mx = fmaxf(mx, __shfl_xor(mx, 32));
      const float m_new = fmaxf(m_run, mx);
      float ps = 0.f;
#pragma unroll
      for (int kt = 0; kt < 2; ++kt)
#pragma unroll
        for (int i = 0; i < 16; ++i) ps += (st[kt][i] > -1e29f) ? __expf(st[kt][i] - m_new) : 0.f;
      ps += __shfl_xor(ps, 32);
      l_run = l_run * __expf(m_run - m_new) + ps;
      m_run = m_new;
    }
    const float linv = l_run > 0.f ? 1.f / l_run : 0.f;
    f32x16 o[2];
    zero16(o[0]);
    zero16(o[1]);
    for (int jt = 0; jt < ntiles; ++jt) {
      attn_load(Kb, 64, VTb, 512, jt, kr, vr);
      __syncthreads();
      attn_store(sm.a, kr, vr);
      __syncthreads();
      f32x16 st[2];
      attn_qk(sm.a, qf, st);
#pragma unroll
      for (int kt = 0; kt < 2; ++kt)
#pragma unroll
        for (int i = 0; i < 16; ++i) {
          const int n = jt * 64 + kt * 32 + crow(i, h);
          st[kt][i] = (16 * n + 31 <= query) ? __expf(st[kt][i] * 0.125f - m_run) * linv : 0.f;
        }
      attn_pv(sm.a, st, o);
      for (int w = 0; w < 4; ++w) {
        if (wave == w) {
          float* ip = sm.imp + r * 132 + jt * 16 + h;
#pragma unroll
          for (int kt = 0; kt < 2; ++kt)
#pragma unroll
            for (int a = 0; a < 4; ++a) {
              const float G = st[kt][4 * a] + st[kt][4 * a + 1] + st[kt][4 * a + 2] + st[kt][4 * a + 3];
              const float x = __shfl_xor(st[kt][4 * a + 3], 32);
              ip[kt * 8 + 2 * a] += G + (h ? x : 0.f);
              if (!h) ip[kt * 8 + 2 * a + 2] += x;
            }
        }
        __syncthreads();
      }
    }
    {
      const size_t m = (size_t)b * S_ + query;
      float gc = gates[m * 48 + head * 3 + 0];
#if ABL == 3
      gc = 0.f;
#endif
      bf16_t* dst = obuf + m * D_ + head * 64;
#pragma unroll
      for (int dt = 0; dt < 2; ++dt)
#pragma unroll
        for (int a = 0; a < 4; ++a)
          store4bf(dst + dt * 32 + 8 * a + 4 * h, o[dt][4 * a] * gc, o[dt][4 * a + 1] * gc, o[dt][4 * a + 2] * gc,
                   o[dt][4 * a + 3] * gc);
    }
    for (int tk = 0; tk < 8; ++tk) {
      const int tl = wave * 8 + tk, t = t0 + tl, cur = t >> 6;
      const float* ip = sm.imp + tl * 132;
      const int j0 = lane, j1 = lane + 64;
      const bool f0 = (j0 == 0) || (j0 == cur) || (j0 == cur - 1);
      const bool f1 = (j1 == cur) || (j1 == cur - 1);
      const float v0 = f0 ? 1e9f : (j0 <= cur ? ip[j0] : -1.f);
      const float v1 = f1 ? 1e9f : (j1 <= cur ? ip[j1] : -1.f);
      int r0 = 0, r1 = 0;
      for (int jp = 0; jp <= cur; ++jp) {
        const bool fp = (jp == 0) || (jp == cur) || (jp == cur - 1);
        const float vp = fp ? 1e9f : ip[jp];
        r0 += (vp > v0 || (vp == v0 && jp < j0)) ? 1 : 0;
        r1 += (vp > v1 || (vp == v1 && jp < j1)) ? 1 : 0;
      }
      const unsigned long long m0 = __ballot(j0 <= cur && r0 < 16);
      const unsigned long long m1 = __ballot(j1 <= cur && r1 < 16);
      if (lane == 0) {
        u32x4 w;
        w.x = (unsigned)m0;
        w.y = (unsigned)(m0 >> 32);
        w.z = (unsigned)m1;
        w.w = (unsigned)(m1 >> 32);
        sel[(size_t)kv * S_ + t] = w;
      }
    }
  }
}

DI void nsa_attn_phase(const Params& P, char* smem, int rep) {
  AttnSmem& sm = *(AttnSmem*)smem;
  char* R = wsp(P) + OFF_R;
  const bf16_t* Q = (const bf16_t*)R;
  const bf16_t* KS = (const bf16_t*)(R + 80 * MiB);
  const bf16_t* KW = (const bf16_t*)(R + 96 * MiB);
  const bf16_t* VST = (const bf16_t*)(R + 128 * MiB);
  const bf16_t* VWT = (const bf16_t*)(R + 144 * MiB);
  const float* gates = (const float*)(wsp(P) + OFF_GATES);
  const u32x4* sel = (const u32x4*)(wsp(P) + OFF_SEL);
  bf16_t* obuf = (bf16_t*)(wsp(P) + OFF_OBUF);
  const int lane = tidx() & 63, wave = tidx() >> 6, r = lane & 31, h = lane >> 5;
  for (int it = bidx(); it < 4096; it += gridDim.x) {
    const int qt = 63 - (it >> 6), jx = it & 7, jy = (it >> 3) & 7;
    const int kv = jx * 2 + (jy >> 2), b = kv >> 2, head = (kv & 3) * 4 + (jy & 3), bh = b * 16 + head;
    const int q0 = qt * 128, qw = q0 + wave * 32, query = qw + r;
    bf16x8 qf[4];
    load_qf(Q + ((size_t)bh * S_ + query) * 64, qf);
    const u32x4 selw = sel[(size_t)kv * S_ + query];
    const size_t m = (size_t)b * S_ + query;
    float gs = gates[m * 48 + head * 3 + 1], gw = gates[m * 48 + head * 3 + 2];
    if (rep) { gs = 0.f; gw = 0.f; }
#if ABL == 1
    gs = 0.f;
#elif ABL == 2
    gw = 0.f;
#endif
    f32x16 o[2], ow[2];
    float l;
    const int jlo = (q0 > 511 ? q0 - 511 : 0) >> 6;
    flash_pass<1>(KW + (size_t)kv * S_ * 64, VWT + (size_t)kv * 64 * S_, nullptr, 0.f, selw, qw, jlo, 2 * qt + 1, qf, o, l, sm);
    {
      const float sc = gw / l;
#pragma unroll
      for (int dt = 0; dt < 2; ++dt)
#pragma unroll
        for (int i = 0; i < 16; ++i) ow[dt][i] = o[dt][i] * sc;
    }
    flash_pass<2>(KS + (size_t)kv * S_ * 64, VST + (size_t)kv * 64 * S_, nullptr, 0.f, selw, qw, 0, 2 * qt + 1, qf, o, l, sm);
    const float sc = gs / l;
    bf16_t* dst = obuf + m * D_ + head * 64;
#pragma unroll
    for (int dt = 0; dt < 2; ++dt)
#pragma unroll
      for (int a = 0; a < 4; ++a) {
        bf16_t* p = dst + dt * 32 + 8 * a + 4 * h;
        u32x2 g = *(const u32x2*)p;
        store4bf(p, ow[dt][4 * a] + o[dt][4 * a] * sc + bflo(g.x), ow[dt][4 * a + 1] + o[dt][4 * a + 1] * sc + bfhi(g.x),
                 ow[dt][4 * a + 2] + o[dt][4 * a + 2] * sc + bflo(g.y), ow[dt][4 * a + 3] + o[dt][4 * a + 3] * sc + bfhi(g.y));
      }
  }
}

struct GlaSmem {
  float glow[64 * 16];
  float tot[2 * 128];
  float ssq[2 * 64];
  bf16_t q[64 * 136];
  bf16_t ki[64 * 136];
  bf16_t a[64 * 72];
};

DI void gla_compute_b(const Params& P, GlaSmem& sm, int b, int hg, int t0, float (&bv)[32], float& blast) {
  const int tid = tidx(), d = tid & 127, half = tid >> 7;
  const float* glow = (const float*)(wsp(P) + OFF_GLOW) + ((size_t)b * S_ + t0) * 16;
  __syncthreads();
  for (int e = tid; e < 1024; e += 256) sm.glow[e] = glow[e];
  const int col = hg * 128 + d;
  float w[16];
#pragma unroll
  for (int q = 0; q < 16; ++q) w[q] = inp(P, 22)[q * 512 + col];
  const float bias = inp(P, 23)[col];
  __syncthreads();
  float run = 0.f;
#pragma unroll
  for (int cc = 0; cc < 32; ++cc) {
    const float* gl = sm.glow + (half * 32 + cc) * 16;
    float z = 0.f;
#pragma unroll
    for (int q = 0; q < 16; ++q) z += gl[q] * w[q];
    z += bias;
    run += logsigmoidf_(z) * (1.f / 16.f);
    bv[cc] = run;
    if ((cc & 3) == 3) __builtin_amdgcn_sched_barrier(0);
  }
  sm.tot[half * 128 + d] = run;
  __syncthreads();
  const float t0v = sm.tot[d], t1v = sm.tot[128 + d];
  if (half) {
#pragma unroll
    for (int cc = 0; cc < 32; ++cc) bv[cc] += t0v;
  }
  blast = t0v + t1v;
}

DI void gla_u_phase(const Params& P, char* smem) {
  GlaSmem& sm = *(GlaSmem*)smem;
  char* R = wsp(P) + OFF_R;
  const bf16_t* KG = (const bf16_t*)(R + 32 * MiB);
  const bf16_t* VTG = (const bf16_t*)(R + 64 * MiB);
  bf16_t* UT = (bf16_t*)(R + 128 * MiB);
  float* decay = (float*)(wsp(P) + OFF_DECAY);
  bf16_t* sKT = sm.q;
  const int tid = tidx(), lane = tid & 63, wave = tid >> 6, r = lane & 31, h = lane >> 5;
  const int d = tid & 127, half = tid >> 7;
  for (int it = bidx(); it < 2048; it += gridDim.x) {
    const int n = it & 127, bhg = it >> 7, b = bhg >> 2, hg = bhg & 3, t0 = n * 64;
    float bv[32], blast;
    gla_compute_b(P, sm, b, hg, t0, bv, blast);
#pragma unroll
    for (int cc = 0; cc < 32; ++cc) {
      const int c = half * 32 + cc;
      const float k = bf2f(KG[((size_t)b * S_ + t0 + c) * 512 + hg * 128 + d]);
      sKT[d * 72 + c] = f2bf(k * __expf(blast - bv[cc]));
      if ((cc & 7) == 7) __builtin_amdgcn_sched_barrier(0);
    }
    if (half == 0) decay[(size_t)it * 128 + d] = __expf(blast);
    __syncthreads();
#pragma unroll 1
    for (int m2 = 0; m2 < 2; ++m2) {
      const int e0 = (2 * wave + m2) * 32;
      f32x16 acc[4];
#pragma unroll
      for (int q = 0; q < 4; ++q) zero16(acc[q]);
      const bf16_t* vrow = VTG + ((size_t)b * 1024 + hg * 256 + e0 + r) * S_ + t0;
#pragma unroll
      for (int kk = 0; kk < 4; ++kk) {
        bf16x8 a = *(const bf16x8*)(vrow + kk * 16 + h * 8);
#pragma unroll
        for (int nt = 0; nt < 4; ++nt) {
          bf16x8 bb = *(const bf16x8*)(sKT + (nt * 32 + r) * 72 + kk * 16 + h * 8);
          acc[nt] = MFMA(a, bb, acc[nt]);
        }
        __builtin_amdgcn_sched_barrier(0);
      }
      bf16_t* ub = UT + ((size_t)it * 256 + e0 + 4 * h) * 128 + r;
#pragma unroll
      for (int nt = 0; nt < 4; ++nt) {
#pragma unroll
        for (int i = 0; i < 16; ++i) ub[((i & 3) + 8 * (i >> 2)) * 128 + nt * 32] = f2bf(acc[nt][i]);
        __builtin_amdgcn_sched_barrier(0);
      }
    }
  }
}

DI void gla_scan_phase(const Params& P, int rep) {
  bf16_t* UT = (bf16_t*)(wsp(P) + OFF_R + 128 * MiB);
  const float* decay = (const float*)(wsp(P) + OFF_DECAY);
  for (int gid = bidx() * 256 + tidx(); gid < 16 * 256 * 128; gid += gridDim.x * 256) {
    const int bhg = gid >> 15, e = (gid >> 7) & 255, d = gid & 127;
    float state = 0.f;
    for (int n0 = 0; n0 < 128; n0 += 8) {
      float u[8], dc[8];
#pragma unroll
      for (int q = 0; q < 8; ++q) {
        const size_t it = (size_t)bhg * 128 + n0 + q;
        u[q] = bf2f(UT[(it * 256 + e) * 128 + d]);
        dc[q] = decay[it * 128 + d];
      }
#pragma unroll
      for (int q = 0; q < 8; ++q) {
        const size_t it = (size_t)bhg * 128 + n0 + q;
        UT[(it * 256 + e) * 128 + d] = rep ? f2bf(u[q]) : f2bf(state);
        state = dc[q] * state + u[q];
      }
    }
  }
}

DI void gla_out_phase(const Params& P, char* smem, int rep) {
  GlaSmem& sm = *(GlaSmem*)smem;
  char* R = wsp(P) + OFF_R;
  const bf16_t* QG = (const bf16_t*)R;
  const bf16_t* KG = (const bf16_t*)(R + 32 * MiB);
  const bf16_t* VTG = (const bf16_t*)(R + 64 * MiB);
  const bf16_t* UT = (const bf16_t*)(R + 128 * MiB);
  bf16_t* obuf = (bf16_t*)(wsp(P) + OFF_OBUF);
  const float* gout = inp(P, 24);
  const int tid = tidx(), lane = tid & 63, wave = tid >> 6, r = lane & 31, h = lane >> 5;
  const int d = tid & 127, half = tid >> 7;
  for (int it = bidx(); it < 2048; it += gridDim.x) {
    const int n = it & 127, bhg = it >> 7, b = bhg >> 2, hg = bhg & 3, t0 = n * 64;
    float bv[32], blast;
    gla_compute_b(P, sm, b, hg, t0, bv, blast);
#pragma unroll
    for (int cc = 0; cc < 32; ++cc) {
      const int c = half * 32 + cc;
      const size_t off = ((size_t)b * S_ + t0 + c) * 512 + hg * 128 + d;
      const float q = bf2f(QG[off]), k = bf2f(KG[off]);
      sm.q[c * 136 + d] = f2bf(q * 0.08838834764831845f * __expf(bv[cc]));
      sm.ki[c * 136 + d] = f2bf(k * __expf(-bv[cc]));
      if ((cc & 3) == 3) __builtin_amdgcn_sched_barrier(0);
    }
    __syncthreads();
    {
      const int ct = wave >> 1, stt = wave & 1;
      f32x16 acc;
      zero16(acc);
      if (stt <= ct) {
#pragma unroll
        for (int kk = 0; kk < 8; ++kk) {
          bf16x8 a = *(const bf16x8*)(sm.q + (ct * 32 + r) * 136 + kk * 16 + h * 8);
          bf16x8 bb = *(const bf16x8*)(sm.ki + (stt * 32 + r) * 136 + kk * 16 + h * 8);
          acc = MFMA(a, bb, acc);
        }
      }
#pragma unroll
      for (int i = 0; i < 16; ++i) {
        const int c = ct * 32 + crow(i, h), s = stt * 32 + r;
        sm.a[c * 72 + s] = f2bf(s <= c ? acc[i] : 0.f);
      }
    }
    __syncthreads();
    const int ctok = wave & 1, eh = wave >> 1;
    f32x16 acc[4];
#pragma unroll
    for (int q = 0; q < 4; ++q) zero16(acc[q]);
#pragma unroll
    for (int kk = 0; kk < 4; ++kk) {
      bf16x8 bb = *(const bf16x8*)(sm.a + (ctok * 32 + r) * 72 + kk * 16 + h * 8);
#pragma unroll
      for (int mt = 0; mt < 4; ++mt) {
        bf16x8 a = *(const bf16x8*)(VTG + ((size_t)b * 1024 + hg * 256 + eh * 128 + mt * 32 + r) * S_ + t0 + kk * 16 + h * 8);
        acc[mt] = MFMA(a, bb, acc[mt]);
      }
      if (kk & 1) __builtin_amdgcn_sched_barrier(0);
    }
#pragma unroll
    for (int kk = 0; kk < 8; ++kk) {
      bf16x8 bb = *(const bf16x8*)(sm.q + (ctok * 32 + r) * 136 + kk * 16 + h * 8);
#pragma unroll
      for (int mt = 0; mt < 4; ++mt) {
        bf16x8 a = *(const bf16x8*)(UT + ((size_t)it * 256 + eh * 128 + mt * 32 + r) * 128 + kk * 16 + h * 8);
        acc[mt] = MFMA(a, bb, acc[mt]);
      }
      if (kk & 1) __builtin_amdgcn_sched_barrier(0);
    }
    float ss = 0.f;
#pragma unroll
    for (int mt = 0; mt < 4; ++mt)
#pragma unroll
      for (int i = 0; i < 16; ++i) ss += acc[mt][i] * acc[mt][i];
    ss += __shfl_xor(ss, 32);
    if (h == 0) sm.ssq[eh * 64 + ctok * 32 + r] = ss;
    __syncthreads();
    const float tot = sm.ssq[ctok * 32 + r] + sm.ssq[64 + ctok * 32 + r];
    const float rinv = rsqrtf(tot * (1.f / 256.f) + 1e-6f);
    bf16_t* dst = obuf + ((size_t)b * S_ + t0 + ctok * 32 + r) * D_ + hg * 256 + eh * 128;
#pragma unroll
    for (int mt = 0; mt < 4; ++mt)
#pragma unroll
      for (int a = 0; a < 4; ++a) {
        const int el = mt * 32 + 8 * a + 4 * h;
        const float* gp = gout + eh * 128 + el;
        bf16_t* p = dst + el;
        u32x2 g = *(const u32x2*)p;
        if (rep) *(u32x2*)p = g;
        else
        store4bf(p, acc[mt][4 * a] * rinv * gp[0] * bflo(g.x), acc[mt][4 * a + 1] * rinv * gp[1] * bfhi(g.x),
                 acc[mt][4 * a + 2] * rinv * gp[2] * bflo(g.y), acc[mt][4 * a + 3] * rinv * gp[3] * bfhi(g.y));
      }
  }
}

#define XB_TMO 128
#define XB_XCNT(j) (256 + 64 * (j))
#define XB_XSUB(j) (1280 + 64 * (j))
#define XB_XGEN(j) (2304 + 64 * (j))
#define XB_TOP 3328
#define XB_TOPGEN 3392
#define XCD_BAR_WORDS 3456
#define XB_SPIN_CAP (1u << 21)
#define LAS __attribute__((address_space(3)))
DI unsigned xb_ld(unsigned* p) { return __hip_atomic_load(p, __ATOMIC_RELAXED, __HIP_MEMORY_SCOPE_AGENT); }
DI unsigned xb_add(unsigned* p, unsigned v) { return __hip_atomic_fetch_add(p, v, __ATOMIC_RELAXED, __HIP_MEMORY_SCOPE_AGENT); }
DI unsigned xb_xcc_id() { return (unsigned)__builtin_amdgcn_s_getreg((3 << 11) | 20) & 0xFu; }
#define XB_SPIN(cond, bar)                                           \
  do {                                                               \
    unsigned _sp = 0;                                                \
    while (cond) {                                                   \
      __builtin_amdgcn_s_sleep(1);                                   \
      if ((++_sp & 255u) == 0u) {                                    \
        if (xb_ld(&(bar)[XB_TMO])) break;                            \
        if (_sp > XB_SPIN_CAP) {                                     \
          atomicAdd(&(bar)[XB_TMO], 1u);                             \
          break;                                                     \
        }                                                            \
      }                                                              \
    }                                                                \
  } while (0)
struct XcdBarrier {
  unsigned* bar;
  unsigned x;
  volatile LAS unsigned* st;
};
DI XcdBarrier xcd_barrier_post(unsigned* bar, volatile LAS unsigned* st) {
  XcdBarrier b;
  b.bar = bar;
  b.x = xb_xcc_id();
  b.st = st;
  if (threadIdx.x == 0) (void)xb_add(&bar[XB_XCNT(b.x)], 1u);
  return b;
}
DI void xcd_barrier_complete(unsigned* bar, unsigned x, unsigned& nloc, unsigned& nx) {
  const unsigned G = gridDim.x * gridDim.y * gridDim.z;
  unsigned sum, cnt, mine, sp = 0u;
  for (;;) {
    sum = 0u;
    cnt = 0u;
    mine = 0u;
#pragma unroll
    for (unsigned j = 0; j < 16; ++j) {
      const unsigned c = xb_ld(&bar[XB_XCNT(j)]);
      sum += c;
      cnt += (c > 0u) ? 1u : 0u;
      mine = (j == x) ? c : mine;
    }
    if (sum == G) break;
    __builtin_amdgcn_s_sleep(1);
    if ((++sp & 255u) == 0u) {
      if (xb_ld(&bar[XB_TMO])) break;
      if (sp > XB_SPIN_CAP) {
        atomicAdd(&bar[XB_TMO], 1u);
        break;
      }
    }
  }
  nloc = mine > 0u ? mine : 1u;
  nx = cnt > 0u ? cnt : 1u;
}
DI void xcd_barrier(const XcdBarrier& b) {
  asm volatile("s_waitcnt vmcnt(0)" ::: "memory");
  __syncthreads();
  if (threadIdx.x == 0) {
    unsigned* bar = b.bar;
    __builtin_amdgcn_s_waitcnt(0);
    unsigned nloc = b.st[0], nx = b.st[1];
    if (nloc == 0u) {
      xcd_barrier_complete(bar, b.x, nloc, nx);
      b.st[0] = nloc;
      b.st[1] = nx;
    }
    const unsigned old = xb_add(&bar[XB_XSUB(b.x)], 1u);
    const unsigned gen = old / nloc;
    if (old + 1u == (gen + 1u) * nloc) {
      __builtin_amdgcn_fence(__ATOMIC_RELEASE, "agent");
      asm volatile("s_waitcnt vmcnt(0)" ::: "memory");
      const unsigned og = xb_add(&bar[XB_TOP], 1u);
      const unsigned tg = og / nx;
      if (og + 1u == (tg + 1u) * nx) xb_add(&bar[XB_TOPGEN], 1u);
      else XB_SPIN(xb_ld(&bar[XB_TOPGEN]) == tg, bar);
      __builtin_amdgcn_fence(__ATOMIC_ACQUIRE, "agent");
      xb_add(&bar[XB_XGEN(b.x)], 1u);
      asm volatile("s_waitcnt vmcnt(0)" ::: "memory");
    } else {
      XB_SPIN(xb_ld(&bar[XB_XGEN(b.x)]) == gen, bar);
      __builtin_amdgcn_fence(__ATOMIC_ACQUIRE, "agent");
      asm volatile("s_waitcnt vmcnt(0)" ::: "memory");
    }
  }
  __syncthreads();
}

DI void run_phase(const Params& P, int ph, char* smem, int rep) {
  char* ws = wsp(P);
  float* ssq = (float*)(ws + OFF_SSQ);
  bf16_t* xb = (bf16_t*)(ws + OFF_XB);
  bf16_t* obuf = (bf16_t*)(ws + OFF_OBUF);
  bf16_t* act = (bf16_t*)(ws + OFF_R);
  if (ph == 0) {
    init_phase(P);
    prep_layer(P, 0, smem);
    return;
  }
  int L, lp;
  if (ph <= 8) { L = 0; lp = ph - 1; }
  else if (ph <= 18) { L = 1; lp = ph - 10; }
  else if (ph <= 28) { L = 2; lp = ph - 20; }
  else { L = 3; lp = ph - 30; }
  if (lp < 0) {
    prep_layer(P, L, smem);
    return;
  }
  const int nmix = (L == 0) ? 2 : (L == 1 ? 3 : (L == 2 ? 3 : 1));
  const float* s0 = ssq + (size_t)(3 * L) * M_ * 16;
  const float* s1 = s0 + (size_t)M_ * 16;
  const float* s2 = s1 + (size_t)M_ * 16;
  if (lp == 0 || lp == 4 + nmix) {
    const bool f2 = lp != 0;
    EpiFfn1 e;
    e.ssq = f2 ? s2 : s0;
    e.act = act;
    gemm_phase<2>((const bf16_t*)(ws + (f2 ? OFF_W2 : OFF_W1)), 2 * F_, xb, D_, D_, smem, e);
  } else if (lp == 1 || lp == 5 + nmix) {
    const bool f2 = lp != 1;
    EpiResid e;
    e.xin = (L == 0 && !f2 && !rep) ? inp(P, 0) : outp(P);
    e.xout = outp(P);
    e.xb = xb;
    e.ssqn = ssq + (size_t)(3 * L + (f2 ? 3 : 1)) * M_ * 16;
    e.scale = rep ? 0.f : 0.5f;
    gemm_phase<2>((const bf16_t*)(ws + (f2 ? OFF_W2D : OFF_W1D)), D_, act, F_, F_, smem, e);
  } else if (lp == 3 + nmix) {
    EpiResid e;
    e.xin = outp(P);
    e.xout = outp(P);
    e.xb = xb;
    e.ssqn = ssq + (size_t)(3 * L + 2) * M_ * 16;
    e.scale = rep ? 0.f : 1.f;
    gemm_phase<2>((const bf16_t*)(ws + OFF_WMO), D_, obuf, D_, D_, smem, e);
  } else if (lp == 2) {
    const bf16_t* wmi = (const bf16_t*)(ws + OFF_WMI);
    char* R = ws + OFF_R;
    if (L == 0 || L == 3) {
      EpiQKV e;
      e.ssq = s1;
      e.gq = inp(P, 10);
      e.gk = inp(P, 11);
      e.bfv = inp(P, 9);
      e.Q = (bf16_t*)R;
      e.K = (bf16_t*)(R + 64 * MiB);
      e.VT = (bf16_t*)(R + 128 * MiB);
      e.obuf = obuf;
      e.flog = (float*)(ws + OFF_FLOG);
      e.fox = (L == 0);
      gemm_phase<2>(wmi, L == 0 ? 4224 : 3072, xb, D_, D_, smem, e);
    } else if (L == 1) {
      EpiNSA e;
      e.ssq = s1;
      e.gq = inp(P, 18);
      e.gk = inp(P, 19);
      e.Q = (bf16_t*)R;
      e.KC = (bf16_t*)(R + 64 * MiB);
      e.KS = (bf16_t*)(R + 80 * MiB);
      e.KW = (bf16_t*)(R + 96 * MiB);
      e.VC = (bf16_t*)(R + 112 * MiB);
      e.VST = (bf16_t*)(R + 128 * MiB);
      e.VWT = (bf16_t*)(R + 144 * MiB);
      e.gates = (float*)(ws + OFF_GATES);
      gemm_phase<1>(wmi, 2688, xb, D_, D_, smem, e);
    } else {
      EpiGLA e;
      e.ssq = s1;
      e.QG = (bf16_t*)R;
      e.KG = (bf16_t*)(R + 32 * MiB);
      e.VTG = (bf16_t*)(R + 64 * MiB);
      e.obuf = obuf;
      e.glow = (float*)(ws + OFF_GLOW);
      gemm_phase<2>(wmi, 3200, xb, D_, D_, smem, e);
    }
  } else {
    const int mp = lp - 3;
    if (L == 0) {
      if (mp == 0) {
        fox_scan_phase(P, smem);
      }
      else {
        fox_attn_phase(P, smem, rep);
      }
    } else if (L == 1) {
      if (mp == 0) nsa_compress_phase(P, smem);
      else if (mp == 1) nsa_cmp_phase(P, smem);
      else {
        nsa_attn_phase(P, smem, rep);
      }
    } else if (L == 2) {
      if (mp == 0) gla_u_phase(P, smem);
      else if (mp == 1) gla_scan_phase(P, rep);
      else gla_out_phase(P, smem, rep);
    } else {
      sb_attn_phase(P, smem);
    }
  }
}

__global__ void __launch_bounds__(256, 2) mega_kernel(Params P, int ph_lo, int ph_hi) {
  __shared__ __attribute__((aligned(16))) char smem[57344];
  __shared__ __attribute__((aligned(16))) unsigned xbw[4];
  if (threadIdx.x == 0) { xbw[0] = 0u; xbw[1] = 0u; xbw[2] = 0u; xbw[3] = 0u; }
  __syncthreads();
  XcdBarrier xb = xcd_barrier_post((unsigned*)(P.ws + OFF_XBAR), (volatile LAS unsigned*)xbw);
  for (int ph = ph_lo; ph < ph_hi; ++ph) {
    run_phase(P, ph, smem, 0);
    if (ph + 1 < ph_hi) {
      if (ph == ph_lo) {
        asm volatile("s_waitcnt vmcnt(0)" ::: "memory");
        cg::this_grid().sync();
        __builtin_amdgcn_fence(__ATOMIC_ACQUIRE, "agent");
        asm volatile("s_waitcnt vmcnt(0)" ::: "memory");
        __syncthreads();
      } else {
        xcd_barrier(xb);
      }
    }
  }
}

extern "C" void kernel_launch(void* const* d_in, const int* in_sizes, int n_in, void* d_out, int out_size, void* d_ws,
                              size_t ws_size, hipStream_t stream) {
  static int grid_blocks = 0;
  if (!grid_blocks) {
    int dev = 0, cus = 0, per_cu = 0;
    hipGetDevice(&dev);
    hipDeviceGetAttribute(&cus, hipDeviceAttributeMultiprocessorCount, dev);
    hipOccupancyMaxActiveBlocksPerMultiprocessor(&per_cu, mega_kernel, 256, 0);
    if (per_cu > 2) per_cu = 2;
    if (per_cu < 1) per_cu = 1;
    grid_blocks = cus * per_cu;
  }
  Params p{};
  for (int i = 0; i < 28; ++i) p.in[i] = (const float*)d_in[i];
  p.out = (float*)d_out;
  p.ws = (char*)d_ws;
  hipMemsetAsync((char*)d_ws + OFF_XBAR, 0, XCD_BAR_WORDS * sizeof(unsigned), stream);
#if ONE_LAUNCH
  int lo = 0, hi = NPH_RUN;
  void* args[] = {&p, &lo, &hi};
  hipError_t e = hipLaunchCooperativeKernel((void*)mega_kernel, dim3(grid_blocks), dim3(256), args, 0, stream);
  if (e != hipSuccess) fprintf(stderr, "cooperative launch failed: %s (grid %d)\n", hipGetErrorString(e), grid_blocks);
#else
  for (int ph = 0; ph < NPH_RUN; ++ph) mega_kernel<<<grid_blocks, 256, 0, stream>>>(p, ph, ph + 1);
#endif
}
```

```cpp
#include <hip/hip_runtime.h>
#include <hip/hip_cooperative_groups.h>
#include <cstdio>
namespace cg = cooperative_groups;

#ifndef ONE_LAUNCH
#define ONE_LAUNCH 1
#endif

#define ABL 0
#ifndef NPH_RUN
#define NPH_RUN 37
#endif
#define DI __device__ __forceinline__
typedef unsigned short bf16_t;
typedef __attribute__((ext_vector_type(8))) short bf16x8;
typedef __attribute__((ext_vector_type(4))) short bf16x4;
typedef __attribute__((ext_vector_type(16))) float f32x16;
typedef __attribute__((ext_vector_type(2))) __bf16 bf2_t;
typedef __attribute__((ext_vector_type(4))) unsigned u32x4;
typedef __attribute__((ext_vector_type(2))) unsigned u32x2;
typedef __attribute__((ext_vector_type(4))) float f32x4;
DI int tidx() { int t = threadIdx.x; asm volatile("" : "+v"(t)); return t; }
DI int bidx() { int t = blockIdx.x; asm volatile("" : "+s"(t)); return t; }

#define MFMA(a, b, c) __builtin_amdgcn_mfma_f32_32x32x16_bf16((a), (b), (c), 0, 0, 0)

constexpr int S_ = 8192;
constexpr int M_ = 32768;
constexpr int D_ = 1024;
constexpr int F_ = 2816;
constexpr int NPH = 37;
constexpr size_t MiB = 1048576;
constexpr size_t OFF_W1 = 0, OFF_W1D = 11 * MiB, OFF_W2 = 17 * MiB, OFF_W2D = 28 * MiB, OFF_WMI = 34 * MiB,
                 OFF_WMO = 43 * MiB, OFF_WCK = 45 * MiB, OFF_WCV = 46 * MiB;
constexpr size_t OFF_XB = 48 * MiB, OFF_OBUF = 112 * MiB, OFF_SSQ = 460 * MiB, OFF_FLOG = 178 * MiB, OFF_C = 180 * MiB,
                 OFF_GATES = 182 * MiB, OFF_SEL = 188 * MiB, OFF_GLOW = 190 * MiB, OFF_DECAY = 192 * MiB,
                 OFF_KCMP = 193 * MiB, OFF_VCMPT = 194 * MiB, OFF_CBIAS = 195 * MiB, OFF_XBAR = 196 * MiB, OFF_R = 200 * MiB;

struct Params {
  const float* in[28];
  float* out;
  char* ws;
};

#define GAS __attribute__((address_space(1)))
DI const float* inp(const Params& P, int k) {
  asm volatile("" : "+s"(k));
  GAS const float* p = (GAS const float*)P.in[k];
  asm volatile("" : "+s"(p));
  return (const float*)p;
}
DI char* wsp(const Params& P) {
  GAS char* w = (GAS char*)P.ws;
  asm volatile("" : "+s"(w));
  return (char*)w;
}
DI float* outp(const Params& P) {
  GAS float* w = (GAS float*)P.out;
  asm volatile("" : "+s"(w));
  return (float*)w;
}
DI unsigned pack2(float a, float b) {
  bf2_t v;
  v[0] = (__bf16)a;
  v[1] = (__bf16)b;
  return __builtin_bit_cast(unsigned, v);
}
DI bf16_t f2bf(float a) { return (bf16_t)(pack2(a, 0.f) & 0xffffu); }
DI float bf2f(bf16_t v) { return __uint_as_float(((unsigned)v) << 16); }
DI float bflo(unsigned u) { return __uint_as_float(u << 16); }
DI float bfhi(unsigned u) { return __uint_as_float(u & 0xffff0000u); }
DI int crow(int i, int h) { return (i & 3) + 8 * (i >> 2) + 4 * h; }
DI float sigmoidf_(float x) { return __builtin_amdgcn_rcpf(1.f + __expf(-x)); }
DI float logsigmoidf_(float z) { return fminf(z, 0.f) - log1pf(__expf(-fabsf(z))); }
DI float row_rstd(const float* ssq, int m) {
  const f32x4* p = (const f32x4*)(ssq + (size_t)m * 16);
  f32x4 a = p[0], b = p[1], c = p[2], d = p[3];
  float s = a.x;
  s += a.y; s += a.z; s += a.w;
  s += b.x; s += b.y; s += b.z; s += b.w;
  s += c.x; s += c.y; s += c.z; s += c.w;
  s += d.x; s += d.y; s += d.z; s += d.w;
  return rsqrtf(s * (1.f / 1024.f) + 1e-6f);
}
DI void store4bf(bf16_t* p, float a, float b, float c, float d) {
  u32x2 u;
  u.x = pack2(a, b);
  u.y = pack2(c, d);
  *(u32x2*)p = u;
}
DI bf16x8 pack8(float a0, float a1, float a2, float a3, float a4, float a5, float a6, float a7) {
  u32x4 u;
  u.x = pack2(a0, a1);
  u.y = pack2(a2, a3);
  u.z = pack2(a4, a5);
  u.w = pack2(a6, a7);
  return __builtin_bit_cast(bf16x8, u);
}
DI bf16x8 cat4(bf16x4 lo, bf16x4 hi) { return __builtin_shufflevector(lo, hi, 0, 1, 2, 3, 4, 5, 6, 7); }
DI void zero16(f32x16& v) {
#pragma unroll
  for (int i = 0; i < 16; ++i) v[i] = 0.f;
}

template <int MH>
DI void gemm_tile(const bf16_t* Wg, int ldw, const bf16_t* Xg, int ldx, int K, bf16_t* sW, bf16_t* sX,
                  f32x16 (&acc)[MH][2][2]) {
  const int tid = tidx(), lane = tid & 63, wave = tid >> 6, wn = wave >> 1, wm = wave & 1, r = lane & 31,
            h = lane >> 5;
#pragma unroll
  for (int a = 0; a < MH; ++a)
#pragma unroll
    for (int b = 0; b < 2; ++b)
#pragma unroll
      for (int c = 0; c < 2; ++c) zero16(acc[a][b][c]);
  u32x4 rw[4], rx[4 * MH];
  const int nk = K >> 6;
  const int row0 = tid >> 3, cc = tid & 7;
  const bf16_t* wp = Wg + (size_t)row0 * ldw + cc * 8;
  const bf16_t* xp = Xg + (size_t)row0 * ldx + cc * 8;
#pragma unroll
  for (int i = 0; i < 4; ++i) rw[i] = *(const u32x4*)(wp + (size_t)(32 * i) * ldw);
#pragma unroll
  for (int i = 0; i < 4 * MH; ++i) rx[i] = *(const u32x4*)(xp + (size_t)(32 * i) * ldx);
  for (int kt = 0; kt < nk; ++kt) {
    __syncthreads();
#pragma unroll
    for (int i = 0; i < 4; ++i) *(u32x4*)(sW + (row0 + 32 * i) * 72 + cc * 8) = rw[i];
#pragma unroll
    for (int i = 0; i < 4 * MH; ++i) *(u32x4*)(sX + (row0 + 32 * i) * 72 + cc * 8) = rx[i];
    __syncthreads();
    if (kt + 1 < nk) {
      const int k0 = (kt + 1) * 64;
#pragma unroll
      for (int i = 0; i < 4; ++i) rw[i] = *(const u32x4*)(wp + (size_t)(32 * i) * ldw + k0);
#pragma unroll
      for (int i = 0; i < 4 * MH; ++i) rx[i] = *(const u32x4*)(xp + (size_t)(32 * i) * ldx + k0);
    }
    __builtin_amdgcn_sched_barrier(0);
#pragma unroll
    for (int kk = 0; kk < 4; ++kk) {
      bf16x8 a0 = *(const bf16x8*)(sW + (wn * 64 + r) * 72 + kk * 16 + h * 8);
      bf16x8 a1 = *(const bf16x8*)(sW + (wn * 64 + 32 + r) * 72 + kk * 16 + h * 8);
#pragma unroll
      for (int mq = 0; mq < 2 * MH; ++mq) {
        bf16x8 b = *(const bf16x8*)(sX + (wm * 64 * MH + mq * 32 + r) * 72 + kk * 16 + h * 8);
        acc[mq >> 1][0][mq & 1] = MFMA(a0, b, acc[mq >> 1][0][mq & 1]);
        acc[mq >> 1][1][mq & 1] = MFMA(a1, b, acc[mq >> 1][1][mq & 1]);
      }
    }
  }
}

template <int MH, class Epi>
DI void gemm_phase(const bf16_t* Wt, int Npad, const bf16_t* X, int ldx, int K, char* smem, const Epi& epi) {
  bf16_t* sW = (bf16_t*)smem;
  bf16_t* sX = sW + 128 * 72;
  const int NT = Npad >> 7, MT = M_ / (128 * MH);
  const int wave = tidx() >> 6, wn = wave >> 1, wm = wave & 1;
  const int nblk = gridDim.x;
  const int lb = ((nblk & 7) == 0) ? ((bidx() & 7) * (nblk >> 3) + (bidx() >> 3)) : bidx();
  const bool part2d = ((nblk & 7) == 0) && (NT >= 16) && ((MT & 1) == 0);
  const int xg = bidx() & 7, nper = NT >> 2, mper = MT >> 1;
  const int lenA = nper * mper, nleft = (NT - 4 * nper) * MT;
  const int lenB = (nleft > xg) ? ((nleft - xg + 7) >> 3) : 0;
  const int q0 = part2d ? (bidx() >> 3) : lb, qstep = part2d ? (nblk >> 3) : nblk, qend = part2d ? lenA + lenB : NT * MT;
  for (int t = q0; t < qend; t += qstep) {
    int nt, mt;
    if (part2d) {
      if (t < lenA) {
        nt = (xg >> 1) * nper + t % nper;
        mt = (xg & 1) * mper + t / nper;
      } else {
        const int u = (t - lenA) * 8 + xg;
        nt = 4 * nper + u / MT;
        mt = u % MT;
      }
    } else {
      nt = t % NT;
      mt = t / NT;
    }
    f32x16 acc[MH][2][2];
    gemm_tile<MH>(Wt + (size_t)nt * 128 * K, K, X + (size_t)mt * 128 * MH * ldx, ldx, K, sW, sX, acc);
#pragma unroll
    for (int mh = 0; mh < MH; ++mh) epi(acc[mh], nt * 128 + wn * 64, mt * 128 * MH + wm * 64 * MH + mh * 64);
  }
}

struct EpiFfn1 {
  const float* ssq;
  bf16_t* act;
  DI void operator()(f32x16 (&acc)[2][2], int nb, int mb) const {
    const int lane = tidx() & 63, r = lane & 31, h = lane >> 5;
    const int jb = (nb >> 6) * 32;
#pragma unroll
    for (int mi = 0; mi < 2; ++mi) {
      const int m = mb + mi * 32 + r;
      const float rstd = row_rstd(ssq, m);
#pragma unroll
      for (int a = 0; a < 4; ++a) {
        float v[4];
#pragma unroll
        for (int q = 0; q < 4; ++q) {
          float g = acc[0][mi][4 * a + q] * rstd, u = acc[1][mi][4 * a + q] * rstd;
          v[q] = g * sigmoidf_(g) * u;
        }
        store4bf(act + (size_t)m * F_ + jb + 8 * a + 4 * h, v[0], v[1], v[2], v[3]);
      }
    }
  }
};

struct EpiResid {
  const float* xin;
  float* xout;
  bf16_t* xb;
  float* ssqn;
  float scale;
  DI void operator()(f32x16 (&acc)[2][2], int nb, int mb) const {
    const int lane = tidx() & 63, r = lane & 31, h = lane >> 5;
#pragma unroll
    for (int mi = 0; mi < 2; ++mi) {
      const int m = mb + mi * 32 + r;
      float part = 0.f;
#pragma unroll
      for (int ni = 0; ni < 2; ++ni)
#pragma unroll
        for (int a = 0; a < 4; ++a) {
          const int n = nb + ni * 32 + 8 * a + 4 * h;
          f32x4 xi = *(const f32x4*)(xin + (size_t)m * D_ + n);
          f32x4 xo;
          xo.x = xi.x + scale * acc[ni][mi][4 * a + 0];
          xo.y = xi.y + scale * acc[ni][mi][4 * a + 1];
          xo.z = xi.z + scale * acc[ni][mi][4 * a + 2];
          xo.w = xi.w + scale * acc[ni][mi][4 * a + 3];
          *(f32x4*)(xout + (size_t)m * D_ + n) = xo;
          store4bf(xb + (size_t)m * D_ + n, xo.x, xo.y, xo.z, xo.w);
          part += xo.x * xo.x + xo.y * xo.y + xo.z * xo.z + xo.w * xo.w;
        }
      part += __shfl_xor(part, 32);
      if (h == 0) ssqn[(size_t)m * 16 + (nb >> 6)] = part;
    }
  }
};

struct EpiQKV {
  const float* ssq;
  const float* gq;
  const float* gk;
  const float* bfv;
  bf16_t* Q;
  bf16_t* K;
  bf16_t* VT;
  bf16_t* obuf;
  float* flog;
  int fox;
  DI void operator()(f32x16 (&acc)[2][2], int nb, int mb) const {
    const int lane = tidx() & 63, r = lane & 31, h = lane >> 5;
#pragma unroll
    for (int mi = 0; mi < 2; ++mi) {
      const int m = mb + mi * 32 + r, b = m >> 13, t = m & 8191;
      const float rstd = row_rstd(ssq, m);
      if (nb < 2048) {
        const int isk = nb >= 1024, hh = (nb & 1023) >> 6;
        float v[2][16];
        float ss = 0.f;
#pragma unroll
        for (int ni = 0; ni < 2; ++ni)
#pragma unroll
          for (int i = 0; i < 16; ++i) {
            v[ni][i] = acc[ni][mi][i] * rstd;
            ss += v[ni][i] * v[ni][i];
          }
        if (fox) {
          ss += __shfl_xor(ss, 32);
          const float rinv = rsqrtf(ss * (1.f / 64.f) + 1e-6f);
          const float* g = isk ? gk : gq;
#pragma unroll
          for (int ni = 0; ni < 2; ++ni)
#pragma unroll
            for (int i = 0; i < 16; ++i) v[ni][i] *= rinv * g[ni * 32 + crow(i, h)];
        }
        bf16_t* dst = (isk ? K : Q) + ((size_t)(b * 16 + hh) * S_ + t) * 64;
#pragma unroll
        for (int ni = 0; ni < 2; ++ni)
#pragma unroll
          for (int a = 0; a < 4; ++a)
            store4bf(dst + ni * 32 + 8 * a + 4 * h, v[ni][4 * a], v[ni][4 * a + 1], v[ni][4 * a + 2], v[ni][4 * a + 3]);
      } else if (nb < 3072) {
        const int hh = (nb - 2048) >> 6;
#pragma unroll
        for (int ni = 0; ni < 2; ++ni)
#pragma unroll
          for (int i = 0; i < 16; ++i) {
            const int d = ni * 32 + crow(i, h);
            VT[((size_t)(b * 16 + hh) * 64 + d) * S_ + t] = f2bf(acc[ni][mi][i] * rstd);
          }
      } else if (fox && nb < 4096) {
        const int hh = (nb - 3072) >> 6;
#pragma unroll
        for (int ni = 0; ni < 2; ++ni)
#pragma unroll
          for (int a = 0; a < 4; ++a)
            store4bf(obuf + (size_t)m * D_ + hh * 64 + ni * 32 + 8 * a + 4 * h, sigmoidf_(acc[ni][mi][4 * a] * rstd),
                     sigmoidf_(acc[ni][mi][4 * a + 1] * rstd), sigmoidf_(acc[ni][mi][4 * a + 2] * rstd),
                     sigmoidf_(acc[ni][mi][4 * a + 3] * rstd));
      } else if (fox && nb == 4096) {
#pragma unroll
        for (int i = 0; i < 8; ++i) {
          const int hh = crow(i, h);
          flog[(size_t)(b * 16 + hh) * S_ + t] = logsigmoidf_(acc[0][mi][i] * rstd + bfv[hh]);
        }
      }
    }
  }
};

struct EpiNSA {
  const float* ssq;
  const float* gq;
  const float* gk;
  bf16_t* Q;
  bf16_t* KC;
  bf16_t* KS;
  bf16_t* KW;
  bf16_t* VC;
  bf16_t* VST;
  bf16_t* VWT;
  float* gates;
  DI void operator()(f32x16 (&acc)[2][2], int nb, int mb) const {
    const int lane = tidx() & 63, r = lane & 31, h = lane >> 5;
    if (nb > 2560) return;
#pragma unroll
    for (int mi = 0; mi < 2; ++mi) {
      const int m = mb + mi * 32 + r, b = m >> 13, t = m & 8191;
      const float rstd = row_rstd(ssq, m);
      if (nb == 2560) {
#pragma unroll
        for (int ni = 0; ni < 2; ++ni)
#pragma unroll
          for (int i = 0; i < 16; ++i) {
            const int nl = ni * 32 + crow(i, h);
            if (nl < 48) gates[(size_t)m * 48 + nl] = sigmoidf_(acc[ni][mi][i] * rstd);
          }
        continue;
      }
      int seg = -1, hh;
      if (nb < 1024) {
        hh = nb >> 6;
      } else {
        seg = (nb - 1024) >> 8;
        hh = ((nb - 1024) & 255) >> 6;
      }
      const int kv = b * 4 + hh;
      if (seg == 1) {
        bf16_t* dst = VC + ((size_t)kv * S_ + t) * 64;
#pragma unroll
        for (int ni = 0; ni < 2; ++ni)
#pragma unroll
          for (int a = 0; a < 4; ++a)
            store4bf(dst + ni * 32 + 8 * a + 4 * h, acc[ni][mi][4 * a] * rstd, acc[ni][mi][4 * a + 1] * rstd,
                     acc[ni][mi][4 * a + 2] * rstd, acc[ni][mi][4 * a + 3] * rstd);
      } else if (seg == 3 || seg == 5) {
        bf16_t* dst = (seg == 3 ? VST : VWT);
#pragma unroll
        for (int ni = 0; ni < 2; ++ni)
#pragma unroll
          for (int i = 0; i < 16; ++i) {
            const int d = ni * 32 + crow(i, h);
            dst[((size_t)kv * 64 + d) * S_ + t] = f2bf(acc[ni][mi][i] * rstd);
          }
      } else {
        float v[2][16];
        float ss = 0.f;
#pragma unroll
        for (int ni = 0; ni < 2; ++ni)
#pragma unroll
          for (int i = 0; i < 16; ++i) {
            v[ni][i] = acc[ni][mi][i] * rstd;
            ss += v[ni][i] * v[ni][i];
          }
        ss += __shfl_xor(ss, 32);
        const float rinv = rsqrtf(ss * (1.f / 64.f) + 1e-6f);
        const float* g = (seg < 0) ? gq : gk;
        const float tf = (float)t;
#pragma unroll
        for (int i = 0; i < 16; ++i) {
          const int fi = crow(i, h);
          const float x1 = v[0][i] * rinv * g[fi], x2 = v[1][i] * rinv * g[32 + fi];
          const float inv = exp2f(-(float)fi * 0.41524101186092034f);
          const float ang = tf * inv;
          const float Chi = 0.15915494f, Clo = 6.4206383e-9f;
          const float p = ang * Chi;
          const float e = __builtin_fmaf(ang, Chi, -p);
          const float fr = (p - floorf(p)) + (e + ang * Clo);
          const float sn = __builtin_amdgcn_sinf(fr), cs = __builtin_amdgcn_cosf(fr);
          v[0][i] = x1 * cs - x2 * sn;
          v[1][i] = x2 * cs + x1 * sn;
          if ((i & 1) == 1) __builtin_amdgcn_sched_barrier(0);
        }
        bf16_t* dst;
        if (seg < 0)
          dst = Q + ((size_t)(b * 16 + hh) * S_ + t) * 64;
        else
          dst = (seg == 0 ? KC : (seg == 2 ? KS : KW)) + ((size_t)kv * S_ + t) * 64;
#pragma unroll
        for (int ni = 0; ni < 2; ++ni)
#pragma unroll
          for (int a = 0; a < 4; ++a)
            store4bf(dst + ni * 32 + 8 * a + 4 * h, v[ni][4 * a], v[ni][4 * a + 1], v[ni][4 * a + 2], v[ni][4 * a + 3]);
      }
    }
  }
};

struct EpiGLA {
  const float* ssq;
  bf16_t* QG;
  bf16_t* KG;
  bf16_t* VTG;
  bf16_t* obuf;
  float* glow;
  DI void operator()(f32x16 (&acc)[2][2], int nb, int mb) const {
    const int lane = tidx() & 63, r = lane & 31, h = lane >> 5;
    if (nb > 3072) return;
#pragma unroll
    for (int mi = 0; mi < 2; ++mi) {
      const int m = mb + mi * 32 + r, b = m >> 13, t = m & 8191;
      const float rstd = row_rstd(ssq, m);
      if (nb < 1024) {
        bf16_t* dst = (nb < 512 ? QG + (size_t)m * 512 + nb : KG + (size_t)m * 512 + (nb - 512));
#pragma unroll
        for (int ni = 0; ni < 2; ++ni)
#pragma unroll
          for (int a = 0; a < 4; ++a)
            store4bf(dst + ni * 32 + 8 * a + 4 * h, acc[ni][mi][4 * a] * rstd, acc[ni][mi][4 * a + 1] * rstd,
                     acc[ni][mi][4 * a + 2] * rstd, acc[ni][mi][4 * a + 3] * rstd);
      } else if (nb < 2048) {
#pragma unroll
        for (int ni = 0; ni < 2; ++ni)
#pragma unroll
          for (int i = 0; i < 16; ++i) {
            const int e = nb - 1024 + ni * 32 + crow(i, h);
            VTG[((size_t)b * 1024 + e) * S_ + t] = f2bf(acc[ni][mi][i] * rstd);
          }
      } else if (nb < 3072) {
#pragma unroll
        for (int ni = 0; ni < 2; ++ni)
#pragma unroll
          for (int a = 0; a < 4; ++a) {
            float v[4];
#pragma unroll
            for (int q = 0; q < 4; ++q) {
              float z = acc[ni][mi][4 * a + q] * rstd;
              v[q] = z * sigmoidf_(z);
            }
            store4bf(obuf + (size_t)m * D_ + (nb - 2048) + ni * 32 + 8 * a + 4 * h, v[0], v[1], v[2], v[3]);
          }
      } else {
#pragma unroll
        for (int i = 0; i < 8; ++i) glow[(size_t)m * 16 + crow(i, h)] = acc[0][mi][i] * rstd;
      }
    }
  }
};

struct EpiCmp {
  const float* cb;
  const float* gk;
  bf16_t* dst;
  int isv;
  DI void operator()(f32x16 (&acc)[2][2], int nb, int mb) const {
    const int lane = tidx() & 63, r = lane & 31, h = lane >> 5;
    if (nb != 0) return;
#pragma unroll
    for (int mi = 0; mi < 2; ++mi) {
      const int n = mb + mi * 32 + r;
      const bool ok = n < 511;
      float v[2][16];
      float ss = 0.f;
#pragma unroll
      for (int ni = 0; ni < 2; ++ni)
#pragma unroll
        for (int i = 0; i < 16; ++i) {
          v[ni][i] = ok ? acc[ni][mi][i] + cb[ni * 32 + crow(i, h)] : 0.f;
          ss += v[ni][i] * v[ni][i];
        }
      if (!isv) {
        ss += __shfl_xor(ss, 32);
        const float rinv = rsqrtf(ss * (1.f / 64.f) + 1e-6f);
#pragma unroll
        for (int ni = 0; ni < 2; ++ni)
#pragma unroll
          for (int a = 0; a < 4; ++a) {
            const int e = ni * 32 + 8 * a + 4 * h;
            store4bf(dst + (size_t)n * 64 + e, v[ni][4 * a] * rinv * gk[e], v[ni][4 * a + 1] * rinv * gk[e + 1],
                     v[ni][4 * a + 2] * rinv * gk[e + 2], v[ni][4 * a + 3] * rinv * gk[e + 3]);
          }
      } else {
#pragma unroll
        for (int ni = 0; ni < 2; ++ni)
#pragma unroll
          for (int i = 0; i < 16; ++i) dst[(size_t)(ni * 32 + crow(i, h)) * 512 + n] = f2bf(v[ni][i]);
      }
    }
  }
};

DI f32x4 ld4(const float* p) { return *(const f32x4*)p; }
DI f32x4 zero4() { return f32x4{0.f, 0.f, 0.f, 0.f}; }
template <class Src4>
DI void prep_job(bf16_t* dst, int Npad, int K, float* sT, Src4 src) {
  const int tid = tidx();
  const int NT = Npad >> 6, KT = K >> 6;
  for (int t = bidx(); t < NT * KT; t += gridDim.x) {
    const int nt = t % NT, kt = t / NT;
    __syncthreads();
#pragma unroll
    for (int i = 0; i < 4; ++i) {
      const int e = tid + 256 * i, kk = e >> 4, n4 = (e & 15) << 2;
      const f32x4 v = src(kt * 64 + kk, nt * 64 + n4);
      float* d = sT + kk * 65 + n4;
      d[0] = v.x;
      d[1] = v.y;
      d[2] = v.z;
      d[3] = v.w;
    }
    __syncthreads();
#pragma unroll
    for (int i = 0; i < 2; ++i) {
      const int e = tid + 256 * i, nn = e >> 3, kq = e & 7;
      const float* p = sT + (kq * 8) * 65 + nn;
      u32x4 o;
      o.x = pack2(p[0], p[65]);
      o.y = pack2(p[130], p[195]);
      o.z = pack2(p[260], p[325]);
      o.w = pack2(p[390], p[455]);
      *(u32x4*)(dst + (size_t)(nt * 64 + nn) * K + kt * 64 + kq * 8) = o;
    }
  }
}

DI void prep_layer(const Params& P, int L, char* smem) {
  float* sT = (float*)smem;
  char* ws = wsp(P);
  const float* ng = inp(P, 1) + (size_t)L * 3 * D_;
  for (int f = 0; f < 2; ++f) {
    const float* wg = inp(P, f ? 5 : 2) + (size_t)L * D_ * F_;
    const float* wu = inp(P, f ? 6 : 3) + (size_t)L * D_ * F_;
    const float* wd = inp(P, f ? 7 : 4) + (size_t)L * D_ * F_;
    const float* g = ng + (f ? 2 * D_ : 0);
    prep_job((bf16_t*)(ws + (f ? OFF_W2 : OFF_W1)), 2 * F_, D_, sT, [=](int k, int n) {
      const int grp = n >> 6, rr = n & 63;
      const float* s = rr < 32 ? wg : wu;
      return ld4(s + (size_t)k * F_ + grp * 32 + (rr & 31)) * g[k];
    });
    prep_job((bf16_t*)(ws + (f ? OFF_W2D : OFF_W1D)), D_, F_, sT, [=](int k, int n) { return ld4(wd + (size_t)k * D_ + n); });
  }
  const float* g1 = ng + D_;
  bf16_t* wmi = (bf16_t*)(ws + OFF_WMI);
  bf16_t* wmo = (bf16_t*)(ws + OFF_WMO);
  if (L == 0) {
    const float* w = inp(P, 8);
    prep_job(wmi, 4224, D_, sT, [=](int k, int n) {
      const int c = n < 3072 ? n : (n < 4096 ? n + 16 : (n < 4112 ? n - 1024 : -1));
      return c < 0 ? zero4() : ld4(w + (size_t)k * 4112 + c) * g1[k];
    });
    const float* wo = inp(P, 12);
    prep_job(wmo, D_, D_, sT, [=](int k, int n) { return ld4(wo + (size_t)k * D_ + n); });
  } else if (L == 1) {
    const float* w = inp(P, 13);
    prep_job(wmi, 2688, D_, sT, [=](int k, int n) { return n < 2608 ? ld4(w + (size_t)k * 2608 + n) * g1[k] : zero4(); });
    const float* wo = inp(P, 20);
    prep_job(wmo, D_, D_, sT, [=](int k, int n) { return ld4(wo + (size_t)k * D_ + n); });
    const float* wck = inp(P, 16);
    const float* wcv = inp(P, 17);
    prep_job((bf16_t*)(ws + OFF_WCK), 128, 2048, sT, [=](int k, int n) { return n < 64 ? ld4(wck + (size_t)k * 64 + n) : zero4(); });
    prep_job((bf16_t*)(ws + OFF_WCV), 128, 2048, sT, [=](int k, int n) { return n < 64 ? ld4(wcv + (size_t)k * 64 + n) : zero4(); });
    if (bidx() == 0 && tidx() < 128) {
      const int e = tidx() & 63, which = tidx() >> 6;
      const float* pos = which ? inp(P, 15) : inp(P, 14);
      const float* wc = which ? inp(P, 17) : inp(P, 16);
      float s = 0.f;
      for (int kd = 0; kd < 2048; ++kd) s += pos[kd] * wc[(size_t)kd * 64 + e];
      ((float*)(ws + OFF_CBIAS))[which * 64 + e] = s;
    }
  } else if (L == 2) {
    const float* w = inp(P, 21);
    prep_job(wmi, 3200, D_, sT, [=](int k, int n) {
      const int c = n < 2048 ? n : (n < 3072 ? n + 16 : (n < 3088 ? n - 1024 : -1));
      return c < 0 ? zero4() : ld4(w + (size_t)k * 3088 + c) * g1[k];
    });
    const float* wo = inp(P, 25);
    prep_job(wmo, D_, D_, sT, [=](int k, int n) { return ld4(wo + (size_t)k * D_ + n); });
  } else {
    const float* w = inp(P, 26);
    prep_job(wmi, 3072, D_, sT, [=](int k, int n) { return ld4(w + (size_t)k * 3072 + n) * g1[k]; });
    const float* wo = inp(P, 27);
    prep_job(wmo, D_, D_, sT, [=](int k, int n) { return ld4(wo + (size_t)k * D_ + n); });
  }
}

DI void init_phase(const Params& P) {
  const int tid = tidx(), lane = tid & 63, wave = tid >> 6;
  float* ssq = (float*)(wsp(P) + OFF_SSQ);
  bf16_t* xb = (bf16_t*)(wsp(P) + OFF_XB);
  const float* x = inp(P, 0);
  for (int row = bidx() * 4 + wave; row < M_; row += gridDim.x * 4) {
    float s = 0.f;
#pragma unroll
    for (int i = 0; i < 4; ++i) {
      const int c = (i * 64 + lane) * 4;
      f32x4 v = *(const f32x4*)(x + (size_t)row * D_ + c);
      s += v.x * v.x + v.y * v.y + v.z * v.z + v.w * v.w;
      store4bf(xb + (size_t)row * D_ + c, v.x, v.y, v.z, v.w);
    }
#pragma unroll
    for (int o = 32; o >= 1; o >>= 1) s += __shfl_xor(s, o);
    if (lane < 16) ssq[(size_t)row * 16 + lane] = (lane == 0) ? s : 0.f;
  }
}

struct AttnSmem {
  bf16_t k[64 * 72];
  bf16_t v[64 * 72];
  float c[64];
};

DI void attn_load(const bf16_t* Kb, int ldk, const bf16_t* VTb, int ldv, int j, u32x4 (&kr)[2], u32x4 (&vr)[2]) {
  const int tid = tidx();
#pragma unroll
  for (int i = 0; i < 2; ++i) {
    const int c = tid + 256 * i, row = c >> 3, cc = c & 7;
    kr[i] = *(const u32x4*)(Kb + (size_t)(j * 64 + row) * ldk + cc * 8);
    vr[i] = *(const u32x4*)(VTb + (size_t)row * ldv + j * 64 + cc * 8);
  }
}
DI void attn_store(AttnSmem& sm, const u32x4 (&kr)[2], const u32x4 (&vr)[2]) {
  const int tid = tidx();
#pragma unroll
  for (int i = 0; i < 2; ++i) {
    const int c = tid + 256 * i, row = c >> 3, cc = c & 7;
    *(u32x4*)(sm.k + row * 72 + cc * 8) = kr[i];
    *(u32x4*)(sm.v + row * 72 + cc * 8) = vr[i];
  }
}
DI void attn_qk(const AttnSmem& sm, const bf16x8 (&qf)[4], f32x16 (&st)[2]) {
  const int lane = tidx() & 63, r = lane & 31, h = lane >> 5;
#pragma unroll
  for (int kt = 0; kt < 2; ++kt) {
    zero16(st[kt]);
#pragma unroll
    for (int kk = 0; kk < 4; ++kk) {
      bf16x8 a = *(const bf16x8*)(sm.k + (kt * 32 + r) * 72 + kk * 16 + h * 8);
      st[kt] = MFMA(a, qf[kk], st[kt]);
    }
  }
}
DI void attn_pv(const AttnSmem& sm, const f32x16 (&st)[2], f32x16 (&o)[2]) {
  const int lane = tidx() & 63, r = lane & 31, h = lane >> 5;
#pragma unroll
  for (int kt = 0; kt < 2; ++kt)
#pragma unroll
    for (int s2 = 0; s2 < 2; ++s2) {
      bf16x8 pk = pack8(st[kt][8 * s2], st[kt][8 * s2 + 1], st[kt][8 * s2 + 2], st[kt][8 * s2 + 3], st[kt][8 * s2 + 4],
                        st[kt][8 * s2 + 5], st[kt][8 * s2 + 6], st[kt][8 * s2 + 7]);
#pragma unroll
      for (int dt = 0; dt < 2; ++dt) {
        const bf16_t* p = sm.v + (dt * 32 + r) * 72 + kt * 32 + 16 * s2 + 4 * h;
        bf16x8 a = cat4(*(const bf16x4*)p, *(const bf16x4*)(p + 8));
        o[dt] = MFMA(a, pk, o[dt]);
      }
    }
}
DI void load_qf(const bf16_t* Qrow, bf16x8 (&qf)[4]) {
  const int h = (tidx() & 63) >> 5;
#pragma unroll
  for (int kk = 0; kk < 4; ++kk) qf[kk] = *(const bf16x8*)(Qrow + kk * 16 + h * 8);
}

template <int MODE>
DI void flash_pass(const bf16_t* Kb, const bf16_t* VTb, const float* cB, float cq, u32x4 selw, int qw, int jlo, int jhi,
                   const bf16x8 (&qf)[4], f32x16 (&o)[2], float& lsum, AttnSmem& sm) {
  const int tid = tidx(), lane = tid & 63, r = lane & 31, h = lane >> 5;
  const int query = qw + r;
  float m_run = -1e30f, l_run = 0.f;
  zero16(o[0]);
  zero16(o[1]);
  u32x4 kr[2], vr[2];
  float cr = 0.f;
  attn_load(Kb, 64, VTb, S_, jlo, kr, vr);
  if (MODE == 0 && tid < 64) cr = cB[jlo * 64 + tid];
  for (int j = jlo; j <= jhi; ++j) {
    __syncthreads();
    attn_store(sm, kr, vr);
    if (MODE == 0 && tid < 64) sm.c[tid] = cr;
    __syncthreads();
    if (j < jhi) {
      attn_load(Kb, 64, VTb, S_, j + 1, kr, vr);
      if (MODE == 0 && tid < 64) cr = cB[(j + 1) * 64 + tid];
    }
    bool active = (j * 64 <= qw + 31);
    bool bit = true;
    if (MODE == 1) active = active && (j * 64 + 63 >= qw - 511);
    if (MODE == 2) {
      const int wi = j >> 5;
      const unsigned w = wi == 0 ? selw.x : (wi == 1 ? selw.y : (wi == 2 ? selw.z : selw.w));
      bit = (w >> (j & 31)) & 1u;
      active = active && (__ballot(bit) != 0ull);
    }
    if (active) {
      f32x16 st[2];
      attn_qk(sm, qf, st);
      const float SC = 0.125f * 1.4426950408889634f;
      const bool interior = (MODE != 0) && (j * 64 + 63 <= qw) && (MODE != 1 || (qw + 31 - j * 64 < 512));
      float mx = -1e30f;
      if (interior) {
#pragma unroll
        for (int kt = 0; kt < 2; ++kt)
#pragma unroll
          for (int i = 0; i < 16; ++i) {
            const float s = st[kt][i] * SC;
            st[kt][i] = s;
            mx = fmaxf(mx, s);
          }
        if (MODE == 2 && !bit) mx = -1e30f;
      } else {
#pragma unroll
        for (int kt = 0; kt < 2; ++kt)
#pragma unroll
          for (int i = 0; i < 16; ++i) {
            const int kl = kt * 32 + crow(i, h);
            const int key = j * 64 + kl;
            float s = st[kt][i] * SC;
            bool ok = key <= query;
            if (MODE == 0) s += (cq - sm.c[kl]) * 1.4426950408889634f;
            if (MODE == 1) ok = ok && (query - key < 512);
            if (MODE == 2) ok = ok && bit;
            s = ok ? s : -1e30f;
            st[kt][i] = s;
            mx = fmaxf(mx, s);
          }
      }
      mx = fmaxf(mx, __shfl_xor(mx, 32));
      const float m_new = fmaxf(m_run, mx);
      const float alpha = __builtin_amdgcn_exp2f(m_run - m_new);
      float ps = 0.f;
      if (interior) {
#pragma unroll
        for (int kt = 0; kt < 2; ++kt)
#pragma unroll
          for (int i = 0; i < 16; ++i) {
            float p = __builtin_amdgcn_exp2f(st[kt][i] - m_new);
            if (MODE == 2) p = bit ? p : 0.f;
            st[kt][i] = p;
            ps += p;
          }
      } else {
#pragma unroll
        for (int kt = 0; kt < 2; ++kt)
#pragma unroll
          for (int i = 0; i < 16; ++i) {
            const float s = st[kt][i];
            const float p = (s > -1e29f) ? __builtin_amdgcn_exp2f(s - m_new) : 0.f;
            st[kt][i] = p;
            ps += p;
          }
      }
      ps += __shfl_xor(ps, 32);
      l_run = l_run * alpha + ps;
      if (__ballot(m_new > m_run) != 0ull) {
#pragma unroll
        for (int dt = 0; dt < 2; ++dt)
#pragma unroll
          for (int i = 0; i < 16; ++i) o[dt][i] *= alpha;
      }
      m_run = m_new;
      attn_pv(sm, st, o);
    }
  }
  lsum = l_run;
}

DI void fox_pass(const bf16_t* Kb, const bf16_t* VTb, const float* cB, float cq, float sbound, int qw, int jhi,
                 const bf16x8 (&qf)[4], f32x16 (&o)[2], float& lsum, AttnSmem& sm) {
  const int tid = tidx(), lane = tid & 63, r = lane & 31, h = lane >> 5;
  const int query = qw + r;
  float m_run = -1e30f, l_run = 0.f;
  zero16(o[0]);
  zero16(o[1]);
  u32x4 kr[2], vr[2];
  float cr = 0.f;
  int done = 0;
  attn_load(Kb, 64, VTb, S_, jhi, kr, vr);
  if (tid < 64) cr = cB[jhi * 64 + tid];
  for (int j = jhi; j >= 0; --j) {
    if (__syncthreads_and(done)) break;
    attn_store(sm, kr, vr);
    if (tid < 64) sm.c[tid] = cr;
    __syncthreads();
    if (j > 0) {
      attn_load(Kb, 64, VTb, S_, j - 1, kr, vr);
      if (tid < 64) cr = cB[(j - 1) * 64 + tid];
    }
    if (j * 64 <= qw + 31) {
      f32x16 st[2];
      attn_qk(sm, qf, st);
      float mx = -1e30f;
#pragma unroll
      for (int kt = 0; kt < 2; ++kt)
#pragma unroll
        for (int i = 0; i < 16; ++i) {
          const int kl = kt * 32 + crow(i, h);
          const int key = j * 64 + kl;
          float s = st[kt][i] * 0.125f + (cq - sm.c[kl]);
          s = (key <= query) ? s : -1e30f;
          st[kt][i] = s;
          mx = fmaxf(mx, s);
        }
      mx = fmaxf(mx, __shfl_xor(mx, 32));
      const float m_new = fmaxf(m_run, mx);
      const float alpha = __expf(m_run - m_new);
      float ps = 0.f;
#pragma unroll
      for (int kt = 0; kt < 2; ++kt)
#pragma unroll
        for (int i = 0; i < 16; ++i) {
          const float s = st[kt][i];
          const float p = (s > -1e29f) ? __expf(s - m_new) : 0.f;
          st[kt][i] = p;
          ps += p;
        }
      ps += __shfl_xor(ps, 32);
      l_run = l_run * alpha + ps;
      m_run = m_new;
#pragma unroll
      for (int dt = 0; dt < 2; ++dt)
#pragma unroll
        for (int i = 0; i < 16; ++i) o[dt][i] *= alpha;
      attn_pv(sm, st, o);
      done = (sbound + cq - sm.c[0] < m_run - 104.f) ? 1 : 0;
    }
  }
  lsum = l_run;
}
DI void fox_scan_phase(const Params& P, char* smem) {
  double* sp = (double*)smem;
  const float* flog = (const float*)(wsp(P) + OFF_FLOG);
  float* c = (float*)(wsp(P) + OFF_C);
  const int tid = tidx();
  for (int seq = bidx(); seq < 64; seq += gridDim.x) {
    const float* src = flog + (size_t)seq * S_ + tid * 32;
    double tot = 0.0;
    for (int i = 0; i < 32; ++i) tot += (double)src[i];
    __syncthreads();
    sp[tid] = tot;
    __syncthreads();
    double pre = 0.0;
    for (int i = 0; i < tid; ++i) pre += sp[i];
    float* dst = c + (size_t)seq * S_ + tid * 32;
    for (int i = 0; i < 32; ++i) {
      pre += (double)src[i];
      dst[i] = (float)pre;
    }
  }
}

DI void fox_attn_phase(const Params& P, char* smem, int rep) {
  AttnSmem& sm = *(AttnSmem*)smem;
  const bf16_t* Q = (const bf16_t*)(wsp(P) + OFF_R);
  const bf16_t* K = Q + (size_t)M_ * D_;
  const bf16_t* VT = K + (size_t)M_ * D_;
  const float* c = (const float*)(wsp(P) + OFF_C);
  bf16_t* obuf = (bf16_t*)(wsp(P) + OFF_OBUF);
  const int lane = tidx() & 63, wave = tidx() >> 6, r = lane & 31, h = lane >> 5;
  float gqm = 0.f, gkm = 0.f;
  for (int d = 0; d < 64; ++d) {
    gqm = fmaxf(gqm, fabsf(inp(P, 10)[d]));
    gkm = fmaxf(gkm, fabsf(inp(P, 11)[d]));
  }
  const float sbound = 8.16f * gqm * gkm;
  for (int it = bidx(); it < 4096; it += gridDim.x) {
    const int qt = 63 - (it >> 6), bh = it & 63;
    const int q0 = qt * 128, qw = q0 + wave * 32, query = qw + r;
    bf16x8 qf[4];
    load_qf(Q + ((size_t)bh * S_ + query) * 64, qf);
    const float cq = c[(size_t)bh * S_ + query];
    f32x16 o[2];
    float l;
    fox_pass(K + (size_t)bh * S_ * 64, VT + (size_t)bh * 64 * S_, c + (size_t)bh * S_, cq, sbound, qw, 2 * qt + 1, qf, o, l, sm);
    const float inv = 1.f / l;
    const int b = bh >> 4, hh = bh & 15;
    bf16_t* dst = obuf + ((size_t)b * S_ + query) * D_ + hh * 64;
#pragma unroll
    for (int dt = 0; dt < 2; ++dt)
#pragma unroll
      for (int a = 0; a < 4; ++a) {
        bf16_t* p = dst + dt * 32 + 8 * a + 4 * h;
        u32x2 g = *(const u32x2*)p;
        if (rep) *(u32x2*)p = g;
        else
        store4bf(p, o[dt][4 * a] * inv * bflo(g.x), o[dt][4 * a + 1] * inv * bfhi(g.x), o[dt][4 * a + 2] * inv * bflo(g.y),
                 o[dt][4 * a + 3] * inv * bfhi(g.y));
      }
  }
}

DI void sb_attn_phase(const Params& P, char* smem) {
  AttnSmem& sm = *(AttnSmem*)smem;
  const bf16_t* Q = (const bf16_t*)(wsp(P) + OFF_R);
  const bf16_t* K = Q + (size_t)M_ * D_;
  const bf16_t* VT = K + (size_t)M_ * D_;
  bf16_t* obuf = (bf16_t*)(wsp(P) + OFF_OBUF);
  const int tid = tidx(), lane = tid & 63, wave = tid >> 6, r = lane & 31, h = lane >> 5;
  bf16x8 tdiag[2], ones;
#pragma unroll
  for (int s2 = 0; s2 < 2; ++s2)
#pragma unroll
    for (int jj = 0; jj < 8; ++jj) {
      const int kj = 16 * s2 + 8 * (jj >> 2) + 4 * h + (jj & 3);
      tdiag[s2][jj] = (kj > r) ? (short)0x3f80 : (short)0;
    }
#pragma unroll
  for (int jj = 0; jj < 8; ++jj) ones[jj] = (short)0x3f80;

  for (int it = bidx(); it < 4096; it += gridDim.x) {
    const int qt = 63 - (it >> 6), bh = it & 63;
    const int q0 = qt * 128, qw = q0 + wave * 32, query = qw + r;
    const bf16_t* Kb = K + (size_t)bh * S_ * 64;
    const bf16_t* VTb = VT + (size_t)bh * 64 * S_;
    bf16x8 qf[4];
    load_qf(Q + ((size_t)bh * S_ + query) * 64, qf);
    f32x16 o[2];
    zero16(o[0]);
    zero16(o[1]);
    float R = 0.f;
    u32x4 kr[2], vr[2];
    const int jhi = 2 * qt + 1;
    attn_load(Kb, 64, VTb, S_, jhi, kr, vr);
    for (int j = jhi; j >= 0; --j) {
      if (__syncthreads_and(R < -110.f)) break;
      attn_store(sm, kr, vr);
      __syncthreads();
      if (j > 0) attn_load(Kb, 64, VTb, S_, j - 1, kr, vr);
      if (j * 64 < qw + 31) {
        f32x16 st[2], Lv[2], lat[2];
        attn_qk(sm, qf, st);
        float tot = 0.f;
#pragma unroll
        for (int kt = 0; kt < 2; ++kt)
#pragma unroll
          for (int i = 0; i < 16; ++i) {
            const int key = j * 64 + kt * 32 + crow(i, h);
            const float z = st[kt][i] * 0.125f;
            const float sp = fmaxf(z, 0.f) + __logf(1.f + __expf(-fabsf(z)));
            const float L = (key < query) ? -sp : 0.f;
            st[kt][i] = z;
            Lv[kt][i] = L;
            tot += L;
          }
        tot += __shfl_xor(tot, 32);
        bf16x8 hi[2][2], lo[2][2];
#pragma unroll
        for (int kt = 0; kt < 2; ++kt)
#pragma unroll
          for (int s2 = 0; s2 < 2; ++s2) {
            float hv[8], lv[8];
#pragma unroll
            for (int q = 0; q < 8; ++q) {
              const float L = Lv[kt][8 * s2 + q];
              hv[q] = bf2f(f2bf(L));
              lv[q] = L - hv[q];
            }
            hi[kt][s2] = pack8(hv[0], hv[1], hv[2], hv[3], hv[4], hv[5], hv[6], hv[7]);
            lo[kt][s2] = pack8(lv[0], lv[1], lv[2], lv[3], lv[4], lv[5], lv[6], lv[7]);
          }
        zero16(lat[0]);
        zero16(lat[1]);
#pragma unroll
        for (int s2 = 0; s2 < 2; ++s2) {
          lat[0] = MFMA(tdiag[s2], hi[0][s2], lat[0]);
          lat[0] = MFMA(tdiag[s2], lo[0][s2], lat[0]);
          lat[0] = MFMA(ones, hi[1][s2], lat[0]);
          lat[0] = MFMA(ones, lo[1][s2], lat[0]);
          lat[1] = MFMA(tdiag[s2], hi[1][s2], lat[1]);
          lat[1] = MFMA(tdiag[s2], lo[1][s2], lat[1]);
        }
#pragma unroll
        for (int kt = 0; kt < 2; ++kt)
#pragma unroll
          for (int i = 0; i < 16; ++i) {
            const int key = j * 64 + kt * 32 + crow(i, h);
            const float e = st[kt][i] + Lv[kt][i] + lat[kt][i] + R;
            st[kt][i] = (key < query) ? __expf(e) : 0.f;
          }
        R += tot;
        attn_pv(sm, st, o);
      }
    }
    const int b = bh >> 4, hh = bh & 15;
    bf16_t* dst = obuf + ((size_t)b * S_ + query) * D_ + hh * 64;
#pragma unroll
    for (int dt = 0; dt < 2; ++dt)
#pragma unroll
      for (int a = 0; a < 4; ++a)
        store4bf(dst + dt * 32 + 8 * a + 4 * h, o[dt][4 * a], o[dt][4 * a + 1], o[dt][4 * a + 2], o[dt][4 * a + 3]);
  }
}

DI void nsa_compress_phase(const Params& P, char* smem) {
  bf16_t* sW = (bf16_t*)smem;
  bf16_t* sX = sW + 128 * 72;
  const bf16_t* KC = (const bf16_t*)(wsp(P) + OFF_R + 64 * MiB);
  const bf16_t* VC = (const bf16_t*)(wsp(P) + OFF_R + 112 * MiB);
  const float* cb = (const float*)(wsp(P) + OFF_CBIAS);
  const int wave = tidx() >> 6, wn = wave >> 1, wm = wave & 1;
  for (int t = bidx(); t < 64; t += gridDim.x) {
    const int isv = t >> 5, kv = (t >> 1) & 15, mt = t & 1;
    const bf16_t* Wt = (const bf16_t*)(wsp(P) + (isv ? OFF_WCV : OFF_WCK));
    const bf16_t* X = (isv ? VC : KC) + ((size_t)kv * S_ + (size_t)mt * 256 * 16) * 64;
    f32x16 acc[2][2][2];
    gemm_tile<2>(Wt, 2048, X, 1024, 2048, sW, sX, acc);
    EpiCmp epi;
    epi.cb = cb + isv * 64;
    epi.gk = inp(P, 19);
    epi.isv = isv;
    epi.dst = isv ? (bf16_t*)(wsp(P) + OFF_VCMPT) + (size_t)kv * 64 * 512 : (bf16_t*)(wsp(P) + OFF_KCMP) + (size_t)kv * 512 * 64;
    epi(acc[0], wn * 64, mt * 256 + wm * 128);
    epi(acc[1], wn * 64, mt * 256 + wm * 128 + 64);
  }
}

struct CmpSmem {
  AttnSmem a;
  float imp[32 * 132];
};

DI void nsa_cmp_phase(const Params& P, char* smem) {
  CmpSmem& sm = *(CmpSmem*)smem;
  const bf16_t* Q = (const bf16_t*)(wsp(P) + OFF_R);
  const bf16_t* KCMP = (const bf16_t*)(wsp(P) + OFF_KCMP);
  const bf16_t* VCMPT = (const bf16_t*)(wsp(P) + OFF_VCMPT);
  const float* gates = (const float*)(wsp(P) + OFF_GATES);
  bf16_t* obuf = (bf16_t*)(wsp(P) + OFF_OBUF);
  u32x4* sel = (u32x4*)(wsp(P) + OFF_SEL);
  const int tid = tidx(), lane = tid & 63, wave = tid >> 6, r = lane & 31, h = lane >> 5;
  for (int it = bidx(); it < 4096; it += gridDim.x) {
    const int tt = 255 - (it >> 4), kv = it & 15, b = kv >> 2, g = kv & 3;
    const int t0 = tt * 32, head = g * 4 + wave, query = t0 + r;
    const bf16_t* Kb = KCMP + (size_t)kv * 512 * 64;
    const bf16_t* VTb = VCMPT + (size_t)kv * 64 * 512;
    bf16x8 qf[4];
    load_qf(Q + ((size_t)(b * 16 + head) * S_ + query) * 64, qf);
    const int ntiles = ((t0 >> 4) >> 6) + 1;
    __syncthreads();
    for (int e = tid; e < 32 * 132; e += 256) sm.imp[e] = 0.f;
    float m_run = -1e30f, l_run = 0.f;
    u32x4 kr[2], vr[2];
    for (int jt = 0; jt < ntiles; ++jt) {
      attn_load(Kb, 64, VTb, 512, jt, kr, vr);
      __syncthreads();
      attn_store(sm.a, kr, vr);
      __syncthreads();
      f32x16 st[2];
      attn_qk(sm.a, qf, st);
      float mx = -1e30f;
#pragma unroll
      for (int kt = 0; kt < 2; ++kt)
#pragma unroll
        for (int i = 0; i < 16; ++i) {
          const int n = jt * 64 + kt * 32 + crow(i, h);
          const float s = (16 * n + 31 <= query) ? st[kt][i] * 0.125f : -1e30f;
          st[kt][i] = s;
          mx = fmaxf(mx, s);
        }
      mx = fmaxf(mx, __shfl_xor(mx, 32));
      const float m_new = fmaxf(m_run, mx);
      float ps = 0.f;
#pragma unroll
      for (int kt = 0; kt < 2; ++kt)
#pragma unroll
        for (int i = 0; i < 16; ++i) ps += (st[kt][i] > -1e29f) ? __expf(st[kt][i] - m_new) : 0.f;
      ps += __shfl_xor(ps, 32);
      l_run = l_run * __expf(m_run - m_new) + ps;
      m_run = m_new;
    }
    const float linv = l_run > 0.f ? 1.f / l_run : 0.f;
    f32x16 o[2];
    zero16(o[0]);
    zero16(o[1]);
    for (int jt = 0; jt < ntiles; ++jt) {
      attn_load(Kb, 64, VTb, 512, jt, kr, vr);
      __syncthreads();
      attn_store(sm.a, kr, vr);
      __syncthreads();
      f32x16 st[2];
      attn_qk(sm.a, qf, st);
#pragma unroll
      for (int kt = 0; kt < 2; ++kt)
#pragma unroll
        for (int i = 0; i < 16; ++i) {
          const int n = jt * 64 + kt * 32 + crow(i, h);
          st[kt][i] = (16 * n + 31 <= query) ? __expf(st[kt][i] * 0.125f - m_run) * linv : 0.f;
        }
      attn_pv(sm.a, st, o);
      for (int w = 0; w < 4; ++w) {
        if (wave == w) {
          float* ip = sm.imp + r * 132 + jt * 16 + h;
#pragma unroll
          for (int kt = 0; kt < 2; ++kt)
#pragma unroll
            for (int a = 0; a < 4; ++a) {
              const float G = st[kt][4 * a] + st[kt][4 * a + 1] + st[kt][4 * a + 2] + st[kt][4 * a + 3];
              const float x = __shfl_xor(st[kt][4 * a + 3], 32);
              ip[kt * 8 + 2 * a] += G + (h ? x : 0.f);
              if (!h) ip[kt * 8 + 2 * a + 2] += x;
            }
        }
        __syncthreads();
      }
    }
    {
      const size_t m = (size_t)b * S_ + query;
      float gc = gates[m * 48 + head * 3 + 0];
#if ABL == 3
      gc = 0.f;
#endif
      bf16_t* dst = obuf + m * D_ + head * 64;
#pragma unroll
      for (int dt = 0; dt < 2; ++dt)
#pragma unroll
        for (int a = 0; a < 4; ++a)
          store4bf(dst + dt * 32 + 8 * a + 4 * h, o[dt][4 * a] * gc, o[dt][4 * a + 1] * gc, o[dt][4 * a + 2] * gc,
                   o[dt][4 * a + 3] * gc);
    }
    for (int tk = 0; tk < 8; ++tk) {
      const int tl = wave * 8 + tk, t = t0 + tl, cur = t >> 6;
      const float* ip = sm.imp + tl * 132;
      const int j0 = lane, j1 = lane + 64;
      const bool f0 = (j0 == 0) || (j0 == cur) || (j0 == cur - 1);
      const bool f1 = (j1 == cur) || (j1 == cur - 1);
      const float v0 = f0 ? 1e9f : (j0 <= cur ? ip[j0] : -1.f);
      const float v1 = f1 ? 1e9f : (j1 <= cur ? ip[j1] : -1.f);
      int r0 = 0, r1 = 0;
      for (int jp = 0; jp <= cur; ++jp) {
        const bool fp = (jp == 0) || (jp == cur) || (jp == cur - 1);
        const float vp = fp ? 1e9f : ip[jp];
        r0 += (vp > v0 || (vp == v0 && jp < j0)) ? 1 : 0;
        r1 += (vp > v1 || (vp == v1 && jp < j1)) ? 1 : 0;
      }
      const unsigned long long m0 = __ballot(j0 <= cur && r0 < 16);
      const unsigned long long m1 = __ballot(j1 <= cur && r1 < 16);
      if (lane == 0) {
        u32x4 w;
        w.x = (unsigned)m0;
        w.y = (unsigned)(m0 >> 32);
        w.z = (unsigned)m1;
        w.w = (unsigned)(m1 >> 32);
        sel[(size_t)kv * S_ + t] = w;
      }
    }
  }
}

DI void nsa_attn_phase(const Params& P, char* smem, int rep) {
  AttnSmem& sm = *(AttnSmem*)smem;
  char* R = wsp(P) + OFF_R;
  const bf16_t* Q = (const bf16_t*)R;
  const bf16_t* KS = (const bf16_t*)(R + 80 * MiB);
  const bf16_t* KW = (const bf16_t*)(R + 96 * MiB);
  const bf16_t* VST = (const bf16_t*)(R + 128 * MiB);
  const bf16_t* VWT = (const bf16_t*)(R + 144 * MiB);
  const float* gates = (const float*)(wsp(P) + OFF_GATES);
  const u32x4* sel = (const u32x4*)(wsp(P) + OFF_SEL);
  bf16_t* obuf = (bf16_t*)(wsp(P) + OFF_OBUF);
  const int lane = tidx() & 63, wave = tidx() >> 6, r = lane & 31, h = lane >> 5;
  for (int it = bidx(); it < 4096; it += gridDim.x) {
    const int qt = 63 - (it >> 6), jx = it & 7, jy = (it >> 3) & 7;
    const int kv = jx * 2 + (jy >> 2), b = kv >> 2, head = (kv & 3) * 4 + (jy & 3), bh = b * 16 + head;
    const int q0 = qt * 128, qw = q0 + wave * 32, query = qw + r;
    bf16x8 qf[4];
    load_qf(Q + ((size_t)bh * S_ + query) * 64, qf);
    const u32x4 selw = sel[(size_t)kv * S_ + query];
    const size_t m = (size_t)b * S_ + query;
    float gs = gates[m * 48 + head * 3 + 1], gw = gates[m * 48 + head * 3 + 2];
    if (rep) { gs = 0.f; gw = 0.f; }
#if ABL == 1
    gs = 0.f;
#elif ABL == 2
    gw = 0.f;
#endif
    f32x16 o[2], ow[2];
    float l;
    const int jlo = (q0 > 511 ? q0 - 511 : 0) >> 6;
    flash_pass<1>(KW + (size_t)kv * S_ * 64, VWT + (size_t)kv * 64 * S_, nullptr, 0.f, selw, qw, jlo, 2 * qt + 1, qf, o, l, sm);
    {
      const float sc = gw / l;
#pragma unroll
      for (int dt = 0; dt < 2; ++dt)
#pragma unroll
        for (int i = 0; i < 16; ++i) ow[dt][i] = o[dt][i] * sc;
    }
    flash_pass<2>(KS + (size_t)kv * S_ * 64, VST + (size_t)kv * 64 * S_, nullptr, 0.f, selw, qw, 0, 2 * qt + 1, qf, o, l, sm);
    const float sc = gs / l;
    bf16_t* dst = obuf + m * D_ + head * 64;
#pragma unroll
    for (int dt = 0; dt < 2; ++dt)
#pragma unroll
      for (int a = 0; a < 4; ++a) {
        bf16_t* p = dst + dt * 32 + 8 * a + 4 * h;
        u32x2 g = *(const u32x2*)p;
        store4bf(p, ow[dt][4 * a] + o[dt][4 * a] * sc + bflo(g.x), ow[dt][4 * a + 1] + o[dt][4 * a + 1] * sc + bfhi(g.x),
                 ow[dt][4 * a + 2] + o[dt][4 * a + 2] * sc + bflo(g.y), ow[dt][4 * a + 3] + o[dt][4 * a + 3] * sc + bfhi(g.y));
      }
  }
}

struct GlaSmem {
  float glow[64 * 16];
  float tot[2 * 128];
  float ssq[2 * 64];
  bf16_t q[64 * 136];
  bf16_t ki[64 * 136];
  bf16_t a[64 * 72];
};

DI void gla_compute_b(const Params& P, GlaSmem& sm, int b, int hg, int t0, float (&bv)[32], float& blast) {
  const int tid = tidx(), d = tid & 127, half = tid >> 7;
  const float* glow = (const float*)(wsp(P) + OFF_GLOW) + ((size_t)b * S_ + t0) * 16;
  __syncthreads();
  for (int e = tid; e < 1024; e += 256) sm.glow[e] = glow[e];
  const int col = hg * 128 + d;
  float w[16];
#pragma unroll
  for (int q = 0; q < 16; ++q) w[q] = inp(P, 22)[q * 512 + col];
  const float bias = inp(P, 23)[col];
  __syncthreads();
  float run = 0.f;
#pragma unroll
  for (int cc = 0; cc < 32; ++cc) {
    const float* gl = sm.glow + (half * 32 + cc) * 16;
    float z = 0.f;
#pragma unroll
    for (int q = 0; q < 16; ++q) z += gl[q] * w[q];
    z += bias;
    run += logsigmoidf_(z) * (1.f / 16.f);
    bv[cc] = run;
    if ((cc & 3) == 3) __builtin_amdgcn_sched_barrier(0);
  }
  sm.tot[half * 128 + d] = run;
  __syncthreads();
  const float t0v = sm.tot[d], t1v = sm.tot[128 + d];
  if (half) {
#pragma unroll
    for (int cc = 0; cc < 32; ++cc) bv[cc] += t0v;
  }
  blast = t0v + t1v;
}

DI void gla_u_phase(const Params& P, char* smem) {
  GlaSmem& sm = *(GlaSmem*)smem;
  char* R = wsp(P) + OFF_R;
  const bf16_t* KG = (const bf16_t*)(R + 32 * MiB);
  const bf16_t* VTG = (const bf16_t*)(R + 64 * MiB);
  bf16_t* UT = (bf16_t*)(R + 128 * MiB);
  float* decay = (float*)(wsp(P) + OFF_DECAY);
  bf16_t* sKT = sm.q;
  const int tid = tidx(), lane = tid & 63, wave = tid >> 6, r = lane & 31, h = lane >> 5;
  const int d = tid & 127, half = tid >> 7;
  for (int it = bidx(); it < 2048; it += gridDim.x) {
    const int n = it & 127, bhg = it >> 7, b = bhg >> 2, hg = bhg & 3, t0 = n * 64;
    float bv[32], blast;
    gla_compute_b(P, sm, b, hg, t0, bv, blast);
#pragma unroll
    for (int cc = 0; cc < 32; ++cc) {
      const int c = half * 32 + cc;
      const float k = bf2f(KG[((size_t)b * S_ + t0 + c) * 512 + hg * 128 + d]);
      sKT[d * 72 + c] = f2bf(k * __expf(blast - bv[cc]));
      if ((cc & 7) == 7) __builtin_amdgcn_sched_barrier(0);
    }
    if (half == 0) decay[(size_t)it * 128 + d] = __expf(blast);
    __syncthreads();
#pragma unroll 1
    for (int m2 = 0; m2 < 2; ++m2) {
      const int e0 = (2 * wave + m2) * 32;
      f32x16 acc[4];
#pragma unroll
      for (int q = 0; q < 4; ++q) zero16(acc[q]);
      const bf16_t* vrow = VTG + ((size_t)b * 1024 + hg * 256 + e0 + r) * S_ + t0;
#pragma unroll
      for (int kk = 0; kk < 4; ++kk) {
        bf16x8 a = *(const bf16x8*)(vrow + kk * 16 + h * 8);
#pragma unroll
        for (int nt = 0; nt < 4; ++nt) {
          bf16x8 bb = *(const bf16x8*)(sKT + (nt * 32 + r) * 72 + kk * 16 + h * 8);
          acc[nt] = MFMA(a, bb, acc[nt]);
        }
        __builtin_amdgcn_sched_barrier(0);
      }
      bf16_t* ub = UT + ((size_t)it * 256 + e0 + 4 * h) * 128 + r;
#pragma unroll
      for (int nt = 0; nt < 4; ++nt) {
#pragma unroll
        for (int i = 0; i < 16; ++i) ub[((i & 3) + 8 * (i >> 2)) * 128 + nt * 32] = f2bf(acc[nt][i]);
        __builtin_amdgcn_sched_barrier(0);
      }
    }
  }
}

DI void gla_scan_phase(const Params& P, int rep) {
  bf16_t* UT = (bf16_t*)(wsp(P) + OFF_R + 128 * MiB);
  const float* decay = (const float*)(wsp(P) + OFF_DECAY);
  for (int gid = bidx() * 256 + tidx(); gid < 16 * 256 * 128; gid += gridDim.x * 256) {
    const int bhg = gid >> 15, e = (gid >> 7) & 255, d = gid & 127;
    float state = 0.f;
    for (int n0 = 0; n0 < 128; n0 += 8) {
      float u[8], dc[8];
#pragma unroll
      for (int q = 0; q < 8; ++q) {
        const size_t it = (size_t)bhg * 128 + n0 + q;
        u[q] = bf2f(UT[(it * 256 + e) * 128 + d]);
        dc[q] = decay[it * 128 + d];
      }
#pragma unroll
      for (int q = 0; q < 8; ++q) {
        const size_t it = (size_t)bhg * 128 + n0 + q;
        UT[(it * 256 + e) * 128 + d] = rep ? f2bf(u[q]) : f2bf(state);
        state = dc[q] * state + u[q];
      }
    }
  }
}

DI void gla_out_phase(const Params& P, char* smem, int rep) {
  GlaSmem& sm = *(GlaSmem*)smem;
  char* R = wsp(P) + OFF_R;
  const bf16_t* QG = (const bf16_t*)R;
  const bf16_t* KG = (const bf16_t*)(R + 32 * MiB);
  const bf16_t* VTG = (const bf16_t*)(R + 64 * MiB);
  const bf16_t* UT = (const bf16_t*)(R + 128 * MiB);
  bf16_t* obuf = (bf16_t*)(wsp(P) + OFF_OBUF);
  const float* gout = inp(P, 24);
  const int tid = tidx(), lane = tid & 63, wave = tid >> 6, r = lane & 31, h = lane >> 5;
  const int d = tid & 127, half = tid >> 7;
  for (int it = bidx(); it < 2048; it += gridDim.x) {
    const int n = it & 127, bhg = it >> 7, b = bhg >> 2, hg = bhg & 3, t0 = n * 64;
    float bv[32], blast;
    gla_compute_b(P, sm, b, hg, t0, bv, blast);
#pragma unroll
    for (int cc = 0; cc < 32; ++cc) {
      const int c = half * 32 + cc;
      const size_t off = ((size_t)b * S_ + t0 + c) * 512 + hg * 128 + d;
      const float q = bf2f(QG[off]), k = bf2f(KG[off]);
      sm.q[c * 136 + d] = f2bf(q * 0.08838834764831845f * __expf(bv[cc]));
      sm.ki[c * 136 + d] = f2bf(k * __expf(-bv[cc]));
      if ((cc & 3) == 3) __builtin_amdgcn_sched_barrier(0);
    }
    __syncthreads();
    {
      const int ct = wave >> 1, stt = wave & 1;
      f32x16 acc;
      zero16(acc);
      if (stt <= ct) {
#pragma unroll
        for (int kk = 0; kk < 8; ++kk) {
          bf16x8 a = *(const bf16x8*)(sm.q + (ct * 32 + r) * 136 + kk * 16 + h * 8);
          bf16x8 bb = *(const bf16x8*)(sm.ki + (stt * 32 + r) * 136 + kk * 16 + h * 8);
          acc = MFMA(a, bb, acc);
        }
      }
#pragma unroll
      for (int i = 0; i < 16; ++i) {
        const int c = ct * 32 + crow(i, h), s = stt * 32 + r;
        sm.a[c * 72 + s] = f2bf(s <= c ? acc[i] : 0.f);
      }
    }
    __syncthreads();
    const int ctok = wave & 1, eh = wave >> 1;
    f32x16 acc[4];
#pragma unroll
    for (int q = 0; q < 4; ++q) zero16(acc[q]);
#pragma unroll
    for (int kk = 0; kk < 4; ++kk) {
      bf16x8 bb = *(const bf16x8*)(sm.a + (ctok * 32 + r) * 72 + kk * 16 + h * 8);
#pragma unroll
      for (int mt = 0; mt < 4; ++mt) {
        bf16x8 a = *(const bf16x8*)(VTG + ((size_t)b * 1024 + hg * 256 + eh * 128 + mt * 32 + r) * S_ + t0 + kk * 16 + h * 8);
        acc[mt] = MFMA(a, bb, acc[mt]);
      }
      if (kk & 1) __builtin_amdgcn_sched_barrier(0);
    }
#pragma unroll
    for (int kk = 0; kk < 8; ++kk) {
      bf16x8 bb = *(const bf16x8*)(sm.q + (ctok * 32 + r) * 136 + kk * 16 + h * 8);
#pragma unroll
      for (int mt = 0; mt < 4; ++mt) {
        bf16x8 a = *(const bf16x8*)(UT + ((size_t)it * 256 + eh * 128 + mt * 32 + r) * 128 + kk * 16 + h * 8);
        acc[mt] = MFMA(a, bb, acc[mt]);
      }
      if (kk & 1) __builtin_amdgcn_sched_barrier(0);
    }
    float ss = 0.f;
#pragma unroll
    for (int mt = 0; mt < 4; ++mt)
#pragma unroll
      for (int i = 0; i < 16; ++i) ss += acc[mt][i] * acc[mt][i];
    ss += __shfl_xor(ss, 32);
    if (h == 0) sm.ssq[eh * 64 + ctok * 32 + r] = ss;
    __syncthreads();
    const float tot = sm.ssq[ctok * 32 + r] + sm.ssq[64 + ctok * 32 + r];
    const float rinv = rsqrtf(tot * (1.f / 256.f) + 1e-6f);
    bf16_t* dst = obuf + ((size_t)b * S_ + t0 + ctok * 32 + r) * D_ + hg * 256 + eh * 128;
#pragma unroll
    for (int mt = 0; mt < 4; ++mt)
#pragma unroll
      for (int a = 0; a < 4; ++a) {
        const int el = mt * 32 + 8 * a + 4 * h;
        const float* gp = gout + eh * 128 + el;
        bf16_t* p = dst + el;
        u32x2 g = *(const u32x2*)p;
        if (rep) *(u32x2*)p = g;
        else
        store4bf(p, acc[mt][4 * a] * rinv * gp[0] * bflo(g.x), acc[mt][4 * a + 1] * rinv * gp[1] * bfhi(g.x),
                 acc[mt][4 * a + 2] * rinv * gp[2] * bflo(g.y), acc[mt][4 * a + 3] * rinv * gp[3] * bfhi(g.y));
      }
  }
}

#define XB_TMO 128
#define XB_XCNT(j) (256 + 64 * (j))
#define XB_XSUB(j) (1280 + 64 * (j))
#define XB_XGEN(j) (2304 + 64 * (j))
#define XB_TOP 3328
#define XB_TOPGEN 3392
#define XCD_BAR_WORDS 3456
#define XB_SPIN_CAP (1u << 21)
#define LAS __attribute__((address_space(3)))
DI unsigned xb_ld(unsigned* p) { return __hip_atomic_load(p, __ATOMIC_RELAXED, __HIP_MEMORY_SCOPE_AGENT); }
DI unsigned xb_add(unsigned* p, unsigned v) { return __hip_atomic_fetch_add(p, v, __ATOMIC_RELAXED, __HIP_MEMORY_SCOPE_AGENT); }
DI unsigned xb_xcc_id() { return (unsigned)__builtin_amdgcn_s_getreg((3 << 11) | 20) & 0xFu; }
#define XB_SPIN(cond, bar)                                           \
  do {                                                               \
    unsigned _sp = 0;                                                \
    while (cond) {                                                   \
      __builtin_amdgcn_s_sleep(1);                                   \
      if ((++_sp & 255u) == 0u) {                                    \
        if (xb_ld(&(bar)[XB_TMO])) break;                            \
        if (_sp > XB_SPIN_CAP) {                                     \
          atomicAdd(&(bar)[XB_TMO], 1u);                             \
          break;                                                     \
        }                                                            \
      }                                                              \
    }                                                                \
  } while (0)
struct XcdBarrier {
  unsigned* bar;
  unsigned x;
  volatile LAS unsigned* st;
};
DI XcdBarrier xcd_barrier_post(unsigned* bar, volatile LAS unsigned* st) {
  XcdBarrier b;
  b.bar = bar;
  b.x = xb_xcc_id();
  b.st = st;
  if (threadIdx.x == 0) (void)xb_add(&bar[XB_XCNT(b.x)], 1u);
  return b;
}
DI void xcd_barrier_complete(unsigned* bar, unsigned x, unsigned& nloc, unsigned& nx) {
  const unsigned G = gridDim.x * gridDim.y * gridDim.z;
  unsigned sum, cnt, mine, sp = 0u;
  for (;;) {
    sum = 0u;
    cnt = 0u;
    mine = 0u;
#pragma unroll
    for (unsigned j = 0; j < 16; ++j) {
      const unsigned c = xb_ld(&bar[XB_XCNT(j)]);
      sum += c;
      cnt += (c > 0u) ? 1u : 0u;
      mine = (j == x) ? c : mine;
    }
    if (sum == G) break;
    __builtin_amdgcn_s_sleep(1);
    if ((++sp & 255u) == 0u) {
      if (xb_ld(&bar[XB_TMO])) break;
      if (sp > XB_SPIN_CAP) {
        atomicAdd(&bar[XB_TMO], 1u);
        break;
      }
    }
  }
  nloc = mine > 0u ? mine : 1u;
  nx = cnt > 0u ? cnt : 1u;
}
DI void xcd_barrier(const XcdBarrier& b) {
  asm volatile("s_waitcnt vmcnt(0)" ::: "memory");
  __syncthreads();
  if (threadIdx.x == 0) {
    unsigned* bar = b.bar;
    __builtin_amdgcn_s_waitcnt(0);
    unsigned nloc = b.st[0], nx = b.st[1];
    if (nloc == 0u) {
      xcd_barrier_complete(bar, b.x, nloc, nx);
      b.st[0] = nloc;
      b.st[1] = nx;
    }
    const unsigned old = xb_add(&bar[XB_XSUB(b.x)], 1u);
    const unsigned gen = old / nloc;
    if (old + 1u == (gen + 1u) * nloc) {
      __builtin_amdgcn_fence(__ATOMIC_RELEASE, "agent");
      asm volatile("s_waitcnt vmcnt(0)" ::: "memory");
      const unsigned og = xb_add(&bar[XB_TOP], 1u);
      const unsigned tg = og / nx;
      if (og + 1u == (tg + 1u) * nx) xb_add(&bar[XB_TOPGEN], 1u);
      else XB_SPIN(xb_ld(&bar[XB_TOPGEN]) == tg, bar);
      __builtin_amdgcn_fence(__ATOMIC_ACQUIRE, "agent");
      xb_add(&bar[XB_XGEN(b.x)], 1u);
      asm volatile("s_waitcnt vmcnt(0)" ::: "memory");
    } else {
      XB_SPIN(xb_ld(&bar[XB_XGEN(b.x)]) == gen, bar);
      __builtin_amdgcn_fence(__ATOMIC_ACQUIRE, "agent");
      asm volatile("s_waitcnt vmcnt(0)" ::: "memory");
    }
  }
  __syncthreads();
}

DI void run_phase(const Params& P, int ph, char* smem, int rep) {
  char* ws = wsp(P);
  float* ssq = (float*)(ws + OFF_SSQ);
  bf16_t* xb = (bf16_t*)(ws + OFF_XB);
  bf16_t* obuf = (bf16_t*)(ws + OFF_OBUF);
  bf16_t* act = (bf16_t*)(ws + OFF_R);
  if (ph == 0) {
    init_phase(P);
    prep_layer(P, 0, smem);
    return;
  }
  int L, lp;
  if (ph <= 8) { L = 0; lp = ph - 1; }
  else if (ph <= 18) { L = 1; lp = ph - 10; }
  else if (ph <= 28) { L = 2; lp = ph - 20; }
  else { L = 3; lp = ph - 30; }
  if (lp < 0) {
    prep_layer(P, L, smem);
    return;
  }
  const int nmix = (L == 0) ? 2 : (L == 1 ? 3 : (L == 2 ? 3 : 1));
  const float* s0 = ssq + (size_t)(3 * L) * M_ * 16;
  const float* s1 = s0 + (size_t)M_ * 16;
  const float* s2 = s1 + (size_t)M_ * 16;
  if (lp == 0 || lp == 4 + nmix) {
    const bool f2 = lp != 0;
    EpiFfn1 e;
    e.ssq = f2 ? s2 : s0;
    e.act = act;
    gemm_phase<2>((const bf16_t*)(ws + (f2 ? OFF_W2 : OFF_W1)), 2 * F_, xb, D_, D_, smem, e);
  } else if (lp == 1 || lp == 5 + nmix) {
    const bool f2 = lp != 1;
    EpiResid e;
    e.xin = (L == 0 && !f2 && !rep) ? inp(P, 0) : outp(P);
    e.xout = outp(P);
    e.xb = xb;
    e.ssqn = ssq + (size_t)(3 * L + (f2 ? 3 : 1)) * M_ * 16;
    e.scale = rep ? 0.f : 0.5f;
    gemm_phase<2>((const bf16_t*)(ws + (f2 ? OFF_W2D : OFF_W1D)), D_, act, F_, F_, smem, e);
  } else if (lp == 3 + nmix) {
    EpiResid e;
    e.xin = outp(P);
    e.xout = outp(P);
    e.xb = xb;
    e.ssqn = ssq + (size_t)(3 * L + 2) * M_ * 16;
    e.scale = rep ? 0.f : 1.f;
    gemm_phase<2>((const bf16_t*)(ws + OFF_WMO), D_, obuf, D_, D_, smem, e);
  } else if (lp == 2) {
    const bf16_t* wmi = (const bf16_t*)(ws + OFF_WMI);
    char* R = ws + OFF_R;
    if (L == 0 || L == 3) {
      EpiQKV e;
      e.ssq = s1;
      e.gq = inp(P, 10);
      e.gk = inp(P, 11);
      e.bfv = inp(P, 9);
      e.Q = (bf16_t*)R;
      e.K = (bf16_t*)(R + 64 * MiB);
      e.VT = (bf16_t*)(R + 128 * MiB);
      e.obuf = obuf;
      e.flog = (float*)(ws + OFF_FLOG);
      e.fox = (L == 0);
      gemm_phase<2>(wmi, L == 0 ? 4224 : 3072, xb, D_, D_, smem, e);
    } else if (L == 1) {
      EpiNSA e;
      e.ssq = s1;
      e.gq = inp(P, 18);
      e.gk = inp(P, 19);
      e.Q = (bf16_t*)R;
      e.KC = (bf16_t*)(R + 64 * MiB);
      e.KS = (bf16_t*)(R + 80 * MiB);
      e.KW = (bf16_t*)(R + 96 * MiB);
      e.VC = (bf16_t*)(R + 112 * MiB);
      e.VST = (bf16_t*)(R + 128 * MiB);
      e.VWT = (bf16_t*)(R + 144 * MiB);
      e.gates = (float*)(ws + OFF_GATES);
      gemm_phase<1>(wmi, 2688, xb, D_, D_, smem, e);
    } else {
      EpiGLA e;
      e.ssq = s1;
      e.QG = (bf16_t*)R;
      e.KG = (bf16_t*)(R + 32 * MiB);
      e.VTG = (bf16_t*)(R + 64 * MiB);
      e.obuf = obuf;
      e.glow = (float*)(ws + OFF_GLOW);
      gemm_phase<2>(wmi, 3200, xb, D_, D_, smem, e);
    }
  } else {
    const int mp = lp - 3;
    if (L == 0) {
      if (mp == 0) {
        fox_scan_phase(P, smem);
      }
      else {
        fox_attn_phase(P, smem, rep);
      }
    } else if (L == 1) {
      if (mp == 0) nsa_compress_phase(P, smem);
      else if (mp == 1) nsa_cmp_phase(P, smem);
      else {
        nsa_attn_phase(P, smem, rep);
      }
    } else if (L == 2) {
      if (mp == 0) gla_u_phase(P, smem);
      else if (mp == 1) gla_scan_phase(P, rep);
      else gla_out_phase(P, smem, rep);
    } else {
      sb_attn_phase(P, smem);
    }
  }
}

__global__ void __launch_bounds__(256, 2) mega_kernel(Params P, int ph_lo, int ph_hi) {
  __shared__ __attribute__((aligned(16))) char smem[57344];
  __shared__ __attribute__((aligned(16))) unsigned xbw[4];
  if (threadIdx.x == 0) { xbw[0] = 0u; xbw[1] = 0u; xbw[2] = 0u; xbw[3] = 0u; }
  __syncthreads();
  XcdBarrier xb = xcd_barrier_post((unsigned*)(P.ws + OFF_XBAR), (volatile LAS unsigned*)xbw);
  for (int ph = ph_lo; ph < ph_hi; ++ph) {
    run_phase(P, ph, smem, 0);
    if (ph + 1 < ph_hi) {
      if (ph == ph_lo) {
        asm volatile("s_waitcnt vmcnt(0)" ::: "memory");
        cg::this_grid().sync();
        __builtin_amdgcn_fence(__ATOMIC_ACQUIRE, "agent");
        asm volatile("s_waitcnt vmcnt(0)" ::: "memory");
        __syncthreads();
      } else {
        xcd_barrier(xb);
      }
    }
  }
}

extern "C" void kernel_launch(void* const* d_in, const int* in_sizes, int n_in, void* d_out, int out_size, void* d_ws,
                              size_t ws_size, hipStream_t stream) {
  static int grid_blocks = 0;
  if (!grid_blocks) {
    int dev = 0, cus = 0, per_cu = 0;
    hipGetDevice(&dev);
    hipDeviceGetAttribute(&cus, hipDeviceAttributeMultiprocessorCount, dev);
    hipOccupancyMaxActiveBlocksPerMultiprocessor(&per_cu, mega_kernel, 256, 0);
    if (per_cu > 2) per_cu = 2;
    if (per_cu < 1) per_cu = 1;
    grid_blocks = cus * per_cu;
  }
  Params p{};
  for (int i = 0; i < 28; ++i) p.in[i] = (const float*)d_in[i];
  p.out = (float*)d_out;
  p.ws = (char*)d_ws;
  hipMemsetAsync((char*)d_ws + OFF_XBAR, 0, XCD_BAR_WORDS * sizeof(unsigned), stream);
#if ONE_LAUNCH
  int lo = 0, hi = NPH_RUN;
  void* args[] = {&p, &lo, &hi};
  hipError_t e = hipLaunchCooperativeKernel((void*)mega_kernel, dim3(grid_blocks), dim3(256), args, 0, stream);
  if (e != hipSuccess) fprintf(stderr, "cooperative launch failed: %s (grid %d)\n", hipGetErrorString(e), grid_blocks);
#else
  for (int ph = 0; ph < NPH_RUN; ++ph) mega_kernel<<<grid_blocks, 256, 0, stream>>>(p, ph, ph + 1);
#endif
}
```
